# Optimizing an MI355X kernel written in HIP

```python
import jax, jax.numpy as jnp
from jax import lax
import numpy as np


D_MODEL = 1024
BATCH = 16
SEQ = 2048
DEPTH = 1

MEM_LEN = 256

GMLP_WIDTH = 1024
GMLP_GROUPS = 8
GMLP_CHUNK = 128
LRU_WIDTH = 1024
LRU_BLOCKS = 8
LRU_BLOCK_DIM = LRU_WIDTH // LRU_BLOCKS
CONV_WIDTH = 4
LRU_C = 8.0
XA_HEADS = 4
XA_HEAD_DIM = 256
XA_WIDTH = XA_HEADS * XA_HEAD_DIM
N_BRANCHES = 3
IN_COLS = 2 * GMLP_WIDTH + 2 * LRU_WIDTH + XA_WIDTH + N_BRANCHES * D_MODEL
N_EXPERTS = 64
TOP_K = 8
N_GROUPS = 8
TOPK_GROUPS = 4
EXPERT_DIM = 256
SHARED_DIM = 256
ROUTED_SCALE = 2.5
EXPERT_BLOCK = 256
LN_EPS = 1e-5
DN_ALPHA = (2.0 * DEPTH) ** 0.25
DN_BETA = (8.0 * DEPTH) ** -0.25

kernel_name = "hybrid_gmlp_rglru_xattn_moe_block"


def layer_norm(x, g, b):
    xf = x.astype(jnp.float32)
    mu = jnp.mean(xf, axis=-1, keepdims=True)
    var = jnp.mean(jnp.square(xf - mu), axis=-1, keepdims=True)
    return ((xf - mu) * lax.rsqrt(var + LN_EPS)).astype(x.dtype) * g + b


def chunked_spatial_gating(uv, norm_g, norm_b, w_sp, b_sp):
    u, v = jnp.split(jax.nn.gelu(uv), 2, axis=-1)
    v = layer_norm(v, norm_g, norm_b)
    B, S, _ = v.shape
    n_chunks = S // GMLP_CHUNK
    vc = v.reshape(B, n_chunks, GMLP_CHUNK, GMLP_GROUPS, GMLP_WIDTH // GMLP_GROUPS)
    causal = jnp.tril(jnp.ones((GMLP_CHUNK, GMLP_CHUNK), dtype=bool))
    w = jnp.where(causal[None], w_sp, 0)
    mixed = jnp.einsum('gts,bnsgc->bntgc', w, vc) + b_sp.T[None, None, :, :, None]
    return u * mixed.reshape(B, S, GMLP_WIDTH)


def causal_depthwise_conv(x, w, b):
    S = x.shape[1]
    xp = jnp.pad(x, ((0, 0), (CONV_WIDTH - 1, 0), (0, 0)))
    out = b
    for k in range(CONV_WIDTH):
        out = out + w[k] * xp[:, CONV_WIDTH - 1 - k: CONV_WIDTH - 1 - k + S]
    return out


def block_diag_linear(x, w, b):
    B, S, _ = x.shape
    xg = x.reshape(B, S, LRU_BLOCKS, LRU_BLOCK_DIM)
    return jnp.einsum('bsgi,gio->bsgo', xg, w).reshape(B, S, LRU_WIDTH) + b


def rg_lru(x, w_a, b_a, w_i, b_i, lam):
    r = jax.nn.sigmoid(block_diag_linear(x, w_a, b_a))
    i = jax.nn.sigmoid(block_diag_linear(x, w_i, b_i))
    log_a = -LRU_C * r.astype(jnp.float32) * jax.nn.softplus(-lam.astype(jnp.float32))
    a = jnp.exp(log_a)
    mult = jnp.sqrt(-jnp.expm1(2.0 * log_a))
    b_term = mult * (i * x).astype(jnp.float32)

    def combine(c1, c2):
        a1, b1 = c1
        a2, b2 = c2
        return a1 * a2, a2 * b1 + b2

    _, h = lax.associative_scan(combine, (a, b_term), axis=1)
    return h.astype(x.dtype)


def memory_cross_attention(q, mem, w_kv):
    B, S, _ = q.shape
    M = mem.shape[1]
    k, v = jnp.split(mem @ w_kv, 2, axis=-1)
    q = q.reshape(B, S, XA_HEADS, XA_HEAD_DIM)
    k = k.reshape(B, M, XA_HEADS, XA_HEAD_DIM)
    v = v.reshape(B, M, XA_HEADS, XA_HEAD_DIM)
    scores = jnp.einsum('bshd,bmhd->bhsm', q, k).astype(jnp.float32) * (XA_HEAD_DIM ** -0.5)
    p = jax.nn.softmax(scores, axis=-1).astype(v.dtype)
    return jnp.einsum('bhsm,bmhd->bshd', p, v).reshape(B, S, XA_WIDTH)


def route(h, w_router, router_bias):
    T = h.shape[0]
    s = jax.nn.sigmoid((h @ w_router).astype(jnp.float32))
    choice = s + router_bias.astype(jnp.float32)
    grp = choice.reshape(T, N_GROUPS, N_EXPERTS // N_GROUPS)
    grp_score = jnp.sum(lax.top_k(grp, 2)[0], axis=-1)
    _, top_grp = lax.top_k(grp_score, TOPK_GROUPS)
    grp_mask = jnp.any(top_grp[:, :, None] == jnp.arange(N_GROUPS)[None, None, :], axis=1)
    exp_mask = jnp.repeat(grp_mask, N_EXPERTS // N_GROUPS, axis=-1)
    _, idx = lax.top_k(jnp.where(exp_mask, choice, -jnp.inf), TOP_K)
    w = jnp.take_along_axis(s, idx, axis=-1)
    w = w / jnp.sum(w, axis=-1, keepdims=True) * ROUTED_SCALE
    return idx, w


def routed_experts(h, idx, wts, w_gate, w_up, w_down):
    T, D = h.shape
    A = T * TOP_K
    n_blocks = -(-A // EXPERT_BLOCK) + N_EXPERTS
    P = n_blocks * EXPERT_BLOCK
    flat_e = idx.reshape(A)
    flat_tok = jnp.arange(A, dtype=jnp.int32) // TOP_K
    flat_w = wts.reshape(A)
    order = jnp.argsort(flat_e)
    sorted_e = flat_e[order]
    counts = jnp.bincount(flat_e, length=N_EXPERTS)
    padded = (counts + EXPERT_BLOCK - 1) // EXPERT_BLOCK * EXPERT_BLOCK
    pad_end = jnp.cumsum(padded)
    pad_start = pad_end - padded
    start = jnp.cumsum(counts) - counts
    dest = pad_start[sorted_e] + (jnp.arange(A, dtype=jnp.int32) - start[sorted_e])
    row_tok = jnp.zeros((P,), jnp.int32).at[dest].set(flat_tok[order])
    row_w = jnp.zeros((P,), wts.dtype).at[dest].set(flat_w[order])
    block_start = jnp.arange(n_blocks, dtype=jnp.int32) * EXPERT_BLOCK
    block_e = jnp.minimum(jnp.searchsorted(pad_end, block_start, side='right'), N_EXPERTS - 1)

    def body(acc, blk):
        tok, rw, e = blk
        xb = h[tok]
        yb = (jax.nn.silu(xb @ w_gate[e]) * (xb @ w_up[e])) @ w_down[e]
        return acc.at[tok].add(yb * rw[:, None].astype(yb.dtype)), None

    acc, _ = lax.scan(body, jnp.zeros_like(h),
                      (row_tok.reshape(n_blocks, EXPERT_BLOCK),
                       row_w.reshape(n_blocks, EXPERT_BLOCK), block_e))
    return acc


def hybrid_layer(h, mem, w_in, gmlp_norm_g, gmlp_norm_b, gmlp_spatial_w, gmlp_spatial_b,
                 conv_w, conv_b, lru_wa, lru_ba, lru_wi, lru_bi, lru_lambda, w_kv,
                 w_br_gmlp, w_br_lru, w_br_xa, w_out, ln1_g, ln1_b,
                 w_router, router_bias, exp_gate, exp_up, exp_down, sh_gate, sh_up, sh_down, ln2_g, ln2_b):
    B, S, D = h.shape
    z = h @ w_in
    c1 = 2 * GMLP_WIDTH
    c2 = c1 + LRU_WIDTH
    c3 = c2 + LRU_WIDTH
    c4 = c3 + XA_WIDTH
    uv, lru_x, lru_g, q, gates = jnp.split(z, [c1, c2, c3, c4], axis=-1)
    y_gmlp = chunked_spatial_gating(uv, gmlp_norm_g, gmlp_norm_b, gmlp_spatial_w, gmlp_spatial_b)
    xc = causal_depthwise_conv(lru_x, conv_w, conv_b)
    y_lru = rg_lru(xc, lru_wa, lru_ba, lru_wi, lru_bi, lru_lambda) * jax.nn.gelu(lru_g)
    y_xa = memory_cross_attention(q, mem, w_kv)
    g = jax.nn.sigmoid(gates).reshape(B, S, N_BRANCHES, D)
    merged = (g[:, :, 0] * (y_gmlp @ w_br_gmlp)
              + g[:, :, 1] * (y_lru @ w_br_lru)
              + g[:, :, 2] * (y_xa @ w_br_xa))
    h = layer_norm(DN_ALPHA * h + merged @ w_out, ln1_g, ln1_b)
    hf = h.reshape(B * S, D)
    idx, wts = route(hf, w_router, router_bias)
    routed = routed_experts(hf, idx, wts, exp_gate, exp_up, exp_down)
    shared = (jax.nn.silu(hf @ sh_gate) * (hf @ sh_up)) @ sh_down
    return layer_norm(DN_ALPHA * h + (routed + shared).reshape(B, S, D), ln2_g, ln2_b)


def setup_inputs(seed: int = 0) -> dict:
    key = jax.random.key(seed)
    ks = iter(jax.random.split(key, 48))
    f32 = jnp.float32
    L, D = DEPTH, D_MODEL

    def nrm(shape, scale):
        return jax.random.normal(next(ks), shape, f32) * scale

    u = jax.random.uniform(next(ks), (L, LRU_WIDTH), f32, 0.9, 0.999)
    p = u ** (1.0 / LRU_C)
    lam = jnp.log(p) - jnp.log1p(-p)
    w_kv = jnp.concatenate([nrm((L, D, XA_WIDTH), D ** -0.5),
                            nrm((L, D, XA_WIDTH), DN_BETA * D ** -0.5)], axis=-1)
    return {
        'x': nrm((BATCH, SEQ, D), 1.0),
        'mem': nrm((BATCH, MEM_LEN, D), 1.0),
        'ln_in_g': 1.0 + nrm((D,), 0.02),
        'ln_in_b': nrm((D,), 0.02),
        'w_in': nrm((L, D, IN_COLS), D ** -0.5),
        'gmlp_norm_g': 1.0 + nrm((L, GMLP_WIDTH), 0.02),
        'gmlp_norm_b': nrm((L, GMLP_WIDTH), 0.02),
        'gmlp_spatial_w': nrm((L, GMLP_GROUPS, GMLP_CHUNK, GMLP_CHUNK), GMLP_CHUNK ** -0.5),
        'gmlp_spatial_b': 1.0 + nrm((L, GMLP_GROUPS, GMLP_CHUNK), 0.1),
        'conv_w': nrm((L, CONV_WIDTH, LRU_WIDTH), CONV_WIDTH ** -0.5),
        'conv_b': nrm((L, LRU_WIDTH), 0.02),
        'lru_wa': nrm((L, LRU_BLOCKS, LRU_BLOCK_DIM, LRU_BLOCK_DIM), LRU_BLOCK_DIM ** -0.5),
        'lru_ba': nrm((L, LRU_WIDTH), 0.02),
        'lru_wi': nrm((L, LRU_BLOCKS, LRU_BLOCK_DIM, LRU_BLOCK_DIM), LRU_BLOCK_DIM ** -0.5),
        'lru_bi': nrm((L, LRU_WIDTH), 0.02),
        'lru_lambda': lam,
        'w_kv': w_kv,
        'w_br_gmlp': nrm((L, GMLP_WIDTH, D), DN_BETA * GMLP_WIDTH ** -0.5),
        'w_br_lru': nrm((L, LRU_WIDTH, D), DN_BETA * LRU_WIDTH ** -0.5),
        'w_br_xa': nrm((L, XA_WIDTH, D), DN_BETA * XA_WIDTH ** -0.5),
        'w_out': nrm((L, D, D), DN_BETA * D ** -0.5),
        'ln1_g': 1.0 + nrm((L, D), 0.02),
        'ln1_b': nrm((L, D), 0.02),
        'w_router': nrm((L, D, N_EXPERTS), D ** -0.5),
        'router_bias': nrm((L, N_EXPERTS), 0.01),
        'exp_gate': nrm((L, N_EXPERTS, D, EXPERT_DIM), DN_BETA * D ** -0.5),
        'exp_up': nrm((L, N_EXPERTS, D, EXPERT_DIM), DN_BETA * D ** -0.5),
        'exp_down': nrm((L, N_EXPERTS, EXPERT_DIM, D), DN_BETA * EXPERT_DIM ** -0.5),
        'sh_gate': nrm((L, D, SHARED_DIM), DN_BETA * D ** -0.5),
        'sh_up': nrm((L, D, SHARED_DIM), DN_BETA * D ** -0.5),
        'sh_down': nrm((L, SHARED_DIM, D), DN_BETA * SHARED_DIM ** -0.5),
        'ln2_g': 1.0 + nrm((L, D), 0.02),
        'ln2_b': nrm((L, D), 0.02),
    }


def reference(x, mem, ln_in_g, ln_in_b, w_in, gmlp_norm_g, gmlp_norm_b, gmlp_spatial_w, gmlp_spatial_b,
              conv_w, conv_b, lru_wa, lru_ba, lru_wi, lru_bi, lru_lambda, w_kv,
              w_br_gmlp, w_br_lru, w_br_xa, w_out, ln1_g, ln1_b,
              w_router, router_bias, exp_gate, exp_up, exp_down, sh_gate, sh_up, sh_down, ln2_g, ln2_b):
    h = layer_norm(x, ln_in_g, ln_in_b)
    for l in range(DEPTH):
        h = hybrid_layer(h, mem, w_in[l], gmlp_norm_g[l], gmlp_norm_b[l], gmlp_spatial_w[l], gmlp_spatial_b[l],
                         conv_w[l], conv_b[l], lru_wa[l], lru_ba[l], lru_wi[l], lru_bi[l], lru_lambda[l], w_kv[l],
                         w_br_gmlp[l], w_br_lru[l], w_br_xa[l], w_out[l], ln1_g[l], ln1_b[l],
                         w_router[l], router_bias[l], exp_gate[l], exp_up[l], exp_down[l],
                         sh_gate[l], sh_up[l], sh_down[l], ln2_g[l], ln2_b[l])
    return h
```

```cpp
#include <hip/hip_runtime.h>
#include <hip/hip_cooperative_groups.h>
#include <cstdio>
#include <cstdint>
namespace cg = cooperative_groups;
#ifndef DBG_SEL
#define DBG_SEL 0
#endif
#ifndef MK_DEBUG
#define MK_DEBUG 0
#endif

constexpr int T = 32768, D = 1024, NB = 16, SEQ = 2048, MEMLEN = 256, TM = NB * MEMLEN;
constexpr int INC = 8192;
constexpr int NE = 64, TOPK = 8, ED = 256;
constexpr int NCH = 4, CT = T / NCH;
constexpr int RTMAX = 320, SHT = CT / 256;
constexpr int CROWS = (RTMAX + SHT) * 256;
constexpr float LN_EPS = 1e-5f;
constexpr float DN_ALPHA = 1.189207115002721f;
constexpr float ROUTED_SCALE = 2.5f;

constexpr size_t MiB = 1u << 20;
constexpr size_t WS_CTL = 0;
constexpr size_t WS_XSTAT = 1 * MiB;
constexpr size_t WS_VSTAT = 2 * MiB;
constexpr size_t WS_IDX = 6 * MiB;
constexpr size_t WS_WTS = 7 * MiB;
constexpr size_t WS_RK = 8 * MiB;
constexpr size_t WS_POS = 9 * MiB;
constexpr size_t WS_HIST = 10 * MiB;
constexpr size_t WS_TILEE = 10 * MiB + 64 * 1024;
constexpr size_t WS_NTILE = 10 * MiB + 96 * 1024;
constexpr size_t WS_ROWW = 13 * MiB;
constexpr size_t WS_ROWOFF = 11 * MiB;
constexpr size_t WS_WA = 16 * MiB;
constexpr size_t WS_WI = WS_WA + 256 * 1024;
constexpr size_t WS_WSP = WS_WI + 256 * 1024;
constexpr size_t WS_WR = WS_WSP + 256 * 1024;
constexpr size_t WS_WIN = 17 * MiB;
constexpr size_t WS_WBR = 17 * MiB, WS_WOUT = 23 * MiB;
constexpr size_t WS_WKV = 33 * MiB;
constexpr size_t WS_MEMB = 37 * MiB, WS_KB = 45 * MiB, WS_VT = 53 * MiB;
constexpr size_t WS_H0 = 61 * MiB;
constexpr size_t WS_U = 125 * MiB, WS_LG = 189 * MiB, WS_Q = 253 * MiB, WS_GV = 317 * MiB, WS_LX = 381 * MiB;
constexpr size_t WS_P = WS_GV;
constexpr size_t WS_G0 = 445 * MiB;
constexpr size_t WS_H1 = WS_H0, WS_H1LO = 125 * MiB;
constexpr size_t WS_WGU = 189 * MiB;
constexpr size_t WS_WD = 254 * MiB;
constexpr size_t WS_HB = 287 * MiB;
constexpr size_t WS_Y = 331 * MiB;
constexpr size_t WS_END = 507 * MiB;
static_assert(WS_WD + (size_t)65 * 1024 * 256 * 2 <= WS_HB && WS_HB + (size_t)CROWS * 256 * 2 <= WS_Y && WS_Y + (size_t)CROWS * 1024 * 2 <= WS_END, "MoE map");
static_assert(WS_WGU + (size_t)65 * 2 * 256 * 1024 * 2 <= WS_WD, "MoE map 2");
static_assert(WS_ROWOFF + (size_t)NCH * CROWS * 4 <= WS_ROWW && WS_ROWW + (size_t)NCH * CROWS * 4 <= WS_WA, "tables");

constexpr int LDS_BYTES = 147456;
#define LAS __attribute__((address_space(3)))
typedef unsigned short bf16;
typedef short bf16x8 __attribute__((ext_vector_type(8)));
typedef float f32x4 __attribute__((ext_vector_type(4)));
typedef float f32x2 __attribute__((ext_vector_type(2)));
typedef unsigned u32x4 __attribute__((ext_vector_type(4)));
typedef unsigned u32x2 __attribute__((ext_vector_type(2)));

__device__ __forceinline__ unsigned f2bf(float f) { unsigned u = __builtin_bit_cast(unsigned, f); return (u + 0x7fffu + ((u >> 16) & 1u)) >> 16; }
__device__ __forceinline__ unsigned pk2(float lo, float hi) { return f2bf(lo) | (f2bf(hi) << 16); }
__device__ __forceinline__ float bf2f(unsigned b) { return __builtin_bit_cast(float, b << 16); }
__device__ __forceinline__ float bflo(unsigned w) { return __builtin_bit_cast(float, w << 16); }
__device__ __forceinline__ float bfhi(unsigned w) { return __builtin_bit_cast(float, w & 0xffff0000u); }
__device__ __forceinline__ float wave_sum(float v) {
#pragma unroll
    for (int o = 1; o < 64; o <<= 1) v += __shfl_xor(v, o);
    return v;
}
__device__ __forceinline__ float fast_sigmoid(float x) { return __builtin_amdgcn_rcpf(1.0f + __builtin_amdgcn_exp2f(-1.4426950408889634f * x)); }
__device__ __forceinline__ float gelu_tanh(float x) { const float u = x * (1.0f + 0.044715f * x * x); return x * fast_sigmoid(1.5957691216057308f * u); }
#define LDS_WAIT() asm volatile("s_waitcnt lgkmcnt(0)" ::: "memory")
#define VM_WAIT() asm volatile("s_waitcnt vmcnt(0)" ::: "memory")
namespace pg8 {
#define PG8_LAS __attribute__((address_space(3)))
typedef unsigned short bf16_t;
typedef short bf16x8 __attribute__((ext_vector_type(8)));
typedef float f32x4 __attribute__((ext_vector_type(4)));
typedef float f32x2 __attribute__((ext_vector_type(2)));
typedef unsigned u32x4 __attribute__((ext_vector_type(4)));
typedef unsigned u32x2 __attribute__((ext_vector_type(2)));
constexpr int BM = 256, BK = 64, HALF = 128, HTB = HALF * BK * 2  , STAGE_BYTES = 8 * HTB, NXCD = 8, WGM = 8;

__host__ __device__ __forceinline__ int lds_byte(int r, int c) { const int st = (r >> 4) * 2 + (c >> 5), rr = r & 15, cc = c & 31, ob = rr * 64 + cc * 2; return st * 1024 + (ob ^ (((ob >> 9) & 1) << 5)); }
__host__ __device__ __forceinline__ void stage_rc(int b, int& R, int& C) { const int st = b / 1024, sb = b % 1024, swz = sb ^ (((sb >> 9) & 1) << 5); R = (st >> 1) * 16 + swz / 64; C = (st & 1) * 32 + (swz % 64) / 2; }
__host__ __device__ __forceinline__ int perm32(int rho) { const int n = rho >> 4, i = rho & 15; return 8 * (i >> 2) + 4 * n + (i & 3); }

struct Unit { int pm, pn, aux; };

__device__ __forceinline__ void tile_order(int L, int nM, int nN, int& pm, int& pn) {
    const int nwg = nM * nN; int wgid = L;
    { const int q = nwg / NXCD, r = nwg % NXCD, xcd = wgid % NXCD, off = wgid / NXCD; wgid = (xcd < r ? xcd * (q + 1) : r * (q + 1) + (xcd - r) * q) + off; }
    const int nig = WGM * nN, gid = wgid / nig, fm = gid * WGM, gsz = (nM - fm) < WGM ? (nM - fm) : WGM;
    pm = fm + ((wgid % nig) % gsz); pn = (wgid % nig) / gsz;
}

__device__ __forceinline__ unsigned cvt_pk_bf16(float lo, float hi) { unsigned r; asm volatile("v_cvt_pk_bf16_f32 %0, %1, %2" : "=v"(r) : "v"(lo), "v"(hi)); return r; }

template <class P>
__device__ __forceinline__ void gemm_phase(PG8_LAS unsigned char* lds, const P& S) {
    int tid_ = threadIdx.x; asm volatile("" : "+v"(tid_));
    const int tid = tid_, wid = __builtin_amdgcn_readfirstlane(tid >> 6), lane = tid & 63, wr = wid >> 2, wc = wid & 3, fr = lane & 15, fq = lane >> 4;
    const int K = S.K, nt = K / BK;
    unsigned voffA[2], voffB[2]; int RA[2], CA[2];
#pragma unroll
    for (int i = 0; i < 2; ++i) { int R, C; stage_rc(tid * 16 + i * 8192, R, C); const int Rb = P::PERM ? ((R & ~31) + perm32(R & 31)) : R;
        RA[i] = R; CA[i] = C; voffA[i] = (unsigned)(R * K + C) * 2u; voffB[i] = (unsigned)(Rb * K + C) * 2u; }
    const size_t kstep = (size_t)(BK * 2);
    const size_t hstep = (size_t)HALF * K * 2;
    const unsigned ldsw = (unsigned)wid * 1024u;
    const int aoff = lds_byte(wr * 64 + fr, fq * 8), boff = lds_byte(wc * 32 + fr, fq * 8);
#define PG8_SA(b, h) (((b) * 2 + (h)) * HTB)
#define PG8_SB(b, h) ((4 + (b) * 2 + (h)) * HTB)
#define PG8_STAGE(bufoff, gbase, o0, o1) do { \
        __builtin_amdgcn_global_load_lds((const unsigned*)((const char*)(gbase) + (o0)), (PG8_LAS unsigned*)(lds + (bufoff) + ldsw), 16, 0, 0); \
        __builtin_amdgcn_global_load_lds((const unsigned*)((const char*)(gbase) + (o1)), (PG8_LAS unsigned*)(lds + (bufoff) + ldsw + 8192), 16, 0, 0); } while (0)
#define PG8_STAGEB(bufoff, gbase) PG8_STAGE(bufoff, gbase, voffB[0], voffB[1])
#define PG8_STAGEA(bufoff, p, v, h) do { if constexpr (P::GATHER) PG8_STAGE(bufoff, p, (v)[h][0], (v)[h][1]); else PG8_STAGE(bufoff, (p) + (h) * hstep, voffA[0], voffA[1]); } while (0)
#define PG8_LDA(dst, b, h) do { _Pragma("unroll") for (int m = 0; m < 4; ++m) _Pragma("unroll") for (int k = 0; k < 2; ++k) dst[m][k] = *(const PG8_LAS bf16x8*)(lds + PG8_SA(b, h) + aoff + m * 2048 + k * 1024); } while (0)
#define PG8_LDB(dst, b, h) do { _Pragma("unroll") for (int n = 0; n < 2; ++n) _Pragma("unroll") for (int k = 0; k < 2; ++k) dst[n][k] = *(const PG8_LAS bf16x8*)(lds + PG8_SB(b, h) + boff + n * 2048 + k * 1024); } while (0)
#define PG8_MMA(ai, bj, At, Bt) do { __builtin_amdgcn_s_setprio(1); _Pragma("unroll") for (int m = 0; m < 4; ++m) _Pragma("unroll") for (int n = 0; n < 2; ++n) _Pragma("unroll") for (int k = 0; k < 2; ++k) \
        acc[ai][bj][m][n] = __builtin_amdgcn_mfma_f32_16x16x32_bf16(Bt[n][k], At[m][k], acc[ai][bj][m][n], 0, 0, 0); __builtin_amdgcn_s_setprio(0); } while (0)
#define PG8_WAIT_V(n) asm volatile("s_waitcnt vmcnt(" #n ")" ::: "memory")
#define PG8_WAIT_L(n) asm volatile("s_waitcnt lgkmcnt(" #n ")" ::: "memory")
#define PG8_BAR __builtin_amdgcn_s_barrier()
#define PG8_SCHED __builtin_amdgcn_sched_barrier(0)
    Unit cur, nxt; int ui = 0;
    if (!S.next(0, cur)) return;
    f32x4 acc[2][2][4][2];
#pragma unroll
    for (int a = 0; a < 2; ++a)
#pragma unroll
        for (int b = 0; b < 2; ++b)
#pragma unroll
            for (int m = 0; m < 4; ++m)
#pragma unroll
                for (int n = 0; n < 2; ++n) acc[a][b][m][n] = (f32x4){0.f, 0.f, 0.f, 0.f};
    bf16x8 At[4][2], B0[2][2], B1[2][2];
    unsigned vA[2][2] = {{0u, 0u}, {0u, 0u}};
    const char* cA = S.abase(cur); const char* cB = S.bbase(cur);
    if constexpr (P::GATHER) S.gather(cur, RA[0], vA, CA[0], CA[1]);
    PG8_STAGEB(PG8_SB(0, 0), cB); PG8_STAGEB(PG8_SB(0, 1), cB + hstep); PG8_STAGEA(PG8_SA(0, 0), cA, vA, 0); PG8_STAGEA(PG8_SA(0, 1), cA, vA, 1);
    if (wr == 1) PG8_BAR;
    PG8_WAIT_V(2); PG8_BAR;
    PG8_STAGEB(PG8_SB(1, 0), cB + kstep); PG8_STAGEA(PG8_SA(1, 0), cA + kstep, vA, 0); PG8_STAGEB(PG8_SB(1, 1), cB + hstep + kstep);
    PG8_WAIT_V(6); PG8_BAR;
    for (;;) {
        const bool has_next = S.next(ui + 1, nxt);
        const char* nA = has_next ? S.abase(nxt) : cA; const char* nB = has_next ? S.bbase(nxt) : cB;
        if constexpr (P::GATHER) { if (has_next && tid < 64) S.gather_to_lds(nxt, lds + STAGE_BYTES, tid); }
        for (int t = 0; t < nt; t += 2) {
            const bool last = (t == nt - 2);
            const char* a1 = cA + (size_t)(t + 1) * kstep;
            const char* a2 = last ? nA : cA + (size_t)(t + 2) * kstep; const char* b2 = last ? nB : cB + (size_t)(t + 2) * kstep;
            const char* a3 = a2 + kstep; const char* b3 = b2 + kstep;
            PG8_LDB(B0, 0, 0); PG8_LDB(B1, 0, 1); PG8_SCHED; PG8_LDA(At, 0, 0); PG8_STAGEA(PG8_SA(1, 1), a1, vA, 1);
            PG8_WAIT_V(8); PG8_WAIT_L(0); PG8_BAR; PG8_MMA(0, 0, At, B0); PG8_MMA(0, 1, At, B1); PG8_BAR; PG8_SCHED;
            if constexpr (P::GATHER) { if (last && has_next) { const u32x4 o = *(const PG8_LAS u32x4*)(lds + STAGE_BYTES + RA[0] * 16); const unsigned c2 = (unsigned)CA[0] * 2u;
                vA[0][0] = o.x + c2; vA[0][1] = o.y + c2; vA[1][0] = o.z + c2; vA[1][1] = o.w + c2; } }
            PG8_LDA(At, 0, 1); PG8_STAGEB(PG8_SB(0, 0), b2); PG8_STAGEB(PG8_SB(0, 1), b2 + hstep); PG8_STAGEA(PG8_SA(0, 0), a2, vA, 0);
            PG8_WAIT_V(8); PG8_WAIT_L(0); PG8_BAR; PG8_MMA(1, 0, At, B0); PG8_MMA(1, 1, At, B1); PG8_BAR; PG8_SCHED;
            PG8_LDB(B0, 1, 0); PG8_LDB(B1, 1, 1); PG8_SCHED; PG8_LDA(At, 1, 0); PG8_STAGEA(PG8_SA(0, 1), a2, vA, 1);
            PG8_WAIT_V(8); PG8_WAIT_L(0); PG8_BAR; PG8_MMA(0, 0, At, B0); PG8_MMA(0, 1, At, B1); PG8_BAR; PG8_SCHED;
            PG8_LDA(At, 1, 1); PG8_STAGEB(PG8_SB(1, 0), b3); PG8_STAGEB(PG8_SB(1, 1), b3 + hstep); PG8_STAGEA(PG8_SA(1, 0), a3, vA, 0);
            PG8_WAIT_V(8); PG8_WAIT_L(0); PG8_BAR; PG8_MMA(1, 0, At, B0); PG8_MMA(1, 1, At, B1); PG8_BAR; PG8_SCHED;
        }
        if (wr == 0) PG8_BAR;
        S.epi(acc, cur, wr, wc, fr, fq);
        if (!has_next) break;
#pragma unroll
        for (int a = 0; a < 2; ++a)
#pragma unroll
            for (int b = 0; b < 2; ++b)
#pragma unroll
                for (int m = 0; m < 4; ++m)
#pragma unroll
                    for (int n = 0; n < 2; ++n) acc[a][b][m][n] = (f32x4){0.f, 0.f, 0.f, 0.f};
        cur = nxt; cA = nA; cB = nB; ++ui;
        if (wr == 1) PG8_BAR;
    }
    PG8_WAIT_V(0);
    PG8_BAR;
#undef PG8_SA
#undef PG8_SB
#undef PG8_STAGE
#undef PG8_STAGEA
#undef PG8_STAGEB
#undef PG8_LDA
#undef PG8_LDB
#undef PG8_MMA
#undef PG8_WAIT_V
#undef PG8_WAIT_L
#undef PG8_BAR
#undef PG8_SCHED
}
}
using pg8::Unit;
constexpr size_t TSTEP1024 = (size_t)256 * 1024 * 2;
constexpr size_t TSTEP256 = (size_t)256 * 256 * 2;

struct ActC { float ca, cb, d1, d3, d0; };
__device__ __forceinline__ ActC act_gelu() { return ActC{1.f, 0.f, -1.4426950409f * 1.5957691216f, -1.4426950409f * 0.0713548163f, 0.f}; }
__device__ __forceinline__ ActC act_sigmoid() { return ActC{0.f, 1.f, -1.4426950409f, 0.f, 0.f}; }
__device__ __forceinline__ ActC act_linear(float s) { return ActC{s, 0.f, 0.f, 0.f, -1.4426950409f * 40.f}; }
__device__ __forceinline__ void store_tile_uni(const f32x4 (&acc)[2][2][4][2], bf16* O, int ldc, int row0, int col0, const ActC A, f32x2* stat, int statcol, int fq) {
#pragma unroll
    for (int ai = 0; ai < 2; ++ai)
#pragma unroll
        for (int m = 0; m < 4; ++m) {
            const int row = row0 + ai * 128 + m * 16;
            bf16* rowp = O + (size_t)row * ldc + col0;
            float s = 0.f, q = 0.f;
#pragma unroll
            for (int bj = 0; bj < 2; ++bj) {
                float v[8];
#pragma unroll
                for (int j = 0; j < 4; ++j) { v[j] = acc[ai][bj][m][0][j]; v[4 + j] = acc[ai][bj][m][1][j]; }
#pragma unroll
                for (int j = 0; j < 8; ++j) {
                    const float z = v[j];
                    const float e = __builtin_amdgcn_exp2f(z * (A.d1 + A.d3 * z * z) + A.d0);
                    v[j] = (A.ca * z + A.cb) * __builtin_amdgcn_rcpf(1.0f + e);
                    s += v[j]; q += v[j] * v[j];
                }
                u32x4 w; w.x = pg8::cvt_pk_bf16(v[0], v[1]); w.y = pg8::cvt_pk_bf16(v[2], v[3]); w.z = pg8::cvt_pk_bf16(v[4], v[5]); w.w = pg8::cvt_pk_bf16(v[6], v[7]);
                *(u32x4*)(rowp + bj * 128) = w;
            }
            if (stat) {
                s += __shfl_xor(s, 16); s += __shfl_xor(s, 32); q += __shfl_xor(q, 16); q += __shfl_xor(q, 32);
                if (fq == 0) stat[(size_t)row * 16 + statcol] = (f32x2){s, q};
            }
        }
}

struct ProbB {
    static constexpr bool PERM = true, GATHER = false;
    int K, G, c; unsigned char* ws; bf16* dout;
    __device__ __forceinline__ bool next(int i, Unit& u) const {
        const long L = (long)i * G + c; if (L >= 4096 + 128) return false;
        if (L < 4096) { pg8::tile_order((int)L, 128, 32, u.pm, u.pn); u.aux = 0; }
        else if (L < 4096 + 64) { const int l = (int)L - 4096; u.pm = l >> 2; u.pn = l & 3; u.aux = 1; }
        else { const int l = (int)L - 4160; u.pm = l >> 4; u.pn = l & 15; u.aux = 2; }
        return true;
    }
    __device__ __forceinline__ const char* abase(const Unit& u) const {
        const size_t o = u.aux == 0 ? WS_H0 + (size_t)u.pm * TSTEP1024 : u.aux == 1 ? WS_MEMB + (size_t)u.pm * TSTEP1024 : WS_WKV + (size_t)(4 + u.pm) * TSTEP1024;
        return (const char*)ws + o; }
    __device__ __forceinline__ const char* bbase(const Unit& u) const {
        const size_t o = u.aux == 0 ? WS_WIN + (size_t)u.pn * TSTEP1024 : u.aux == 1 ? WS_WKV + (size_t)u.pn * TSTEP1024 : WS_MEMB + (size_t)u.pn * TSTEP1024;
        return (const char*)ws + o; }
    __device__ __forceinline__ void gather(const Unit&, int, unsigned (&)[2][2], int, int) const {}
    __device__ __forceinline__ void epi(const f32x4 (&acc)[2][2][4][2], const Unit& u, int wr, int wc, int fr, int fq) const {
        const int row0 = u.pm * 256 + wr * 64 + fr;
        if (u.aux == 0) {
            const int reg = u.pn >> 2, col0 = (u.pn & 3) * 256 + wc * 32 + 8 * fq;
            const size_t off = reg == 0 ? WS_U : reg == 1 ? WS_GV : reg == 2 ? WS_LX : reg == 3 ? WS_LG : reg == 4 ? WS_Q : WS_G0;
            bf16* O = reg < 6 ? (bf16*)(ws + off) : reg == 6 ? dout : dout + (size_t)T * 1024;
            const ActC A = (reg == 0 || reg == 1 || reg == 3) ? act_gelu() : reg == 2 ? act_linear(1.f) : reg == 4 ? act_linear(0.0625f) : act_sigmoid();
            store_tile_uni(acc, O, 1024, row0, col0, A, reg == 1 ? (f32x2*)(ws + WS_VSTAT) : nullptr, (u.pn & 3) * 4 + wc, fq);
        } else {
            bf16* O = u.aux == 1 ? (bf16*)(ws + WS_KB) : (bf16*)(ws + WS_VT);
            store_tile_uni(acc, O, u.aux == 1 ? 1024 : 4096, row0, u.pn * 256 + wc * 32 + 8 * fq, act_linear(1.f), nullptr, 0, fq);
        }
    }
};

struct ProbD1 {
    static constexpr bool PERM = false, GATHER = false;
    int K, G, c; unsigned char* ws; bf16* dout;
    __device__ __forceinline__ bool next(int i, Unit& u) const {
        const long L = (long)(i / 3) * G + c; if (L >= 512) return false;
        pg8::tile_order((int)L, 128, 4, u.pm, u.pn); u.aux = i % 3; return true;
    }
    __device__ __forceinline__ const char* abase(const Unit& u) const { return (const char*)ws + (u.aux == 0 ? WS_U : u.aux == 1 ? WS_LG : WS_Q) + (size_t)u.pm * TSTEP1024; }
    __device__ __forceinline__ const char* bbase(const Unit& u) const { return (const char*)ws + WS_WBR + (size_t)u.aux * 2 * MiB + (size_t)u.pn * TSTEP1024; }
    __device__ __forceinline__ void gather(const Unit&, int, unsigned (&)[2][2], int, int) const {}
    __device__ __forceinline__ void epi(const f32x4 (&acc)[2][2][4][2], const Unit& u, int wr, int wc, int fr, int fq) const {
        const int row0 = u.pm * 256 + wr * 64 + fr, col0 = u.pn * 256 + wc * 32 + 4 * fq;
        const bf16* g = u.aux == 0 ? (const bf16*)(ws + WS_G0) : u.aux == 1 ? dout : dout + (size_t)T * 1024;
        float* P = (float*)(ws + WS_P); bf16* M = (bf16*)(ws + WS_H0);
        const int k = u.aux;
#pragma unroll
        for (int ai = 0; ai < 2; ++ai)
#pragma unroll
            for (int m = 0; m < 4; ++m) {
                const size_t off = (size_t)(row0 + ai * 128 + m * 16) * 1024 + col0;
#pragma unroll
                for (int bj = 0; bj < 2; ++bj)
#pragma unroll
                    for (int n = 0; n < 2; ++n) {
                        const size_t o = off + bj * 128 + n * 16;
                        const u32x2 gw = *(const u32x2*)(g + o);
                        f32x4 v = acc[ai][bj][m][n];
                        v[0] *= bflo(gw.x); v[1] *= bfhi(gw.x); v[2] *= bflo(gw.y); v[3] *= bfhi(gw.y);
                        if (k != 0) v += *(const f32x4*)(P + o);
                        if (k != 2) *(f32x4*)(P + o) = v;
                        else { u32x2 w; w.x = pg8::cvt_pk_bf16(v[0], v[1]); w.y = pg8::cvt_pk_bf16(v[2], v[3]); *(u32x2*)(M + o) = w; }
                    }
            }
    }
};

struct ProbD2 {
    static constexpr bool PERM = false, GATHER = false;
    int K, G, c; unsigned char* ws; float* out; const float *x, *gin, *bin;
    __device__ __forceinline__ bool next(int i, Unit& u) const {
        const long L = (long)i * G + c; if (L >= 512) return false;
        pg8::tile_order((int)L, 128, 4, u.pm, u.pn); u.aux = 0; return true;
    }
    __device__ __forceinline__ const char* abase(const Unit& u) const { return (const char*)ws + WS_H0 + (size_t)u.pm * TSTEP1024; }
    __device__ __forceinline__ const char* bbase(const Unit& u) const { return (const char*)ws + WS_WOUT + (size_t)u.pn * TSTEP1024; }
    __device__ __forceinline__ void gather(const Unit&, int, unsigned (&)[2][2], int, int) const {}
    __device__ __forceinline__ void epi(const f32x4 (&acc)[2][2][4][2], const Unit& u, int wr, int wc, int fr, int fq) const {
        const int row0 = u.pm * 256 + wr * 64 + fr, col0 = u.pn * 256 + wc * 32 + 4 * fq;
        const f32x2* xs = (const f32x2*)(ws + WS_XSTAT);
#pragma unroll
        for (int bj = 0; bj < 2; ++bj)
#pragma unroll
            for (int n = 0; n < 2; ++n) {
                const int col = col0 + bj * 128 + n * 16;
                const f32x4 gv = *(const f32x4*)(gin + col), bv = *(const f32x4*)(bin + col);
#pragma unroll
                for (int ai = 0; ai < 2; ++ai)
#pragma unroll
                    for (int m = 0; m < 4; ++m) {
                        const int row = row0 + ai * 128 + m * 16;
                        const f32x2 st = xs[row];
                        const size_t o = (size_t)row * 1024 + col;
                        const f32x4 xv = *(const f32x4*)(x + o);
                        const f32x4 h = (xv - st.x) * st.y * gv + bv;
                        *(f32x4*)(out + o) = DN_ALPHA * h + acc[ai][bj][m][n];
                    }
            }
    }
};

struct ProbE1 {
    static constexpr bool PERM = true, GATHER = true;
    int K, G, c; unsigned char* ws; int chunk, ntile;
    __device__ __forceinline__ bool next(int i, Unit& u) const {
        const long L = (long)i * G + c; if (L >= 2 * (ntile + SHT)) return false;
        const int l2 = (int)L >> 1; u.pm = l2 < ntile ? l2 : RTMAX + (l2 - ntile); u.pn = (int)L & 1;
        u.aux = ((const int*)(ws + WS_TILEE))[chunk * (RTMAX + SHT) + u.pm]; return true;
    }
    __device__ __forceinline__ const char* abase(const Unit&) const { return (const char*)ws + WS_H1; }
    __device__ __forceinline__ const char* bbase(const Unit& u) const { return (const char*)ws + WS_WGU + (size_t)(u.aux * 2 + u.pn) * TSTEP1024; }
    __device__ __forceinline__ void gather(const Unit& u, int R0, unsigned (&v)[2][2], int C0, int) const {
        const u32x4 o = *(const u32x4*)((const unsigned*)(ws + WS_ROWOFF) + (size_t)chunk * CROWS + u.pm * 256 + R0 * 4);
        const unsigned c2 = (unsigned)C0 * 2u;
        v[0][0] = o.x + c2; v[0][1] = o.y + c2; v[1][0] = o.z + c2; v[1][1] = o.w + c2;
    }
    __device__ __forceinline__ void gather_to_lds(const Unit& u, PG8_LAS unsigned char* dst, int t64) const {
        *(PG8_LAS u32x4*)(dst + t64 * 16) = *(const u32x4*)((const unsigned*)(ws + WS_ROWOFF) + (size_t)chunk * CROWS + u.pm * 256 + t64 * 4);
    }
    __device__ __forceinline__ void epi(const f32x4 (&acc)[2][2][4][2], const Unit& u, int wr, int wc, int fr, int fq) const {
        const int row0 = u.pm * 256 + wr * 64 + fr, col0 = u.pn * 128 + wc * 32 + 8 * fq;
        bf16* H = (bf16*)(ws + WS_HB);
#pragma unroll
        for (int ai = 0; ai < 2; ++ai)
#pragma unroll
            for (int m = 0; m < 4; ++m) {
                float v[8];
#pragma unroll
                for (int j = 0; j < 4; ++j) {
                    const float g0 = acc[ai][0][m][0][j], u0 = acc[ai][1][m][0][j], g1 = acc[ai][0][m][1][j], u1 = acc[ai][1][m][1][j];
                    v[j] = g0 * fast_sigmoid(g0) * u0; v[4 + j] = g1 * fast_sigmoid(g1) * u1;
                }
                u32x4 w; w.x = pg8::cvt_pk_bf16(v[0], v[1]); w.y = pg8::cvt_pk_bf16(v[2], v[3]); w.z = pg8::cvt_pk_bf16(v[4], v[5]); w.w = pg8::cvt_pk_bf16(v[6], v[7]);
                *(u32x4*)(H + (size_t)(row0 + ai * 128 + m * 16) * 256 + col0) = w;
            }
    }
};

struct ProbE2 {
    static constexpr bool PERM = true, GATHER = false;
    int K, G, c; unsigned char* ws; int chunk, ntile;
    __device__ __forceinline__ bool next(int i, Unit& u) const {
        const long L = (long)i * G + c; if (L >= 4 * (ntile + SHT)) return false;
        const int l4 = (int)L >> 2; u.pm = l4 < ntile ? l4 : RTMAX + (l4 - ntile); u.pn = (int)L & 3;
        u.aux = ((const int*)(ws + WS_TILEE))[chunk * (RTMAX + SHT) + u.pm]; return true;
    }
    __device__ __forceinline__ const char* abase(const Unit& u) const { return (const char*)ws + WS_HB + (size_t)u.pm * TSTEP256; }
    __device__ __forceinline__ const char* bbase(const Unit& u) const { return (const char*)ws + WS_WD + (size_t)(u.aux * 4 + u.pn) * TSTEP256; }
    __device__ __forceinline__ void gather(const Unit&, int, unsigned (&)[2][2], int, int) const {}
    __device__ __forceinline__ void epi(const f32x4 (&acc)[2][2][4][2], const Unit& u, int wr, int wc, int fr, int fq) const {
        const int row0 = u.pm * 256 + wr * 64 + fr, col0 = u.pn * 256 + wc * 32 + 8 * fq;
        bf16* Y = (bf16*)(ws + WS_Y); const float* rw = (const float*)(ws + WS_ROWW) + (size_t)chunk * CROWS;
#pragma unroll
        for (int ai = 0; ai < 2; ++ai)
#pragma unroll
            for (int m = 0; m < 4; ++m) {
                const int row = row0 + ai * 128 + m * 16; const float s = rw[row];
                bf16* rowp = Y + (size_t)row * 1024 + col0;
#pragma unroll
                for (int bj = 0; bj < 2; ++bj) {
                    const f32x4 a = acc[ai][bj][m][0] * s, b = acc[ai][bj][m][1] * s;
                    u32x4 w; w.x = pg8::cvt_pk_bf16(a[0], a[1]); w.y = pg8::cvt_pk_bf16(a[2], a[3]); w.z = pg8::cvt_pk_bf16(b[0], b[1]); w.w = pg8::cvt_pk_bf16(b[2], b[3]);
                    *(u32x4*)(rowp + bj * 128) = w;
                }
            }
    }
};
struct Args { const float* in[33]; float* out; unsigned char* ws; int ph_lo, ph_hi; };
static_assert(sizeof(Args) == 33 * 8 + 8 + 8 + 8, "Args has no padding");
struct Ctx {
    float* out; unsigned char* ws; LAS unsigned char* lds;
    int tid, lane, wave, G, bid, vcu;
};

__device__ __forceinline__ void transpose_item(const float* W, int ldw, bf16* WTn0, int ldt, LAS float* scr, int k0, int n0, int lane, bf16* WTlo  ) {
#pragma unroll 8
    for (int i = 0; i < 32; ++i) { const int kk = 2 * i + (lane >> 5); scr[kk * 33 + (lane & 31)] = W[(size_t)(k0 + kk) * ldw + n0 + (lane & 31)]; }
    LDS_WAIT(); asm volatile("" ::: "memory");
    const int c = lane & 7;
#pragma unroll
    for (int j = 0; j < 4; ++j) { const int n = (lane >> 3) + 8 * j; const LAS float* s = scr + (8 * c) * 33 + n;
        float f[8];
#pragma unroll
        for (int q = 0; q < 8; ++q) f[q] = s[q * 33];
        u32x4 o; o.x = pk2(f[0], f[1]); o.y = pk2(f[2], f[3]); o.z = pk2(f[4], f[5]); o.w = pk2(f[6], f[7]);
        *(u32x4*)(WTn0 + (size_t)n * ldt + k0 + 8 * c) = o;
        if (WTlo) {
#pragma unroll
            for (int q = 0; q < 8; ++q) f[q] -= bf2f(f2bf(f[q]));
            u32x4 p; p.x = pk2(f[0], f[1]); p.y = pk2(f[2], f[3]); p.z = pk2(f[4], f[5]); p.w = pk2(f[6], f[7]);
            *(u32x4*)(WTlo + (size_t)n * ldt + k0 + 8 * c) = p;
        } }
    LDS_WAIT(); asm volatile("" ::: "memory");
}

__device__ __forceinline__ void phase_p0(Ctx& X, const Args& A) {
    LAS float* scr = (LAS float*)(X.lds + X.wave * 16384);
    const int gw = X.vcu * 8 + X.wave, NGW = X.G * 8;
    unsigned char* ws = X.ws;
    constexpr int I_IN = 16 * 256, I_KV = 16 * 64, I_LR = 64, I_RT = 32;
    constexpr int NIT = I_IN + I_KV + 2 * I_LR + I_RT;
    for (int it = gw; it < NIT; it += NGW) {
        int r = it;
        if (r < I_IN) { const int kb = r >> 8, nb = r & 255; transpose_item(A.in[4], INC, (bf16*)(ws + WS_WIN) + (size_t)(32 * nb) * 1024, 1024, scr, 64 * kb, 32 * nb, X.lane, nullptr); continue; } r -= I_IN;
        if (r < I_KV) { const int kb = r >> 6, nb = r & 63; transpose_item(A.in[16], 2048, (bf16*)(ws + WS_WKV) + (size_t)(32 * nb) * 1024, 1024, scr, 64 * kb, 32 * nb, X.lane, nullptr); continue; } r -= I_KV;
        if (r < 2 * I_LR) { const int which = r >= I_LR; if (which) r -= I_LR; const int g = r >> 3, kb = (r >> 2) & 1, nb = r & 3;
            transpose_item(A.in[which ? 13 : 11] + g * 16384, 128, (bf16*)(ws + (which ? WS_WI : WS_WA)) + g * 16384 + (32 * nb) * 128, 128, scr, 64 * kb, 32 * nb, X.lane, nullptr); continue; } r -= 2 * I_LR;
        { const int kb = r >> 1, nb = r & 1; transpose_item(A.in[23], 64, (bf16*)(ws + WS_WR) + (size_t)(32 * nb) * 1024, 1024, scr, 64 * kb, 32 * nb, X.lane, (bf16*)(ws + WS_WR) + 65536 + (size_t)(32 * nb) * 1024); }
    }
    for (int i = X.bid * 512 + X.tid; i < 8 * 128 * 128; i += X.G * 512) { const int t = (i >> 7) & 127, s = i & 127; ((bf16*)(ws + WS_WSP))[i] = (bf16)(s <= t ? f2bf(A.in[7][i]) : 0u); }
    {
        const f32x4* gp = (const f32x4*)A.in[2] + X.lane; const f32x4* bp = (const f32x4*)A.in[3] + X.lane;
        f32x4 gg[4], bb[4];
#pragma unroll
        for (int j = 0; j < 4; ++j) { gg[j] = gp[64 * j]; bb[j] = bp[64 * j]; }
        for (int m = gw; m < T; m += NGW) {
            const f32x4* xr = (const f32x4*)(A.in[0] + (size_t)m * D) + X.lane;
            f32x4 v[4]; float s = 0.f;
#pragma unroll
            for (int j = 0; j < 4; ++j) { v[j] = xr[64 * j]; s += (v[j].x + v[j].y) + (v[j].z + v[j].w); }
            const float mean = wave_sum(s) * (1.f / D); float s2 = 0.f;
#pragma unroll
            for (int j = 0; j < 4; ++j) { v[j] = v[j] - mean; s2 += (v[j].x * v[j].x + v[j].y * v[j].y) + (v[j].z * v[j].z + v[j].w * v[j].w); }
            const float rstd = 1.f / sqrtf(wave_sum(s2) * (1.f / D) + LN_EPS);
            if (X.lane == 0) ((f32x2*)(ws + WS_XSTAT))[m] = (f32x2){mean, rstd};
            u32x2* o8 = (u32x2*)((bf16*)(ws + WS_H0) + (size_t)m * D) + X.lane;
#pragma unroll
            for (int j = 0; j < 4; ++j) { const f32x4 h = v[j] * rstd * gg[j] + bb[j]; o8[64 * j] = (u32x2){pk2(h.x, h.y), pk2(h.z, h.w)}; }
        }
    }
    for (int m = gw; m < TM; m += NGW) {
        const f32x4* xr = (const f32x4*)(A.in[1] + (size_t)m * D) + X.lane; u32x2* o8 = (u32x2*)((bf16*)(ws + WS_MEMB) + (size_t)m * D) + X.lane;
#pragma unroll
        for (int j = 0; j < 4; ++j) { const f32x4 h = xr[64 * j]; o8[64 * j] = (u32x2){pk2(h.x, h.y), pk2(h.z, h.w)}; }
    }
}

__device__ __forceinline__ void conv_wbr(Ctx& X, const Args& A) {
    LAS float* scr = (LAS float*)(X.lds + X.wave * 16384);
    const int gw = X.vcu * 8 + X.wave, NGW = X.G * 8;
    for (int it = gw; it < 4 * 512; it += NGW) { const int which = it >> 9, r = it & 511, kb = r >> 5, nb = r & 31;
        transpose_item(A.in[17 + which], 1024, (bf16*)(X.ws + WS_WBR) + (size_t)which * 1048576 + (size_t)(32 * nb) * 1024, 1024, scr, 64 * kb, 32 * nb, X.lane, nullptr); }
}
__device__ __forceinline__ void conv_experts(Ctx& X, const Args& A) {
    LAS float* scr = (LAS float*)(X.lds + X.wave * 16384);
    const int gw = X.vcu * 8 + X.wave, NGW = X.G * 8;
    for (int it = gw; it < 65 * 384; it += NGW) {
        const int e = it / 384, r = it % 384, which = r >> 7, q = r & 127;
        if (which < 2) { const int kb = q >> 3, nb = q & 7, n0 = 32 * nb;
            const float* W = e < 64 ? A.in[25 + which] + (size_t)e * 1024 * 256 : A.in[28 + which];
            bf16* dst = (bf16*)(X.ws + WS_WGU) + ((size_t)(e * 2 + (n0 >> 7)) * 256 + which * 128 + (n0 & 127)) * 1024;
            transpose_item(W, 256, dst, 1024, scr, 64 * kb, n0, X.lane, nullptr);
        } else { const int kb = q >> 5, nb = q & 31;
            const float* W = e < 64 ? A.in[27] + (size_t)e * 256 * 1024 : A.in[30];
            transpose_item(W, 1024, (bf16*)(X.ws + WS_WD) + ((size_t)e * 1024 + 32 * nb) * 256, 256, scr, 64 * kb, 32 * nb, X.lane, nullptr); }
    }
}

__device__ __forceinline__ int swz(int r, int ch, int rowbytes) { return r * rowbytes + (((ch & ~15) | ((ch ^ r) & 15)) << 4); }

__device__ __forceinline__ void gmlp_unit(Ctx& X, const Args& A, int unit) {
    const int bn = unit >> 3, g = unit & 7, t0 = bn * 128, c0 = g * 128;
    unsigned char* ws = X.ws; LAS unsigned char* lds = X.lds;
    LAS f32x2* st = (LAS f32x2*)(lds + 32768);
    if (X.tid < 128) {
        const f32x2* vs = (const f32x2*)(ws + WS_VSTAT) + (size_t)(t0 + X.tid) * 16; float s = 0.f, q = 0.f;
#pragma unroll
        for (int p = 0; p < 16; ++p) { const f32x2 v = vs[p]; s += v.x; q += v.y; }
        const float mean = s * (1.f / 1024.f), var = q * (1.f / 1024.f) - mean * mean;
        st[X.tid] = (f32x2){mean, 1.f / sqrtf(var + LN_EPS)};
    }
    __syncthreads();
    {
        const int ch = X.tid & 15; const float* ng = A.in[5] + c0 + ch * 8; const float* nb = A.in[6] + c0 + ch * 8;
        float gg[8], bb[8];
#pragma unroll
        for (int j = 0; j < 8; ++j) { gg[j] = ng[j]; bb[j] = nb[j]; }
#pragma unroll
        for (int i = 0; i < 4; ++i) {
            const int s = (X.tid + 512 * i) >> 4;
            const u32x4 w = *(const u32x4*)((const bf16*)(ws + WS_GV) + (size_t)(t0 + s) * 1024 + c0 + ch * 8);
            const f32x2 ms = st[s];
            float v[8] = {bflo(w.x), bfhi(w.x), bflo(w.y), bfhi(w.y), bflo(w.z), bfhi(w.z), bflo(w.w), bfhi(w.w)};
#pragma unroll
            for (int j = 0; j < 8; ++j) { const int c = ch * 8 + j; const float y = (v[j] - ms.x) * ms.y * gg[j] + bb[j];
                *(LAS bf16*)(lds + swz(c, s >> 3, 256) + (s & 7) * 2) = (bf16)f2bf(y); }
        }
    }
    __syncthreads();
    {
        const int w = X.wave, l = X.lane, fr = l & 15, fq = l >> 4;
        f32x4 acc[8];
#pragma unroll
        for (int cb = 0; cb < 8; ++cb) acc[cb] = (f32x4){0.f, 0.f, 0.f, 0.f};
        const bf16* Wg = (const bf16*)(ws + WS_WSP) + g * 16384 + (16 * w + fr) * 128 + 8 * fq;
        const int kmax = w >> 1;
        for (int kk = 0; kk <= kmax; ++kk) {
            const bf16x8 bfr = *(const bf16x8*)(Wg + 32 * kk);
#pragma unroll
            for (int cb = 0; cb < 8; ++cb) {
                const bf16x8 afr = *(const LAS bf16x8*)(lds + swz(16 * cb + fr, 4 * kk + fq, 256));
                acc[cb] = __builtin_amdgcn_mfma_f32_16x16x32_bf16(afr, bfr, acc[cb], 0, 0, 0);
            }
        }
        const int t = 16 * w + fr; const float bs = A.in[8][g * 128 + t];
        bf16* up = (bf16*)(ws + WS_U) + (size_t)(t0 + t) * 1024 + c0 + 4 * fq;
#pragma unroll
        for (int cb = 0; cb < 8; ++cb) {
            const u32x2 uw = *(const u32x2*)(up + 16 * cb);
            const float y0 = bflo(uw.x) * (acc[cb][0] + bs), y1 = bfhi(uw.x) * (acc[cb][1] + bs), y2 = bflo(uw.y) * (acc[cb][2] + bs), y3 = bfhi(uw.y) * (acc[cb][3] + bs);
            *(u32x2*)(up + 16 * cb) = (u32x2){pk2(y0, y1), pk2(y2, y3)};
        }
    }
    __syncthreads();
}

__device__ __forceinline__ void lru_unit(Ctx& X, const Args& A, int unit) {
    const int b = unit >> 4, g = (unit >> 1) & 7, half = unit & 1, c0 = g * 128, oc0 = c0 + half * 64;
    unsigned char* ws = X.ws; LAS unsigned char* lds = X.lds;
    constexpr int O_XC = 0, O_A = 32768, O_B = 65536, O_RAW = 98304, O_SA = 132096, O_SB = 134144, O_CY = 136192;
    LAS float* La = (LAS float*)(lds + O_A); LAS float* Lb = (LAS float*)(lds + O_B);
    LAS float* SA = (LAS float*)(lds + O_SA); LAS float* SB = (LAS float*)(lds + O_SB); LAS float* CY = (LAS float*)(lds + O_CY);
    const int w = X.wave, l = X.lane, fr = l & 15, fq = l >> 4, ob = w & 3, th = w >> 2;
    const int cch = X.tid & 15;
    const bf16* wpa = (const bf16*)(ws + WS_WA) + g * 16384 + (half * 64 + 16 * ob + fr) * 128 + 8 * fq; const bf16* wpi = (const bf16*)(ws + WS_WI) + g * 16384 + (half * 64 + 16 * ob + fr) * 128 + 8 * fq;
    const int och = oc0 + 16 * ob + fr;
    const float ba = A.in[12][och], bi = A.in[14][och];
    const float lam = A.in[15][och];
    const float sp8 = 8.0f * (lam > 15.f ? __expf(-lam) : log1pf(__expf(-lam)));
    if (X.tid < 64) CY[X.tid] = 0.f;
#pragma unroll 1
    for (int n = 0; n < 16; ++n) {
        const int t0 = b * SEQ + n * 128;
#pragma unroll 1
        for (int i = 0; i < 5; ++i) { const int q = X.tid + 512 * i; if (q < 131 * 16) { const int row = q >> 4, ch = q & 15;
            u32x4 v = (u32x4){0u, 0u, 0u, 0u};
            if (n > 0 || row >= 3) v = *(const u32x4*)((const bf16*)(ws + WS_LX) + (size_t)(t0 - 3 + row) * 1024 + c0 + ch * 8);
            *(LAS u32x4*)(lds + O_RAW + row * 256 + ch * 16) = v; } }
        __syncthreads();
        {
            float a[4][8];
            { const f32x4* cbp = (const f32x4*)(A.in[10] + c0 + cch * 8); const f32x4 b0 = cbp[0], b1 = cbp[1];
#pragma unroll
              for (int i = 0; i < 4; ++i) { a[i][0] = b0.x; a[i][1] = b0.y; a[i][2] = b0.z; a[i][3] = b0.w; a[i][4] = b1.x; a[i][5] = b1.y; a[i][6] = b1.z; a[i][7] = b1.w; } }
#pragma unroll
            for (int k = 0; k < 4; ++k) { const f32x4* cwp = (const f32x4*)(A.in[9] + k * 1024 + c0 + cch * 8); const f32x4 w0 = cwp[0], w1 = cwp[1];
                const float cw[8] = {w0.x, w0.y, w0.z, w0.w, w1.x, w1.y, w1.z, w1.w};
#pragma unroll
                for (int i = 0; i < 4; ++i) { const int t = (X.tid + 512 * i) >> 4;
                    const u32x4 v = *(const LAS u32x4*)(lds + O_RAW + (t + 3 - k) * 256 + cch * 16);
                    const float xv[8] = {bflo(v.x), bfhi(v.x), bflo(v.y), bfhi(v.y), bflo(v.z), bfhi(v.z), bflo(v.w), bfhi(v.w)};
#pragma unroll
                    for (int j = 0; j < 8; ++j) a[i][j] += cw[j] * xv[j]; } }
#pragma unroll
            for (int i = 0; i < 4; ++i) { const int t = (X.tid + 512 * i) >> 4;
                *(LAS u32x4*)(lds + O_XC + swz(t, cch, 256)) = (u32x4){pk2(a[i][0], a[i][1]), pk2(a[i][2], a[i][3]), pk2(a[i][4], a[i][5]), pk2(a[i][6], a[i][7])}; }
        }
        __syncthreads();
        {
            bf16x8 wa[4], wi[4];
#pragma unroll
            for (int kk = 0; kk < 4; ++kk) { wa[kk] = *(const bf16x8*)(wpa + 32 * kk); wi[kk] = *(const bf16x8*)(wpi + 32 * kk); }
            const int cx = half * 64 + 16 * ob + fr;
#pragma unroll 1
            for (int tb = 0; tb < 4; ++tb) {
                f32x4 pa = (f32x4){0.f, 0.f, 0.f, 0.f}, pi = (f32x4){0.f, 0.f, 0.f, 0.f};
#pragma unroll
                for (int kk = 0; kk < 4; ++kk) { const bf16x8 xa = *(const LAS bf16x8*)(lds + O_XC + swz(64 * th + 16 * tb + fr, 4 * kk + fq, 256));
                    pa = __builtin_amdgcn_mfma_f32_16x16x32_bf16(xa, wa[kk], pa, 0, 0, 0); pi = __builtin_amdgcn_mfma_f32_16x16x32_bf16(xa, wi[kk], pi, 0, 0, 0); }
#pragma unroll
                for (int r = 0; r < 4; ++r) { const int t = 64 * th + 16 * tb + 4 * fq + r;
                    const float ra = fast_sigmoid(pa[r] + ba), ri = fast_sigmoid(pi[r] + bi);
                    const float la = -ra * sp8; const float a = __expf(la); const float x2 = 2.f * la;
                    const float em = x2 > -0.25f ? -x2 * (1.f + x2 * (0.5f + x2 * (0.16666667f + x2 * (0.041666668f + x2 * 0.0083333338f)))) : 1.f - __expf(x2);
                    const float mult = sqrtf(em);
                    const float xc = bf2f(*(const LAS bf16*)(lds + O_XC + swz(t, cx >> 3, 256) + (cx & 7) * 2));
                    La[t * 64 + 16 * ob + fr] = a; Lb[t * 64 + 16 * ob + fr] = mult * ri * xc; }
            }
        }
        __syncthreads();
        const int o = X.tid & 63, sg = X.tid >> 6;
        { float A = 1.f, Bc = 0.f;
#pragma unroll 4
            for (int j = 0; j < 16; ++j) { const float a = La[(16 * sg + j) * 64 + o], bt = Lb[(16 * sg + j) * 64 + o]; A *= a; Bc = a * Bc + bt; }
            SA[sg * 64 + o] = A; SB[sg * 64 + o] = Bc; }
        __syncthreads();
        float h = CY[o];
        for (int s2 = 0; s2 < sg; ++s2) h = SA[s2 * 64 + o] * h + SB[s2 * 64 + o];
        { bf16* yp = (bf16*)(ws + WS_LG) + (size_t)(t0 + 16 * sg) * 1024 + oc0 + o;
#pragma unroll 4
            for (int j = 0; j < 16; ++j) { const float a = La[(16 * sg + j) * 64 + o], bt = Lb[(16 * sg + j) * 64 + o]; h = a * h + bt;
                const float gt = bf2f(yp[(size_t)j * 1024]); yp[(size_t)j * 1024] = (bf16)f2bf(h * gt); } }
        __syncthreads();
        if (sg == 7) CY[o] = h;
    }
    __syncthreads();
}

__device__ __forceinline__ void attn_unit(Ctx& X, const Args& A, int unit) {
    const int b = unit >> 6, h = (unit >> 4) & 3, qt = unit & 15, t0 = b * SEQ + qt * 128;
    unsigned char* ws = X.ws; LAS unsigned char* lds = X.lds;
    const int w = X.wave, l = X.lane, fr = l & 15, fq = l >> 4;
    bf16* qrow = (bf16*)(ws + WS_Q) + (size_t)(t0 + 16 * w + fr) * 1024 + h * 256;
    bf16x8 qf[8];
#pragma unroll
    for (int kk = 0; kk < 8; ++kk) qf[kk] = *(const bf16x8*)(qrow + 32 * kk + 8 * fq);
#pragma unroll
    for (int i = 0; i < 16; ++i) { const int q = X.tid + 512 * i, rho = q >> 5, ch = q & 31;
        const int key = 32 * (rho >> 5) + 8 * ((rho >> 2) & 3) + 4 * ((rho >> 4) & 1) + (rho & 3);
        *(LAS u32x4*)(lds + swz(rho, ch, 512)) = *(const u32x4*)((const bf16*)(ws + WS_KB) + (size_t)(b * 256 + key) * 1024 + h * 256 + ch * 8); }
    __syncthreads();
    f32x4 s[16];
#pragma unroll
    for (int blk = 0; blk < 16; ++blk) { s[blk] = (f32x4){0.f, 0.f, 0.f, 0.f};
#pragma unroll
        for (int kk = 0; kk < 8; ++kk) { const bf16x8 kf = *(const LAS bf16x8*)(lds + swz(16 * blk + fr, 4 * kk + fq, 512));
            s[blk] = __builtin_amdgcn_mfma_f32_16x16x32_bf16(kf, qf[kk], s[blk], 0, 0, 0); } }
    float mx = -3.0e38f;
#pragma unroll
    for (int blk = 0; blk < 16; ++blk) mx = fmaxf(fmaxf(fmaxf(s[blk][0], s[blk][1]), fmaxf(s[blk][2], s[blk][3])), mx);
    mx = fmaxf(mx, __shfl_xor(mx, 16)); mx = fmaxf(mx, __shfl_xor(mx, 32));
    float sum = 0.f;
#pragma unroll
    for (int blk = 0; blk < 16; ++blk)
#pragma unroll
        for (int r = 0; r < 4; ++r) { const float p = __builtin_amdgcn_exp2f((s[blk][r] - mx) * 1.4426950408889634f); s[blk][r] = p; sum += p; }
    sum += __shfl_xor(sum, 16); sum += __shfl_xor(sum, 32);
    const float inv = 1.0f / sum;
    bf16x8 pf[8];
#pragma unroll
    for (int kk = 0; kk < 8; ++kk) { u32x4 pw; pw.x = pk2(s[2 * kk][0], s[2 * kk][1]); pw.y = pk2(s[2 * kk][2], s[2 * kk][3]); pw.z = pk2(s[2 * kk + 1][0], s[2 * kk + 1][1]); pw.w = pk2(s[2 * kk + 1][2], s[2 * kk + 1][3]);
        pf[kk] = __builtin_bit_cast(bf16x8, pw); }
    __syncthreads();
#pragma unroll
    for (int i = 0; i < 16; ++i) { const int q = X.tid + 512 * i, d = q >> 5, ch = q & 31;
        *(LAS u32x4*)(lds + swz(d, ch, 512)) = *(const u32x4*)((const bf16*)(ws + WS_VT) + (size_t)(h * 256 + d) * 4096 + b * 256 + ch * 8); }
    __syncthreads();
#pragma unroll
    for (int db = 0; db < 16; ++db) { f32x4 o = (f32x4){0.f, 0.f, 0.f, 0.f};
#pragma unroll
        for (int kk = 0; kk < 8; ++kk) { const bf16x8 vf = *(const LAS bf16x8*)(lds + swz(16 * db + fr, 4 * kk + fq, 512));
            o = __builtin_amdgcn_mfma_f32_16x16x32_bf16(vf, pf[kk], o, 0, 0, 0); }
        *(u32x2*)(qrow + 16 * db + 4 * fq) = (u32x2){pk2(o[0] * inv, o[1] * inv), pk2(o[2] * inv, o[3] * inv)}; }
    __syncthreads();
}

__device__ __forceinline__ void route_block(Ctx& X, const Args& A, int blk) {
    unsigned char* ws = X.ws; LAS unsigned char* lds = X.lds;
    LAS float* LG = (LAS float*)lds;
    LAS float* LS = (LAS float*)(lds + 33280);
    LAS int* CN = (LAS int*)(lds + 66560);
    LAS float* RB = (LAS float*)(lds + 67072);
    const int w = X.wave, l = X.lane, fr = l & 15, fq = l >> 4;
    if (X.tid < 64) RB[X.tid] = A.in[24][X.tid];
    {
        const f32x4* gp = (const f32x4*)A.in[21] + l; const f32x4* bp = (const f32x4*)A.in[22] + l;
        f32x4 gg[4], bb[4];
#pragma unroll
        for (int j = 0; j < 4; ++j) { gg[j] = gp[64 * j]; bb[j] = bp[64 * j]; }
        for (int rr = 0; rr < 16; ++rr) {
            const int m = blk * 128 + 16 * w + rr;
            const f32x4* xr = (const f32x4*)(X.out + (size_t)m * D) + l;
            f32x4 v[4]; float s = 0.f;
#pragma unroll
            for (int j = 0; j < 4; ++j) { v[j] = xr[64 * j]; s += (v[j].x + v[j].y) + (v[j].z + v[j].w); }
            const float mean = wave_sum(s) * (1.f / D); float s2 = 0.f;
#pragma unroll
            for (int j = 0; j < 4; ++j) { v[j] = v[j] - mean; s2 += (v[j].x * v[j].x + v[j].y * v[j].y) + (v[j].z * v[j].z + v[j].w * v[j].w); }
            const float rstd = 1.f / sqrtf(wave_sum(s2) * (1.f / D) + LN_EPS);
            u32x2* oh = (u32x2*)((bf16*)(ws + WS_H1) + (size_t)m * D) + l; u32x2* ol = (u32x2*)((bf16*)(ws + WS_H1LO) + (size_t)m * D) + l;
#pragma unroll
            for (int j = 0; j < 4; ++j) { const f32x4 hv = v[j] * rstd * gg[j] + bb[j];
                const unsigned h0 = f2bf(hv.x), h1 = f2bf(hv.y), h2 = f2bf(hv.z), h3 = f2bf(hv.w);
                oh[64 * j] = (u32x2){h0 | (h1 << 16), h2 | (h3 << 16)};
                ol[64 * j] = (u32x2){pk2(hv.x - bf2f(h0), hv.y - bf2f(h1)), pk2(hv.z - bf2f(h2), hv.w - bf2f(h3))}; }
        }
    }
    VM_WAIT(); __syncthreads();
    {
        f32x4 acc[4];
#pragma unroll
        for (int n = 0; n < 4; ++n) acc[n] = (f32x4){0.f, 0.f, 0.f, 0.f};
        const bf16* ah = (const bf16*)(ws + WS_H1) + (size_t)(blk * 128 + 16 * w + fr) * D + 8 * fq; const bf16* al = (const bf16*)(ws + WS_H1LO) + (size_t)(blk * 128 + 16 * w + fr) * D + 8 * fq;
        const bf16* bh = (const bf16*)(ws + WS_WR) + (size_t)fr * 1024 + 8 * fq;
        for (int kk = 0; kk < 32; ++kk) {
            const bf16x8 xh = *(const bf16x8*)(ah + 32 * kk), xl = *(const bf16x8*)(al + 32 * kk);
#pragma unroll
            for (int n = 0; n < 4; ++n) { const bf16x8 wh = *(const bf16x8*)(bh + (size_t)n * 16384 + 32 * kk), wl = *(const bf16x8*)(bh + 65536 + (size_t)n * 16384 + 32 * kk);
                acc[n] = __builtin_amdgcn_mfma_f32_16x16x32_bf16(xh, wh, acc[n], 0, 0, 0);
                acc[n] = __builtin_amdgcn_mfma_f32_16x16x32_bf16(xh, wl, acc[n], 0, 0, 0);
                acc[n] = __builtin_amdgcn_mfma_f32_16x16x32_bf16(xl, wh, acc[n], 0, 0, 0); }
        }
#pragma unroll
        for (int n = 0; n < 4; ++n)
#pragma unroll
            for (int r = 0; r < 4; ++r) { const int e = 16 * n + fr; const float sg = 1.0f / (1.0f + __expf(-acc[n][r]));
                LS[(16 * w + 4 * fq + r) * 65 + e] = sg; LG[(16 * w + 4 * fq + r) * 65 + e] = sg + RB[e]; }
    }
    __syncthreads();
    int idx[8], rk[8]; float wt[8]; unsigned long long sel = 0ull;
    const int tok = blk * 128 + X.tid;
    if (X.tid < 128) {
        const LAS float* ch = LG + X.tid * 65; const LAS float* sc = LS + X.tid * 65;
        float gs[8];
#pragma unroll
        for (int g = 0; g < 8; ++g) { float m1 = -3.0e38f, m2 = -3.0e38f;
#pragma unroll
            for (int j = 0; j < 8; ++j) { const float v = ch[g * 8 + j]; if (v > m1) { m2 = m1; m1 = v; } else if (v > m2) m2 = v; }
            gs[g] = m1 + m2; }
        unsigned gmask = 0u;
#pragma unroll
        for (int it = 0; it < 4; ++it) { float best = -3.0e38f; int bi = 0;
#pragma unroll
            for (int g = 0; g < 8; ++g) { const bool ok = !((gmask >> g) & 1u) && gs[g] > best; best = ok ? gs[g] : best; bi = ok ? g : bi; }
            gmask |= 1u << bi; }
        float wsum = 0.f;
#pragma unroll
        for (int k = 0; k < 8; ++k) { float best = -3.0e38f; int be = 0;
            for (int e = 0; e < 64; ++e) { const float v = ch[e]; const bool ok = ((gmask >> (e >> 3)) & 1u) && !((sel >> e) & 1ull) && v > best; best = ok ? v : best; be = ok ? e : be; }
            sel |= 1ull << be; idx[k] = be; wt[k] = sc[be]; wsum += wt[k]; }
        const float sc2 = ROUTED_SCALE / wsum;
#pragma unroll
        for (int k = 0; k < 8; ++k) { wt[k] *= sc2; rk[k] = 0; }
        for (int e = 0; e < 64; ++e) { const bool has = (sel >> e) & 1ull; const unsigned long long bal = __ballot(has);
            const int myr = __popcll(bal & ((1ull << l) - 1ull));
#pragma unroll
            for (int k = 0; k < 8; ++k) rk[k] = (has && idx[k] == e) ? myr : rk[k];
            if (l == 0) CN[w * 64 + e] = __popcll(bal); }
    }
    __syncthreads();
    if (X.tid < 128) {
        if (w == 1) {
#pragma unroll
            for (int k = 0; k < 8; ++k) rk[k] += CN[idx[k]]; }
        int* ip = (int*)(ws + WS_IDX) + (size_t)tok * 8; float* wp = (float*)(ws + WS_WTS) + (size_t)tok * 8; int* rp = (int*)(ws + WS_RK) + (size_t)tok * 8;
#pragma unroll
        for (int k = 0; k < 8; ++k) { ip[k] = idx[k]; wp[k] = wt[k]; rp[k] = rk[k]; }
        if (X.tid < 64) ((int*)(ws + WS_HIST))[blk * 64 + X.tid] = CN[X.tid] + CN[64 + X.tid];
    }
    __syncthreads();
}

__device__ __forceinline__ void place_block(Ctx& X, const Args& A, int blk) {
    unsigned char* ws = X.ws; LAS unsigned char* lds = X.lds;
    LAS int* CNT = (LAS int*)lds; LAS int* PAD = CNT + 64; LAS int* BEF = CNT + 128; LAS int* PST = CNT + 192;
    const int chn = blk >> 6, jj = blk & 63;
    if (X.tid < 64) { const int* hp = (const int*)(ws + WS_HIST) + (size_t)(chn * 64) * 64 + X.tid; int cnt = 0, bef = 0;
        for (int j = 0; j < 64; ++j) { const int v = hp[j * 64]; cnt += v; bef += (j < jj) ? v : 0; }
        CNT[X.tid] = cnt; PAD[X.tid] = (cnt + 255) & ~255; BEF[X.tid] = bef; }
    __syncthreads();
    if (X.tid == 0) { int ps = 0; for (int e = 0; e < 64; ++e) { PST[e] = ps; ps += PAD[e]; } PST[64] = ps; }
    __syncthreads();
    unsigned* rowoff = (unsigned*)(ws + WS_ROWOFF) + (size_t)chn * CROWS; float* roww = (float*)(ws + WS_ROWW) + (size_t)chn * CROWS;
#define ROWOFF_IDX(d) ((((d) >> 8) << 8) + (((d) & 63) << 2) + (((d) >> 6) & 3))
    if (X.tid < 128) { const int tok = blk * 128 + X.tid;
        const int* ip = (const int*)(ws + WS_IDX) + (size_t)tok * 8; const float* wp = (const float*)(ws + WS_WTS) + (size_t)tok * 8; const int* rp = (const int*)(ws + WS_RK) + (size_t)tok * 8;
        int* pp = (int*)(ws + WS_POS) + (size_t)tok * 8;
#pragma unroll
        for (int k = 0; k < 8; ++k) { const int e = ip[k]; const int dest = PST[e] + BEF[e] + rp[k]; rowoff[ROWOFF_IDX(dest)] = (unsigned)tok * 2048u; roww[dest] = wp[k]; pp[k] = dest; } }
    if (jj == 0) {
        for (int e = 0; e < 64; ++e) { const int st = PST[e] + CNT[e], en = PST[e] + PAD[e]; if (st + X.tid < en) { const int d = st + X.tid; rowoff[ROWOFF_IDX(d)] = (unsigned)(chn * CT) * 2048u; roww[d] = 0.f; } }
        int* te = (int*)(ws + WS_TILEE) + chn * (RTMAX + SHT);
        if (X.tid < 64) { for (int tl = PST[X.tid] >> 8; tl < (PST[X.tid] + PAD[X.tid]) >> 8; ++tl) te[tl] = X.tid; }
        if (X.tid < SHT) te[RTMAX + X.tid] = 64;
        if (X.tid == 0) ((int*)(ws + WS_NTILE))[chn] = PST[64] >> 8;
        for (int i = X.tid; i < CT; i += 512) { const int d = RTMAX * 256 + i; rowoff[ROWOFF_IDX(d)] = (unsigned)(chn * CT + i) * 2048u; roww[d] = 1.0f; }
    }
    __syncthreads();
}

__device__ __forceinline__ void combine_rows(Ctx& X, const Args& A, int chn) {
    unsigned char* ws = X.ws; int l_ = X.lane; asm volatile("" : "+v"(l_)); const int l = l_; const int gw = X.vcu * 8 + X.wave, NGW = X.G * 8;
    f32x4 g1[4], b1[4], g2[4], b2[4];
#pragma unroll
    for (int j = 0; j < 4; ++j) { g1[j] = ((const f32x4*)A.in[21] + l)[64 * j]; b1[j] = ((const f32x4*)A.in[22] + l)[64 * j]; g2[j] = ((const f32x4*)A.in[31] + l)[64 * j]; b2[j] = ((const f32x4*)A.in[32] + l)[64 * j]; }
    const bf16* Y = (const bf16*)(ws + WS_Y);
    for (int r = gw; r < CT; r += NGW) {
        const int m = chn * CT + r;
        f32x4* xr = (f32x4*)(X.out + (size_t)m * D) + l;
        f32x4 v[4]; float s = 0.f;
#pragma unroll
        for (int j = 0; j < 4; ++j) { v[j] = xr[64 * j]; s += (v[j].x + v[j].y) + (v[j].z + v[j].w); }
        float mean = wave_sum(s) * (1.f / D); float s2 = 0.f;
#pragma unroll
        for (int j = 0; j < 4; ++j) { v[j] = v[j] - mean; s2 += (v[j].x * v[j].x + v[j].y * v[j].y) + (v[j].z * v[j].z + v[j].w * v[j].w); }
        float rstd = 1.f / sqrtf(wave_sum(s2) * (1.f / D) + LN_EPS);
#pragma unroll
        for (int j = 0; j < 4; ++j) v[j] = DN_ALPHA * (v[j] * rstd * g1[j] + b1[j]);
        const int* pp = (const int*)(ws + WS_POS) + (size_t)m * 8;
#pragma unroll
        for (int k = 0; k < 9; ++k) { const int row = k < 8 ? pp[k] : RTMAX * 256 + r;
            const u32x2* yr = (const u32x2*)(Y + (size_t)row * 1024) + l;
#pragma unroll
            for (int j = 0; j < 4; ++j) { const u32x2 y = yr[64 * j]; v[j].x += bflo(y.x); v[j].y += bfhi(y.x); v[j].z += bflo(y.y); v[j].w += bfhi(y.y); } }
        s = 0.f;
#pragma unroll
        for (int j = 0; j < 4; ++j) s += (v[j].x + v[j].y) + (v[j].z + v[j].w);
        mean = wave_sum(s) * (1.f / D); s2 = 0.f;
#pragma unroll
        for (int j = 0; j < 4; ++j) { v[j] = v[j] - mean; s2 += (v[j].x * v[j].x + v[j].y * v[j].y) + (v[j].z * v[j].z + v[j].w * v[j].w); }
        rstd = 1.f / sqrtf(wave_sum(s2) * (1.f / D) + LN_EPS);
#pragma unroll
        for (int j = 0; j < 4; ++j) xr[64 * j] = v[j] * rstd * g2[j] + b2[j];
    }
}
#if MK_DEBUG
__device__ __forceinline__ unsigned hsh(unsigned x) { x ^= x >> 16; x *= 0x7feb352dU; x ^= x >> 15; x *= 0x846ca68bU; x ^= x >> 16; return x; }
__device__ __forceinline__ void dbg_fail(unsigned char* ws, int code) { atomicMin((int*)ws, code); }
__device__ __forceinline__ bool closef(float got, float ex, float rel, float ab) { return fabsf(got - ex) <= rel * fabsf(ex) + ab; }
__device__ __forceinline__ float rbf(float x) { return bf2f(f2bf(x)); }
__device__ __forceinline__ float wave_max(float v) {
#pragma unroll
    for (int o = 1; o < 64; o <<= 1) v = fmaxf(v, __shfl_xor(v, o));
    return v;
}
#define DBG_EXP(ws) ((float*)((ws) + 65536))

__device__ __forceinline__ void chk_B(Ctx& X, const Args& A) {
    unsigned char* ws = X.ws; const int gw = X.bid * 8 + X.wave, NGW = X.G * 8, l = X.lane;
    for (int s = gw; s < 4096; s += NGW) {
        const int t = hsh(2 * s + 1) % T, c = hsh(2 * s + 2) % 8192;
        float acc = 0.f;
        for (int k = l; k < 1024; k += 64) acc += bf2f(((const bf16*)(ws + WS_H0))[(size_t)t * 1024 + k]) * rbf(A.in[4][(size_t)k * 8192 + c]);
        const float z = wave_sum(acc); const int reg = c >> 10, cc = c & 1023;
        const float ex = (reg == 0 || reg == 1 || reg == 3) ? gelu_tanh(z) : reg == 2 ? z : reg == 4 ? z * 0.0625f : 1.f / (1.f + __expf(-z));
        const bf16* buf = reg == 0 ? (const bf16*)(ws + WS_U) : reg == 1 ? (const bf16*)(ws + WS_GV) : reg == 2 ? (const bf16*)(ws + WS_LX) : reg == 3 ? (const bf16*)(ws + WS_LG) : reg == 4 ? (const bf16*)(ws + WS_Q) :
                          reg == 5 ? (const bf16*)(ws + WS_G0) : reg == 6 ? (const bf16*)X.out : (const bf16*)X.out + (size_t)T * 1024;
        const float got = bf2f(buf[(size_t)t * 1024 + cc]);
        if (!closef(got, ex, 0.02f, 0.01f)) { dbg_fail(ws, 10 + reg); }
    }
    for (int s = gw; s < 1024; s += NGW) {
        const int m = hsh(3 * s + 7) % TM, c = hsh(3 * s + 8) % 2048;
        float acc = 0.f;
        for (int k = l; k < 1024; k += 64) acc += rbf(A.in[1][(size_t)m * 1024 + k]) * rbf(A.in[16][(size_t)k * 2048 + c]);
        const float z = wave_sum(acc);
        const float got = c < 1024 ? bf2f(((const bf16*)(ws + WS_KB))[(size_t)m * 1024 + c]) : bf2f(((const bf16*)(ws + WS_VT))[(size_t)(c - 1024) * 4096 + m]);
        if (!closef(got, z, 0.02f, 0.01f)) dbg_fail(ws, c < 1024 ? 18 : 19);
    }
    for (int s = gw; s < 512; s += NGW) {
        const int t = hsh(5 * s + 3) % T; float a = 0.f, q = 0.f;
        for (int k = l; k < 1024; k += 64) { const float v = bf2f(((const bf16*)(ws + WS_GV))[(size_t)t * 1024 + k]); a += v; q += v * v; }
        a = wave_sum(a); q = wave_sum(q);
        float pa = 0.f, pq = 0.f; if (l < 16) { const f32x2 p = ((const f32x2*)(ws + WS_VSTAT))[(size_t)t * 16 + l]; pa = p.x; pq = p.y; }
        pa = wave_sum(pa); pq = wave_sum(pq);
        if (!closef(pa, a, 0.01f, 0.5f) || !closef(pq, q, 0.01f, 0.5f)) dbg_fail(ws, 9);
    }
}

__device__ __forceinline__ void chk_C_pre(Ctx& X, const Args& A) {
    unsigned char* ws = X.ws; const int gw = X.bid * 8 + X.wave, NGW = X.G * 8, l = X.lane;
    float* EX = DBG_EXP(ws);
    for (int s = gw; s < 3 * 512; s += NGW) {
        const int kind = s / 512, si = s % 512;
        if (kind == 0) {
            const int t = hsh(7 * si + 1) % T, c = hsh(7 * si + 2) % 1024, g = c >> 7, t0 = t & ~127, tl = t - t0;
            float acc = 0.f;
            for (int sr = 0; sr <= tl; ++sr) {
                float a = 0.f, q = 0.f;
                for (int k = l; k < 1024; k += 64) { const float v = bf2f(((const bf16*)(ws + WS_GV))[(size_t)(t0 + sr) * 1024 + k]); a += v; q += v * v; }
                a = wave_sum(a); q = wave_sum(q);
                const float mean = a * (1.f / 1024.f), var = q * (1.f / 1024.f) - mean * mean, rstd = 1.f / sqrtf(var + LN_EPS);
                const float vn = (bf2f(((const bf16*)(ws + WS_GV))[(size_t)(t0 + sr) * 1024 + c]) - mean) * rstd * A.in[5][c] + A.in[6][c];
                acc += A.in[7][(g * 128 + tl) * 128 + sr] * vn;
            }
            EX[s] = bf2f(((const bf16*)(ws + WS_U))[(size_t)t * 1024 + c]) * (acc + A.in[8][g * 128 + tl]);
        } else if (kind == 1) {
            if (si >= 64) { EX[s] = 0.f; continue; }
            const int b = hsh(11 * si + 1) % NB, ch = hsh(11 * si + 2) % 1024, ts = hsh(11 * si + 3) % SEQ, g = ch >> 7, o = ch & 127;
            float xh[2][3] = {{0.f, 0.f, 0.f}, {0.f, 0.f, 0.f}}; float h = 0.f;
            const float lam = A.in[15][ch], sp = log1pf(__expf(-lam)), ba = A.in[12][ch], bi = A.in[14][ch];
            float cw[2][4], cb[2], wa[2], wi[2];
#pragma unroll
            for (int q = 0; q < 2; ++q) { const int i = g * 128 + l + 64 * q; cb[q] = A.in[10][i];
#pragma unroll
                for (int k = 0; k < 4; ++k) cw[q][k] = A.in[9][k * 1024 + i];
                wa[q] = rbf(A.in[11][(size_t)g * 16384 + (l + 64 * q) * 128 + o]); wi[q] = rbf(A.in[13][(size_t)g * 16384 + (l + 64 * q) * 128 + o]); }
            for (int t = 0; t <= ts; ++t) {
                float xc[2]; float pa = 0.f, pi = 0.f;
#pragma unroll
                for (int q = 0; q < 2; ++q) { const float x0 = bf2f(((const bf16*)(ws + WS_LX))[(size_t)(b * SEQ + t) * 1024 + g * 128 + l + 64 * q]);
                    xc[q] = rbf(cb[q] + cw[q][0] * x0 + cw[q][1] * xh[q][0] + cw[q][2] * xh[q][1] + cw[q][3] * xh[q][2]);
                    xh[q][2] = xh[q][1]; xh[q][1] = xh[q][0]; xh[q][0] = x0; pa += xc[q] * wa[q]; pi += xc[q] * wi[q]; }
                pa = wave_sum(pa); pi = wave_sum(pi);
                const float xo = __shfl(o < 64 ? xc[0] : xc[1], o & 63);
                const float r = 1.f / (1.f + __expf(-(pa + ba))), ii = 1.f / (1.f + __expf(-(pi + bi)));
                const float la = -8.f * r * sp, a = __expf(la), mult = sqrtf(-expm1f(2.f * la));
                h = a * h + mult * ii * xo;
            }
            EX[s] = h * bf2f(((const bf16*)(ws + WS_LG))[(size_t)(b * SEQ + ts) * 1024 + ch]);
        } else {
            const int t = hsh(13 * si + 1) % T, c = hsh(13 * si + 2) % 1024, hh = c >> 8, b = t / SEQ;
            float sc[4];
#pragma unroll
            for (int j = 0; j < 4; ++j) { const int m = l + 64 * j; float a = 0.f;
                for (int dd = 0; dd < 256; ++dd) a += bf2f(((const bf16*)(ws + WS_Q))[(size_t)t * 1024 + hh * 256 + dd]) * bf2f(((const bf16*)(ws + WS_KB))[(size_t)(b * 256 + m) * 1024 + hh * 256 + dd]);
                sc[j] = a; }
            const float mx = wave_max(fmaxf(fmaxf(sc[0], sc[1]), fmaxf(sc[2], sc[3])));
            float sum = 0.f, ov = 0.f;
#pragma unroll
            for (int j = 0; j < 4; ++j) { const float p = __expf(sc[j] - mx); sum += p; ov += p * bf2f(((const bf16*)(ws + WS_VT))[(size_t)c * 4096 + b * 256 + l + 64 * j]); }
            sum = wave_sum(sum); ov = wave_sum(ov);
            EX[s] = ov / sum;
        }
    }
}
__device__ __forceinline__ void chk_C_post(Ctx& X, const Args& A) {
    unsigned char* ws = X.ws; const float* EX = DBG_EXP(ws);
    for (int s = X.bid * 512 + X.tid; s < 3 * 512; s += X.G * 512) {
        const int kind = s / 512, si = s % 512; float got;
        if (kind == 0) { const int t = hsh(7 * si + 1) % T, c = hsh(7 * si + 2) % 1024; got = bf2f(((const bf16*)(ws + WS_U))[(size_t)t * 1024 + c]); }
        else if (kind == 1) { if (si >= 64) continue; const int b = hsh(11 * si + 1) % NB, ch = hsh(11 * si + 2) % 1024, ts = hsh(11 * si + 3) % SEQ; got = bf2f(((const bf16*)(ws + WS_LG))[(size_t)(b * SEQ + ts) * 1024 + ch]); }
        else { const int t = hsh(13 * si + 1) % T, c = hsh(13 * si + 2) % 1024; got = bf2f(((const bf16*)(ws + WS_Q))[(size_t)t * 1024 + c]); }
        if (!closef(got, EX[s], 0.04f, kind == 2 ? 0.004f : 0.02f)) dbg_fail(ws, 20 + kind);
    }
}
__device__ __forceinline__ void chk_D1(Ctx& X, const Args& A) {
    unsigned char* ws = X.ws; const int gw = X.bid * 8 + X.wave, NGW = X.G * 8, l = X.lane;
    for (int s = gw; s < 2048; s += NGW) {
        const int t = hsh(17 * s + 1) % T, c = hsh(17 * s + 2) % 1024; float ex = 0.f;
#pragma unroll
        for (int k = 0; k < 3; ++k) {
            const bf16* Y = (const bf16*)(ws + (k == 0 ? WS_U : k == 1 ? WS_LG : WS_Q)); const bf16* Gk = k == 0 ? (const bf16*)(ws + WS_G0) : k == 1 ? (const bf16*)X.out : (const bf16*)X.out + (size_t)T * 1024;
            float acc = 0.f;
            for (int j = l; j < 1024; j += 64) acc += bf2f(Y[(size_t)t * 1024 + j]) * rbf(A.in[17 + k][(size_t)j * 1024 + c]);
            ex += bf2f(Gk[(size_t)t * 1024 + c]) * wave_sum(acc);
        }
        const float got = bf2f(((const bf16*)(ws + WS_H0))[(size_t)t * 1024 + c]);
        if (!closef(got, ex, 0.02f, 0.01f)) dbg_fail(ws, 30);
    }
}
__device__ __forceinline__ void chk_D2(Ctx& X, const Args& A) {
    unsigned char* ws = X.ws; const int gw = X.bid * 8 + X.wave, NGW = X.G * 8, l = X.lane;
    for (int s = gw; s < 2048; s += NGW) {
        const int t = hsh(19 * s + 1) % T, c = hsh(19 * s + 2) % 1024;
        float a = 0.f, q = 0.f, acc = 0.f;
        for (int j = l; j < 1024; j += 64) { const float v = A.in[0][(size_t)t * 1024 + j]; a += v; q += v * v; acc += bf2f(((const bf16*)(ws + WS_H0))[(size_t)t * 1024 + j]) * rbf(A.in[20][(size_t)j * 1024 + c]); }
        a = wave_sum(a); q = wave_sum(q); acc = wave_sum(acc);
        const float mean = a * (1.f / 1024.f), var = q * (1.f / 1024.f) - mean * mean, rstd = 1.f / sqrtf(var + LN_EPS);
        const float ex = DN_ALPHA * ((A.in[0][(size_t)t * 1024 + c] - mean) * rstd * A.in[2][c] + A.in[3][c]) + acc;
        if (!closef(X.out[(size_t)t * 1024 + c], ex, 0.01f, 0.01f)) dbg_fail(ws, 31);
    }
}
__device__ __forceinline__ void chk_R1(Ctx& X, const Args& A) {
    unsigned char* ws = X.ws; const int gw = X.bid * 8 + X.wave, NGW = X.G * 8, l = X.lane;
    LAS float* hb = (LAS float*)(X.lds + X.wave * 8192); LAS float* cs = hb + 1024; LAS float* ss = cs + 64;
    int nmis = 0;
    for (int s = gw; s < 2048; s += NGW) {
        const int t = hsh(23 * s + 1) % T;
        float a = 0.f, q = 0.f;
        for (int j = l; j < 1024; j += 64) { const float v = X.out[(size_t)t * 1024 + j]; a += v; q += v * v; }
        a = wave_sum(a); q = wave_sum(q);
        const float mean = a * (1.f / 1024.f), var = q * (1.f / 1024.f) - mean * mean, rstd = 1.f / sqrtf(var + LN_EPS);
        bool badh = false;
        for (int j = l; j < 1024; j += 64) { const float h1 = (X.out[(size_t)t * 1024 + j] - mean) * rstd * A.in[21][j] + A.in[22][j]; hb[j] = h1;
            if (!closef(bf2f(((const bf16*)(ws + WS_H1))[(size_t)t * 1024 + j]), h1, 0.01f, 0.003f)) badh = true; }
        if (__any(badh)) dbg_fail(ws, 39);
        LDS_WAIT();
        float lg = 0.f;
        for (int k = 0; k < 1024; ++k) lg += hb[k] * A.in[23][k * 64 + l];
        const float sg = 1.f / (1.f + __expf(-lg)); ss[l] = sg; cs[l] = sg + A.in[24][l];
        LDS_WAIT();
        unsigned long long sel = 0ull, ksel = 0ull; float wsum = 0.f;
        {
            float gs[8]; unsigned gmask = 0u;
            for (int g = 0; g < 8; ++g) { float m1 = -3e38f, m2 = -3e38f; for (int j = 0; j < 8; ++j) { const float v = cs[g * 8 + j]; if (v > m1) { m2 = m1; m1 = v; } else if (v > m2) m2 = v; } gs[g] = m1 + m2; }
            for (int it = 0; it < 4; ++it) { float best = -3e38f; int bi = 0; for (int g = 0; g < 8; ++g) if (!((gmask >> g) & 1u) && gs[g] > best) { best = gs[g]; bi = g; } gmask |= 1u << bi; }
            for (int k = 0; k < 8; ++k) { float best = -3e38f; int be = 0; for (int e = 0; e < 64; ++e) { const float v = cs[e]; if (((gmask >> (e >> 3)) & 1u) && !((sel >> e) & 1ull) && v > best) { best = v; be = e; } } sel |= 1ull << be; wsum += ss[be]; }
        }
        const int* ip = (const int*)(ws + WS_IDX) + (size_t)t * 8; const float* wp = (const float*)(ws + WS_WTS) + (size_t)t * 8;
        bool wbad = false;
        for (int k = 0; k < 8; ++k) { const int e = ip[k]; if (e < 0 || e > 63) { dbg_fail(ws, 42); continue; } ksel |= 1ull << e; if (!closef(wp[k], ss[e] / wsum * ROUTED_SCALE, 0.01f, 1e-4f)) wbad = true; }
        if (ksel != sel) ++nmis; else if (wbad) dbg_fail(ws, 41);
        LDS_WAIT();
    }
    if (nmis > 0 && l == 0) atomicAdd((int*)ws + 4, nmis);
}
__device__ __forceinline__ void chk_R2(Ctx& X, const Args& A) {
    unsigned char* ws = X.ws;
    if (X.bid == 0 && X.tid == 0 && ((const int*)ws)[4] > 100) dbg_fail(ws, 40);
    for (int s = X.bid * 512 + X.tid; s < 16384; s += X.G * 512) {
        const int tok = hsh(29 * s + 1) % T, k = hsh(29 * s + 2) % 8, chn = tok / CT;
        const int dest = ((const int*)(ws + WS_POS))[tok * 8 + k], e = ((const int*)(ws + WS_IDX))[tok * 8 + k];
        const int nt = ((const int*)(ws + WS_NTILE))[chn];
        if (nt < 256 || nt > RTMAX || dest < 0 || dest >= nt * 256) { dbg_fail(ws, 50); continue; }
        const unsigned ro = ((const unsigned*)(ws + WS_ROWOFF))[(size_t)chn * CROWS + ROWOFF_IDX(dest)];
        if (ro != (unsigned)tok * 2048u) dbg_fail(ws, 51);
        if (((const float*)(ws + WS_ROWW))[(size_t)chn * CROWS + dest] != ((const float*)(ws + WS_WTS))[tok * 8 + k]) dbg_fail(ws, 52);
        if (((const int*)(ws + WS_TILEE))[chn * (RTMAX + SHT) + (dest >> 8)] != e) dbg_fail(ws, 53);
    }
}
__device__ __forceinline__ void chk_E(Ctx& X, const Args& A, int chn, int which) {
    unsigned char* ws = X.ws; const int gw = X.bid * 8 + X.wave, NGW = X.G * 8, l = X.lane;
    const int nt = ((const int*)(ws + WS_NTILE))[chn];
    for (int s = gw; s < 2048; s += NGW) {
        const int ti = hsh(31 * s + 1 + chn) % (nt + SHT), tile = ti < nt ? ti : RTMAX + (ti - nt), row = tile * 256 + hsh(31 * s + 2) % 256;
        const int e = ((const int*)(ws + WS_TILEE))[chn * (RTMAX + SHT) + tile];
        if (e < 0 || e > 64) { dbg_fail(ws, 59); continue; }
        if (which == 0) {
            const int col = hsh(31 * s + 3) % 256;
            const unsigned tok = ((const unsigned*)(ws + WS_ROWOFF))[(size_t)chn * CROWS + ROWOFF_IDX(row)] / 2048u;
            const float* Wg = e < 64 ? A.in[25] + (size_t)e * 262144 : A.in[28]; const float* Wu = e < 64 ? A.in[26] + (size_t)e * 262144 : A.in[29];
            float ag = 0.f, au = 0.f;
            for (int k = l; k < 1024; k += 64) { const float hv = bf2f(((const bf16*)(ws + WS_H1))[(size_t)tok * 1024 + k]); ag += hv * rbf(Wg[(size_t)k * 256 + col]); au += hv * rbf(Wu[(size_t)k * 256 + col]); }
            ag = wave_sum(ag); au = wave_sum(au);
            const float ex = ag / (1.f + __expf(-ag)) * au;
            if (!closef(bf2f(((const bf16*)(ws + WS_HB))[(size_t)row * 256 + col]), ex, 0.03f, 0.003f)) dbg_fail(ws, 60 + chn);
        } else {
            const int col = hsh(31 * s + 3) % 1024;
            const float* Wd = e < 64 ? A.in[27] + (size_t)e * 262144 : A.in[30];
            float acc = 0.f;
            for (int j = l; j < 256; j += 64) acc += bf2f(((const bf16*)(ws + WS_HB))[(size_t)row * 256 + j]) * rbf(Wd[(size_t)j * 1024 + col]);
            acc = wave_sum(acc) * ((const float*)(ws + WS_ROWW))[(size_t)chn * CROWS + row];
            if (!closef(bf2f(((const bf16*)(ws + WS_Y))[(size_t)row * 1024 + col]), acc, 0.03f, 0.002f)) dbg_fail(ws, 70 + chn);
        }
    }
}
__device__ __forceinline__ void dbg_finish(Ctx& X) {
    const int* cw = (const int*)X.ws; const int code = cw[0];
    if (code != 0x7fffffff) { const float v = sqrtf((float)code); for (size_t i = (size_t)X.bid * 512 + X.tid; i < (size_t)T * D; i += (size_t)X.G * 512) X.out[i] = v; }
}
#endif

#ifndef MK_SPLIT
#define MK_SPLIT 0
#endif
#if MK_DEBUG
#define DBG(x) x
#else
#define DBG(x)
#endif
constexpr int N_PHASES = 7 + 3 * NCH;

__global__ void __launch_bounds__(512, 2) mk_fwd(Args a) {
    extern __shared__ __attribute__((aligned(16))) unsigned char lds_raw[];
    cg::grid_group grid = cg::this_grid();
    Ctx X;
    X.out = a.out; X.ws = a.ws; X.lds = (LAS unsigned char*)lds_raw;
#define SET_TID() do { int t_ = threadIdx.x; asm volatile("" : "+v"(t_)); X.tid = t_; X.lane = t_ & 63; X.wave = __builtin_amdgcn_readfirstlane(t_ >> 6); } while (0)
    SET_TID();
    X.G = gridDim.x; X.bid = blockIdx.x; X.vcu = (X.G % 8 == 0) ? (X.bid % 8) * (X.G / 8) + X.bid / 8 : X.bid;
#define L2_FENCE() do { asm volatile("s_waitcnt vmcnt(0) lgkmcnt(0)" ::: "memory"); __syncthreads(); if (threadIdx.x == 0) { __builtin_amdgcn_fence(__ATOMIC_SEQ_CST, "agent"); } asm volatile("s_waitcnt vmcnt(0)" ::: "memory"); __syncthreads(); } while (0)
    L2_FENCE();
    const int lo = a.ph_lo, hi = a.ph_hi;
    int ph = 0;
#define PHASE_BEGIN() if (lo <= ph && ph < hi) { SET_TID();
#define GRID_SYNC() do { asm volatile("s_waitcnt vmcnt(0) lgkmcnt(0)" ::: "memory"); __syncthreads(); grid.sync(); } while (0)
#define PHASE_END() if (ph + 1 < hi) GRID_SYNC(); } ++ph;

    PHASE_BEGIN() DBG(if (X.bid == 0 && X.tid < 64) ((int*)X.ws)[X.tid] = (X.tid == 0) ? 0x7fffffff : 0;) phase_p0(X, a); PHASE_END()
    PHASE_BEGIN() { ProbB P{1024, X.G, X.bid, X.ws, (bf16*)X.out}; pg8::gemm_phase(X.lds, P); } DBG(if (X.tid == 0) atomicAdd((int*)X.ws + 40, 1);) PHASE_END()
    PHASE_BEGIN()
        DBG(if (X.tid == 0 && __hip_atomic_load((int*)X.ws + 40, __ATOMIC_RELAXED, __HIP_MEMORY_SCOPE_AGENT) != X.G) dbg_fail(X.ws, 2); chk_B(X, a); chk_C_pre(X, a); GRID_SYNC();)
        conv_wbr(X, a);
        __syncthreads();
        for (int u = X.bid; u < 256; u += X.G) lru_unit(X, a, u);
        for (int u = X.bid; u < 1024; u += X.G) attn_unit(X, a, u);
        for (int u = X.bid; u < 2048; u += X.G) gmlp_unit(X, a, u);
    PHASE_END()
    PHASE_BEGIN() DBG(chk_C_post(X, a);) { ProbD1 P{1024, X.G, X.bid, X.ws, (bf16*)X.out}; pg8::gemm_phase(X.lds, P); } PHASE_END()
    PHASE_BEGIN() DBG(chk_D1(X, a); GRID_SYNC();) { ProbD2 P{1024, X.G, X.bid, X.ws, X.out, a.in[0], a.in[2], a.in[3]}; pg8::gemm_phase(X.lds, P); } conv_experts(X, a); PHASE_END()
    PHASE_BEGIN() DBG(chk_D2(X, a); GRID_SYNC();) for (int b = X.bid; b < T / 128; b += X.G) route_block(X, a, b); PHASE_END()
    PHASE_BEGIN() DBG(chk_R1(X, a); __syncthreads();) for (int b = X.bid; b < T / 128; b += X.G) place_block(X, a, b); PHASE_END()
    for (int chn = 0; chn < NCH; ++chn) {
        PHASE_BEGIN() DBG(if (chn == 0) chk_R2(X, a);) { const int nt = ((const int*)(X.ws + WS_NTILE))[chn]; ProbE1 P{1024, X.G, X.vcu, X.ws, chn, nt}; pg8::gemm_phase(X.lds, P); } PHASE_END()
        PHASE_BEGIN() DBG(chk_E(X, a, chn, 0);) { const int nt = ((const int*)(X.ws + WS_NTILE))[chn]; ProbE2 P{256, X.G, X.vcu, X.ws, chn, nt}; pg8::gemm_phase(X.lds, P); } PHASE_END()
        PHASE_BEGIN() DBG(chk_E(X, a, chn, 1);) combine_rows(X, a, chn); PHASE_END()
    }
    DBG(grid.sync(); dbg_finish(X);)
    L2_FENCE();
}

extern "C" void kernel_launch(void* const* d_in, const int* in_sizes, int n_in, void* d_out, int out_size, void* d_ws, size_t ws_size, hipStream_t stream) {
    static int grid = 0;
    if (grid == 0) {
        if (n_in != 33 || out_size != T * D || ws_size < WS_END) { fprintf(stderr, "kernel_launch: unexpected shapes: n_in %d out %d ws %zu\n", n_in, out_size, ws_size); grid = -1; return; }
        int dev = 0, cus = 0, per_cu = 0;
        if (hipGetDevice(&dev) != hipSuccess || hipDeviceGetAttribute(&cus, hipDeviceAttributeMultiprocessorCount, dev) != hipSuccess) { grid = -1; return; }
        if (hipFuncSetAttribute((const void*)mk_fwd, hipFuncAttributeMaxDynamicSharedMemorySize, LDS_BYTES) != hipSuccess) { fprintf(stderr, "kernel_launch: hipFuncSetAttribute failed\n"); grid = -1; return; }
        if (hipOccupancyMaxActiveBlocksPerMultiprocessor(&per_cu, (const void*)mk_fwd, 512, LDS_BYTES) != hipSuccess || per_cu < 1) { fprintf(stderr, "kernel_launch: occupancy query says %d\n", per_cu); per_cu = 1; }
        (void)hipGetLastError();
        grid = cus;
        fprintf(stderr, "kernel_launch: cus %d per_cu %d grid %d ws %zu\n", cus, per_cu, grid, ws_size);
    }
    if (grid < 0) return;
    Args a{};
    for (int i = 0; i < 33; ++i) a.in[i] = (const float*)d_in[i];
    a.out = (float*)d_out; a.ws = (unsigned char*)d_ws;
#if MK_SPLIT
    for (int p = 0; p < N_PHASES; ++p) { a.ph_lo = p; a.ph_hi = p + 1;
#else
    { a.ph_lo = 0; a.ph_hi = N_PHASES;
#endif
        void* args[] = {&a};
        const hipError_t e = hipLaunchCooperativeKernel((const void*)mk_fwd, dim3(grid), dim3(512), args, LDS_BYTES, stream);
        if (e != hipSuccess) fprintf(stderr, "kernel_launch: cooperative launch failed: %s (grid %d)\n", hipGetErrorString(e), grid);
    }
}
```

```cpp
#include <hip/hip_runtime.h>
#include <hip/hip_cooperative_groups.h>
#include <cstdio>
#include <cstdint>
namespace cg = cooperative_groups;
#ifndef DBG_SEL
#define DBG_SEL 0
#endif
#ifndef MK_DEBUG
#define MK_DEBUG 0
#endif
#ifndef MK_TIME
#define MK_TIME -1
#endif
#if MK_TIME >= 0
#define XSTAMP(ws_, bid_, tid_, k) do { if ((bid_) == 0 && (tid_) == 0) ((unsigned long long*)((ws_) + 4096))[k] = __builtin_amdgcn_s_memrealtime(); } while (0)
#else
#define XSTAMP(ws_, bid_, tid_, k) do {} while (0)
#endif

constexpr int T = 32768, D = 1024, NB = 16, SEQ = 2048, MEMLEN = 256, TM = NB * MEMLEN;
constexpr int INC = 8192;
constexpr int NE = 64, TOPK = 8, ED = 256;
constexpr int NCH = 2, CT = T / NCH;
constexpr int RTMAX = CT * 8 / 256 + 64, SHT = CT / 256;
constexpr int CROWS = (RTMAX + SHT) * 256;
constexpr int BPC = CT / 128;
constexpr float LN_EPS = 1e-5f;
constexpr float DN_ALPHA = 1.189207115002721f;
constexpr float ROUTED_SCALE = 2.5f;
constexpr float YSCALE = 64.0f;

constexpr size_t MiB = 1u << 20;
constexpr size_t WS_CTL = 0;
constexpr size_t WS_BAR = 256 * 1024;
constexpr size_t WS_XSTAT = 1 * MiB;
constexpr size_t WS_VSTAT = 2 * MiB;
constexpr size_t WS_IDX = 6 * MiB;
constexpr size_t WS_WTS = 7 * MiB;
constexpr size_t WS_RK = 8 * MiB;
constexpr size_t WS_POS = 9 * MiB;
constexpr size_t WS_HIST = 10 * MiB;
constexpr size_t WS_TILEE = 10 * MiB + 64 * 1024;
constexpr size_t WS_NTILE = 10 * MiB + 96 * 1024;
constexpr size_t WS_ROWW = 13 * MiB;
constexpr size_t WS_ROWOFF = 11 * MiB;
constexpr size_t WS_WA = 16 * MiB;
constexpr size_t WS_WI = WS_WA + 256 * 1024;
constexpr size_t WS_WSP = WS_WI + 256 * 1024;
constexpr size_t WS_WR = WS_WSP + 256 * 1024;
constexpr size_t WS_WIN = 17 * MiB;
constexpr size_t WS_WBR = 17 * MiB, WS_WOUT = 23 * MiB;
constexpr size_t WS_WKV = 33 * MiB;
constexpr size_t WS_MEMB = 37 * MiB, WS_KB = 45 * MiB, WS_VT = 53 * MiB;
constexpr size_t WS_H0 = 61 * MiB;
constexpr size_t WS_U = 125 * MiB, WS_LG = 189 * MiB, WS_Q = 253 * MiB, WS_GV = 317 * MiB, WS_LX = 381 * MiB;
constexpr size_t WS_P = WS_GV;
constexpr size_t WS_G0 = 445 * MiB;
constexpr size_t WS_H1 = WS_H0, WS_H1LO = 125 * MiB;
constexpr size_t WS_MO = 447 * MiB;
constexpr size_t WS_WGU = 189 * MiB;
constexpr size_t WS_WD = 254 * MiB;
constexpr size_t WS_HB = 287 * MiB;
constexpr size_t WS_Y = 61 * MiB;
constexpr size_t WS_END = 509 * MiB;
static_assert(WS_WD + (size_t)65 * 1024 * 256 * 2 <= WS_HB && WS_HB + (size_t)NCH * CROWS * 256 * 2 <= WS_END && WS_Y + (size_t)CROWS * 1024 <= WS_WD, "MoE map");
static_assert(WS_WGU + (size_t)65 * 2 * 256 * 1024 * 2 <= WS_WD, "MoE map 2");
static_assert(WS_ROWOFF + (size_t)NCH * CROWS * 4 <= WS_ROWW && WS_ROWW + (size_t)NCH * CROWS * 4 <= WS_WA, "tables");

constexpr int LDS_BYTES = 147456;
#define LAS __attribute__((address_space(3)))
typedef unsigned short bf16;
typedef short bf16x8 __attribute__((ext_vector_type(8)));
typedef float f32x4 __attribute__((ext_vector_type(4)));
typedef float f32x2 __attribute__((ext_vector_type(2)));
typedef unsigned u32x4 __attribute__((ext_vector_type(4)));
typedef unsigned u32x2 __attribute__((ext_vector_type(2)));

__device__ __forceinline__ unsigned f2bf(float f) { unsigned u = __builtin_bit_cast(unsigned, f); return (u + 0x7fffu + ((u >> 16) & 1u)) >> 16; }
__device__ __forceinline__ unsigned pk2(float lo, float hi) { return f2bf(lo) | (f2bf(hi) << 16); }
__device__ __forceinline__ float bf2f(unsigned b) { return __builtin_bit_cast(float, b << 16); }
__device__ __forceinline__ float bflo(unsigned w) { return __builtin_bit_cast(float, w << 16); }
__device__ __forceinline__ float bfhi(unsigned w) { return __builtin_bit_cast(float, w & 0xffff0000u); }
__device__ __forceinline__ float wave_sum(float v) {
    v += __builtin_bit_cast(float, __builtin_amdgcn_update_dpp(0, __builtin_bit_cast(int, v), 0xB1, 0xF, 0xF, false));
    v += __builtin_bit_cast(float, __builtin_amdgcn_update_dpp(0, __builtin_bit_cast(int, v), 0x4E, 0xF, 0xF, false));
    v += __builtin_bit_cast(float, __builtin_amdgcn_update_dpp(0, __builtin_bit_cast(int, v), 0x124, 0xF, 0xF, false));
    v += __builtin_bit_cast(float, __builtin_amdgcn_update_dpp(0, __builtin_bit_cast(int, v), 0x128, 0xF, 0xF, false));
    const int vi = __builtin_bit_cast(int, v);
    const float a = __builtin_bit_cast(float, __builtin_amdgcn_readlane(vi, 0)), b = __builtin_bit_cast(float, __builtin_amdgcn_readlane(vi, 16));
    const float c = __builtin_bit_cast(float, __builtin_amdgcn_readlane(vi, 32)), d = __builtin_bit_cast(float, __builtin_amdgcn_readlane(vi, 48));
    return (a + b) + (c + d);
}
__device__ __forceinline__ float fast_sigmoid(float x) { return __builtin_amdgcn_rcpf(1.0f + __builtin_amdgcn_exp2f(-1.4426950408889634f * x)); }
__device__ __forceinline__ float gelu_tanh(float x) { const float u = x * (1.0f + 0.044715f * x * x); return x * fast_sigmoid(1.5957691216057308f * u); }
__device__ __forceinline__ int lane_id() { int l; asm volatile("v_mbcnt_lo_u32_b32 %0, -1, 0\n\tv_mbcnt_hi_u32_b32 %0, -1, %0" : "=v"(l)); return l; }
#define LDS_WAIT() asm volatile("s_waitcnt lgkmcnt(0)" ::: "memory")
#define VM_WAIT() asm volatile("s_waitcnt vmcnt(0)" ::: "memory")
namespace pg8 {
#define PG8_LAS __attribute__((address_space(3)))
typedef unsigned short bf16_t;
typedef short bf16x8 __attribute__((ext_vector_type(8)));
typedef float f32x4 __attribute__((ext_vector_type(4)));
typedef float f32x2 __attribute__((ext_vector_type(2)));
typedef unsigned u32x4 __attribute__((ext_vector_type(4)));
typedef unsigned u32x2 __attribute__((ext_vector_type(2)));
constexpr int BM = 256, BK = 64, HALF = 128, HTB = HALF * BK * 2  , STAGE_BYTES = 8 * HTB, NXCD = 8, WGM = 8;

__host__ __device__ __forceinline__ int lds_byte(int r, int c) { const int st = (r >> 4) * 2 + (c >> 5), rr = r & 15, cc = c & 31, ob = rr * 64 + cc * 2; return st * 1024 + (ob ^ (((ob >> 9) & 1) << 5)); }
__host__ __device__ __forceinline__ void stage_rc(int b, int& R, int& C) { const int st = b / 1024, sb = b % 1024, swz = sb ^ (((sb >> 9) & 1) << 5); R = (st >> 1) * 16 + swz / 64; C = (st & 1) * 32 + (swz % 64) / 2; }
__host__ __device__ __forceinline__ int perm32(int rho) { const int n = rho >> 4, i = rho & 15; return 8 * (i >> 2) + 4 * n + (i & 3); }

struct Unit { int pm, pn, aux, ch; };

__device__ __forceinline__ void tile_order(int L, int nM, int nN, int& pm, int& pn) {
    const int nwg = nM * nN; int wgid = L;
    { const int q = nwg / NXCD, r = nwg % NXCD, xcd = wgid % NXCD, off = wgid / NXCD; wgid = (xcd < r ? xcd * (q + 1) : r * (q + 1) + (xcd - r) * q) + off; }
    const int nig = WGM * nN, gid = wgid / nig, fm = gid * WGM, gsz = (nM - fm) < WGM ? (nM - fm) : WGM;
    pm = fm + ((wgid % nig) % gsz); pn = (wgid % nig) / gsz;
}

__device__ __forceinline__ unsigned cvt_pk_bf16(float lo, float hi) { unsigned r; asm volatile("v_cvt_pk_bf16_f32 %0, %1, %2" : "=v"(r) : "v"(lo), "v"(hi)); return r; }

#ifndef MK_GT
#define MK_GT 0
#endif
#if MK_GT
#define PG8_TS(k) do { if (TM) { const unsigned n_ = (unsigned)__builtin_amdgcn_s_memrealtime(); if (lane == 0) tl_[k] += n_ - tprev; tprev = n_; } } while (0)
#else
#define PG8_TS(k) do {} while (0)
#endif
template <class P, bool TM = false>
__device__ __forceinline__ void gemm_phase(PG8_LAS unsigned char* lds, const P& S, int tid_in, unsigned* tout = nullptr) {
#if MK_GT
    unsigned tprev = 0;
#define tl_ ((volatile PG8_LAS unsigned*)(lds + 141312 + wid * 32))

#endif
    int tid_ = tid_in; asm volatile("" : "+v"(tid_));
    const int tid = tid_, wid = __builtin_amdgcn_readfirstlane(tid >> 6), lane = tid & 63, wr = wid >> 2, wc = wid & 3, fr = lane & 15, fq = lane >> 4;
    const int K = P::KSEG > 0 ? P::KSEG * BK : S.K, nt = S.K / BK;
    unsigned voffA[2], voffB[2]; int RA[2], CA[2];
#pragma unroll
    for (int i = 0; i < 2; ++i) { int R, C; stage_rc(tid * 16 + i * 8192, R, C); const int Rb = P::PERM ? ((R & ~31) + perm32(R & 31)) : R;
        RA[i] = R; CA[i] = C; voffA[i] = (unsigned)(R * K + C) * 2u; voffB[i] = (unsigned)(Rb * K + C) * 2u; }
    const size_t kstep = (size_t)(BK * 2);
    const size_t hstep = (size_t)HALF * K * 2;
    const unsigned ldsw = (unsigned)wid * 1024u;
    const int aoff = lds_byte(wr * 64 + fr, fq * 8), boff = lds_byte(wc * 32 + fr, fq * 8);
#define PG8_SA(b, h) (((b) * 2 + (h)) * HTB)
#define PG8_SB(b, h) ((4 + (b) * 2 + (h)) * HTB)
#define PG8_STAGE(bufoff, gbase, o0, o1) do { \
        __builtin_amdgcn_global_load_lds((const unsigned*)((const char*)(gbase) + (o0)), (PG8_LAS unsigned*)(lds + (bufoff) + ldsw), 16, 0, 0); \
        __builtin_amdgcn_global_load_lds((const unsigned*)((const char*)(gbase) + (o1)), (PG8_LAS unsigned*)(lds + (bufoff) + ldsw + 8192), 16, 0, 0); } while (0)
#define PG8_STAGEB(bufoff, gbase) PG8_STAGE(bufoff, gbase, voffB[0], voffB[1])
#define PG8_STAGEA(bufoff, p, v, h) do { if constexpr (P::GATHER) PG8_STAGE(bufoff, p, (v)[h][0], (v)[h][1]); else PG8_STAGE(bufoff, (p) + (h) * hstep, voffA[0], voffA[1]); } while (0)
#define PG8_LDA(dst, b, h) do { _Pragma("unroll") for (int m = 0; m < 4; ++m) _Pragma("unroll") for (int k = 0; k < 2; ++k) dst[m][k] = *(const PG8_LAS bf16x8*)(lds + PG8_SA(b, h) + aoff + m * 2048 + k * 1024); } while (0)
#define PG8_LDB(dst, b, h) do { _Pragma("unroll") for (int n = 0; n < 2; ++n) _Pragma("unroll") for (int k = 0; k < 2; ++k) dst[n][k] = *(const PG8_LAS bf16x8*)(lds + PG8_SB(b, h) + boff + n * 2048 + k * 1024); } while (0)
#define PG8_MMA(ai, bj, At, Bt) do { __builtin_amdgcn_s_setprio(1); _Pragma("unroll") for (int m = 0; m < 4; ++m) _Pragma("unroll") for (int n = 0; n < 2; ++n) _Pragma("unroll") for (int k = 0; k < 2; ++k) \
        acc[ai][bj][m][n] = __builtin_amdgcn_mfma_f32_16x16x32_bf16(Bt[n][k], At[m][k], acc[ai][bj][m][n], 0, 0, 0); __builtin_amdgcn_s_setprio(0); } while (0)
#define PG8_WAIT_V(n) asm volatile("s_waitcnt vmcnt(" #n ")" ::: "memory")
#define PG8_WAIT_V_SP2(fresh) do { if constexpr (P::EPI_OPS > 0) asm volatile("s_cmp_lg_u32 %0, 0\n\ts_cbranch_scc1 .Lwa_%=\n\ts_waitcnt vmcnt(8)\n\ts_branch .Lwb_%=\n.Lwa_%=:\n\ts_waitcnt vmcnt(%1)\n.Lwb_%=:" :: "s"(__builtin_amdgcn_readfirstlane(fresh)), "n"(8 + P::EPI_OPS + (P::PRE == 2 ? 2 : 0)) : "memory", "scc"); \
        else asm volatile("s_waitcnt vmcnt(8)" ::: "memory"); } while (0)
#define PG8_WAIT_L(n) asm volatile("s_waitcnt lgkmcnt(" #n ")" ::: "memory")
#define PG8_BAR __builtin_amdgcn_s_barrier()
#define PG8_SCHED __builtin_amdgcn_sched_barrier(0)
    Unit cur, nxt; int ui = 0;
    if (!S.next(0, cur)) return;
    f32x4 acc[2][2][4][2];
#pragma unroll
    for (int a = 0; a < 2; ++a)
#pragma unroll
        for (int b = 0; b < 2; ++b)
#pragma unroll
            for (int m = 0; m < 4; ++m)
#pragma unroll
                for (int n = 0; n < 2; ++n) acc[a][b][m][n] = (f32x4){0.f, 0.f, 0.f, 0.f};
    bf16x8 At[4][2], B0[2][2], B1[2][2];
    unsigned vA[2][2] = {{0u, 0u}, {0u, 0u}};
#define PG8_PA(u, tile) (P::KSEG > 0 ? S.abase(u, (tile) / (P::KSEG > 0 ? P::KSEG : 1)) + (size_t)((tile) % (P::KSEG > 0 ? P::KSEG : 1)) * kstep : S.abase(u, 0) + (size_t)(tile) * kstep)
#define PG8_PB(u, tile) (P::KSEG > 0 ? S.bbase(u, (tile) / (P::KSEG > 0 ? P::KSEG : 1)) + (size_t)((tile) % (P::KSEG > 0 ? P::KSEG : 1)) * kstep : S.bbase(u, 0) + (size_t)(tile) * kstep)
    const char* cA = PG8_PA(cur, 0); const char* cB = PG8_PB(cur, 0);
    if constexpr (P::GATHER) { S.gather(cur, RA[0], vA, CA[0], CA[1]); if (tid < 64) S.rows_to_lds(cur, lds + STAGE_BYTES, 0, tid, false); }
    PG8_STAGEB(PG8_SB(0, 0), cB); PG8_STAGEB(PG8_SB(0, 1), cB + hstep); PG8_STAGEA(PG8_SA(0, 0), cA, vA, 0); PG8_STAGEA(PG8_SA(0, 1), cA, vA, 1);
    if (wr == 1) PG8_BAR;
    PG8_WAIT_V(2); PG8_BAR;
    PG8_STAGEB(PG8_SB(1, 0), cB + kstep); PG8_STAGEA(PG8_SA(1, 0), cA + kstep, vA, 0); PG8_STAGEB(PG8_SB(1, 1), cB + hstep + kstep);
    PG8_WAIT_V(6); PG8_BAR;
#if MK_GT
    if (TM) { if (lane < 8) tl_[lane] = 0u; tprev = (unsigned)__builtin_amdgcn_s_memrealtime(); }
#endif
    for (;;) {
        const bool has_next = S.next(ui + 1, nxt);
        const char* nA = has_next ? PG8_PA(nxt, 0) : PG8_PA(cur, 0); const char* nB = has_next ? PG8_PB(nxt, 0) : PG8_PB(cur, 0);
        if constexpr (P::GATHER) { if (has_next && tid < 64) S.rows_to_lds(nxt, lds + STAGE_BYTES, (ui + 1) % 3, tid, true); }
        for (int t = 0; t < nt; t += 2) {
            const bool last = (t == nt - 2); const int fresh = (t == 0 && ui > 0) ? 1 : 0;
            const char* a1 = PG8_PA(cur, t + 1);
            const char* a2 = last ? nA : PG8_PA(cur, t + 2); const char* b2 = last ? nB : PG8_PB(cur, t + 2);
            if constexpr (P::KSEG > 0) { if (t > 0 && (t % (P::KSEG > 0 ? P::KSEG : 1)) == 0) S.khook(acc, cur, t / (P::KSEG > 0 ? P::KSEG : 1), wr, wc, fr, fq); }
            const char* a3 = a2 + kstep; const char* b3 = b2 + kstep;
            PG8_LDB(B0, 0, 0); PG8_LDB(B1, 0, 1); PG8_SCHED; PG8_LDA(At, 0, 0); if (P::PRE != 1 || !fresh) PG8_STAGEA(PG8_SA(1, 1), a1, vA, 1);
            PG8_WAIT_V_SP2(fresh); PG8_WAIT_L(0); PG8_BAR; PG8_MMA(0, 0, At, B0); PG8_MMA(0, 1, At, B1); PG8_BAR; PG8_SCHED;
            if constexpr (P::GATHER) { if (last && has_next) { int R_, C_; stage_rc(tid * 16, R_, C_); const u32x4 o = *(const PG8_LAS u32x4*)(lds + STAGE_BYTES + R_ * 16); const unsigned c2 = (unsigned)C_ * 2u;
                vA[0][0] = o.x + c2; vA[0][1] = o.y + c2; vA[1][0] = o.z + c2; vA[1][1] = o.w + c2; } }
            PG8_LDA(At, 0, 1); PG8_STAGEB(PG8_SB(0, 0), b2); PG8_STAGEB(PG8_SB(0, 1), b2 + hstep); PG8_STAGEA(PG8_SA(0, 0), a2, vA, 0);
            PG8_WAIT_V_SP2(fresh); PG8_WAIT_L(0); PG8_BAR; PG8_MMA(1, 0, At, B0); PG8_MMA(1, 1, At, B1); PG8_BAR; PG8_SCHED;
            PG8_LDB(B0, 1, 0); PG8_LDB(B1, 1, 1); PG8_SCHED; PG8_LDA(At, 1, 0); PG8_STAGEA(PG8_SA(0, 1), a2, vA, 1);
            if constexpr (P::PRE != 0) PG8_WAIT_V_SP2(fresh); else PG8_WAIT_V(8);
            PG8_WAIT_L(0); PG8_BAR; PG8_MMA(0, 0, At, B0); PG8_MMA(0, 1, At, B1); PG8_BAR; PG8_SCHED;
            PG8_LDA(At, 1, 1); PG8_STAGEB(PG8_SB(1, 0), b3); PG8_STAGEB(PG8_SB(1, 1), b3 + hstep); PG8_STAGEA(PG8_SA(1, 0), a3, vA, 0);
            PG8_WAIT_V(8); PG8_WAIT_L(0); PG8_BAR; PG8_MMA(1, 0, At, B0); PG8_MMA(1, 1, At, B1); PG8_BAR; PG8_SCHED;
#if MK_GT
            if (TM) { if (t == 0) { if (ui == 0) PG8_TS(0); else PG8_TS(6); } else PG8_TS(1); }
#endif
        }
        if constexpr (P::PRE != 0) PG8_STAGEA(PG8_SA(1, 1), nA + kstep, vA, 1);
        if (wr == 0) PG8_BAR;
        PG8_TS(2);
        S.epi(acc, cur, wr, wc, fr, fq, lds + STAGE_BYTES + 1024 + (ui % 3) * 1024);
        PG8_TS(3);
#if MK_GT
        if (TM && lane == 0) tl_[5] += 1;
#endif
        if (!has_next) break;
#pragma unroll
        for (int a = 0; a < 2; ++a)
#pragma unroll
            for (int b = 0; b < 2; ++b)
#pragma unroll
                for (int m = 0; m < 4; ++m)
#pragma unroll
                    for (int n = 0; n < 2; ++n) acc[a][b][m][n] = (f32x4){0.f, 0.f, 0.f, 0.f};
        cur = nxt; ++ui;
        if (wr == 1) PG8_BAR;
        PG8_TS(4);
    }
#if MK_GT
    if (TM && tout != nullptr && lane == 0) { for (int k = 0; k < 6; ++k) tout[wid * 8 + k] = tl_[k]; }
#endif
    PG8_WAIT_V(0);
    PG8_BAR;
#undef PG8_PA
#undef PG8_PB
#undef PG8_SA
#undef PG8_SB
#undef PG8_STAGE
#undef PG8_STAGEA
#undef PG8_STAGEB
#undef PG8_LDA
#undef PG8_LDB
#undef PG8_MMA
#undef PG8_WAIT_V
#undef PG8_WAIT_L
#undef PG8_BAR
#undef PG8_SCHED
}
}
using pg8::Unit;
constexpr size_t TSTEP1024 = (size_t)256 * 1024 * 2;
constexpr size_t TSTEP256 = (size_t)256 * 256 * 2;

struct ActC { float ca, cb, d1, d3, d0; };
__device__ __forceinline__ ActC act_gelu() { return ActC{1.f, 0.f, -1.4426950409f * 1.5957691216f, -1.4426950409f * 0.0713548163f, 0.f}; }
__device__ __forceinline__ ActC act_sigmoid() { return ActC{0.f, 1.f, -1.4426950409f, 0.f, 0.f}; }
__device__ __forceinline__ ActC act_linear(float s) { return ActC{s, 0.f, 0.f, 0.f, -1.4426950409f * 40.f}; }
struct LaneTr { int fr2, fq2, paddr, ipaddr; };
__device__ __forceinline__ LaneTr lane_tr_make(int fr, int fq) { LaneTr t; t.fr2 = fq * 4 + (fr >> 2); t.fq2 = fr & 3; t.paddr = ((fr & 3) * 16 + fq * 4 + (fr >> 2)) * 4; t.ipaddr = (fr * 4 + fq) * 4; return t; }
__device__ __forceinline__ u32x4 lane_tr4(const LaneTr& t, u32x4 w) {
    u32x4 r; r.x = (unsigned)__builtin_amdgcn_ds_bpermute(t.paddr, (int)w.x); r.y = (unsigned)__builtin_amdgcn_ds_bpermute(t.paddr, (int)w.y);
    r.z = (unsigned)__builtin_amdgcn_ds_bpermute(t.paddr, (int)w.z); r.w = (unsigned)__builtin_amdgcn_ds_bpermute(t.paddr, (int)w.w); return r; }
__device__ __forceinline__ u32x4 lane_tr4_inv(const LaneTr& t, u32x4 w) {
    u32x4 r; r.x = (unsigned)__builtin_amdgcn_ds_bpermute(t.ipaddr, (int)w.x); r.y = (unsigned)__builtin_amdgcn_ds_bpermute(t.ipaddr, (int)w.y);
    r.z = (unsigned)__builtin_amdgcn_ds_bpermute(t.ipaddr, (int)w.z); r.w = (unsigned)__builtin_amdgcn_ds_bpermute(t.ipaddr, (int)w.w); return r; }
__device__ __forceinline__ u32x2 lane_tr2_inv(const LaneTr& t, u32x2 w) {
    u32x2 r; r.x = (unsigned)__builtin_amdgcn_ds_bpermute(t.ipaddr, (int)w.x); r.y = (unsigned)__builtin_amdgcn_ds_bpermute(t.ipaddr, (int)w.y); return r; }
__device__ __forceinline__ u32x2 lane_tr2(const LaneTr& t, u32x2 w) {
    u32x2 r; r.x = (unsigned)__builtin_amdgcn_ds_bpermute(t.paddr, (int)w.x); r.y = (unsigned)__builtin_amdgcn_ds_bpermute(t.paddr, (int)w.y); return r; }

template <int MODE>
__device__ __forceinline__ void store_tile_uni(const f32x4 (&acc)[2][2][4][2], bf16* O, int ldc, int rowb, int colb, const ActC A, f32x2* stat, int statcol, int fr, int fq) {
    const LaneTr T = lane_tr_make(fr, fq);
#pragma unroll
    for (int ai = 0; ai < 2; ++ai)
#pragma unroll
        for (int m = 0; m < 4; ++m) {
            const int rowm = rowb + ai * 128 + m * 16;
            bf16* rowp = O + (size_t)(rowm + T.fr2) * ldc + colb + 8 * T.fq2;
            f32x2 s2 = (f32x2){0.f, 0.f}, q2 = (f32x2){0.f, 0.f};
#pragma unroll
            for (int bj = 0; bj < 2; ++bj) {
                f32x2 v[4] = {(f32x2){acc[ai][bj][m][0][0], acc[ai][bj][m][0][1]}, (f32x2){acc[ai][bj][m][0][2], acc[ai][bj][m][0][3]}, (f32x2){acc[ai][bj][m][1][0], acc[ai][bj][m][1][1]}, (f32x2){acc[ai][bj][m][1][2], acc[ai][bj][m][1][3]}};
#pragma unroll
                for (int j = 0; j < 4; ++j) {
                    const f32x2 z = v[j];
                    if (MODE == 2) v[j] = z * A.ca;
                    else {
                        const f32x2 u = z * ((z * z) * A.d3 + A.d1) + A.d0;
                        f32x2 e; e.x = __builtin_amdgcn_exp2f(u.x); e.y = __builtin_amdgcn_exp2f(u.y);
                        const f32x2 den = e + 1.0f; f32x2 r; r.x = __builtin_amdgcn_rcpf(den.x); r.y = __builtin_amdgcn_rcpf(den.y);
                        v[j] = (z * A.ca + A.cb) * r;
                        if (MODE == 1) { s2 += v[j]; q2 += v[j] * v[j]; }
                    }
                }
                u32x4 w; w.x = pg8::cvt_pk_bf16(v[0].x, v[0].y); w.y = pg8::cvt_pk_bf16(v[1].x, v[1].y); w.z = pg8::cvt_pk_bf16(v[2].x, v[2].y); w.w = pg8::cvt_pk_bf16(v[3].x, v[3].y);
                *(u32x4*)(rowp + bj * 128) = lane_tr4(T, w);
            }
            if (MODE == 1) {
                float s = s2.x + s2.y, q = q2.x + q2.y;
                s += __shfl_xor(s, 16); s += __shfl_xor(s, 32); q += __shfl_xor(q, 16); q += __shfl_xor(q, 32);
                if (fq == 0) stat[(size_t)(rowm + fr) * 16 + statcol] = (f32x2){s, q};
            }
        }
}

struct ProbB {
    static constexpr bool PERM = true, GATHER = false; static constexpr int KSEG = 0; static constexpr int EPI_OPS = 16; static constexpr int PRE = 0;
    int K, G, c; unsigned char* ws; bf16* dout;
    __device__ __forceinline__ bool next(int i, Unit& u) const {
        const long L = (long)i * G + c; if (L >= 4096 + 128) return false;
        if (L < 4096) { pg8::tile_order((int)L, 128, 32, u.pm, u.pn); u.aux = 0; }
        else if (L < 4096 + 64) { const int l = (int)L - 4096; u.pm = l >> 2; u.pn = l & 3; u.aux = 1; }
        else { const int l = (int)L - 4160; u.pm = l >> 4; u.pn = l & 15; u.aux = 2; }
        return true;
    }
    __device__ __forceinline__ const char* abase(const Unit& u, int) const {
        const size_t o = u.aux == 0 ? WS_H0 + (size_t)u.pm * TSTEP1024 : u.aux == 1 ? WS_MEMB + (size_t)u.pm * TSTEP1024 : WS_WKV + (size_t)(4 + u.pm) * TSTEP1024;
        return (const char*)ws + o; }
    __device__ __forceinline__ const char* bbase(const Unit& u, int) const {
        const size_t o = u.aux == 0 ? WS_WIN + (size_t)u.pn * TSTEP1024 : u.aux == 1 ? WS_WKV + (size_t)u.pn * TSTEP1024 : WS_MEMB + (size_t)u.pn * TSTEP1024;
        return (const char*)ws + o; }
    __device__ __forceinline__ void gather(const Unit&, int, unsigned (&)[2][2], int, int) const {}
    __device__ __forceinline__ void epi(const f32x4 (&acc)[2][2][4][2], const Unit& u, int wr, int wc, int fr, int fq, PG8_LAS const unsigned char* = nullptr) const {
        const int row0 = u.pm * 256 + wr * 64;
        if (u.aux == 0) {
            const int reg = u.pn >> 2, col0 = (u.pn & 3) * 256 + wc * 32;
            const size_t off = reg == 0 ? WS_U : reg == 1 ? WS_GV : reg == 2 ? WS_LX : reg == 3 ? WS_LG : reg == 4 ? WS_Q : WS_G0;
            bf16* O = reg < 6 ? (bf16*)(ws + off) : reg == 6 ? dout : dout + (size_t)T * 1024;
            if (reg == 2 || reg == 4) store_tile_uni<2>(acc, O, 1024, row0, col0, act_linear(reg == 2 ? 1.f : 0.0625f), nullptr, 0, fr, fq);
            else if (reg == 1) store_tile_uni<1>(acc, O, 1024, row0, col0, act_gelu(), (f32x2*)(ws + WS_VSTAT), (u.pn & 3) * 4 + wc, fr, fq);
            else store_tile_uni<0>(acc, O, 1024, row0, col0, (reg == 0 || reg == 3) ? act_gelu() : act_sigmoid(), nullptr, 0, fr, fq);
        } else {
            bf16* O = u.aux == 1 ? (bf16*)(ws + WS_KB) : (bf16*)(ws + WS_VT);
            store_tile_uni<2>(acc, O, u.aux == 1 ? 1024 : 4096, row0, u.pn * 256 + wc * 32, act_linear(1.f), nullptr, 0, fr, fq);
        }
    }
};

struct ProbD1 {
    static constexpr bool PERM = true, GATHER = false; static constexpr int KSEG = 16; static constexpr int EPI_OPS = 32; static constexpr int PRE = 1;
    int K, G, c; unsigned char* ws; bf16* dout;
    __device__ __forceinline__ bool next(int i, Unit& u) const {
        const long L = (long)i * G + c; if (L >= 512) return false;
        pg8::tile_order((int)L, 128, 4, u.pm, u.pn); u.aux = 0; return true;
    }
    __device__ __forceinline__ const char* abase(const Unit& u, int seg) const { return (const char*)ws + (seg == 0 ? WS_U : seg == 1 ? WS_LG : WS_Q) + (size_t)u.pm * TSTEP1024; }
    __device__ __forceinline__ const char* bbase(const Unit& u, int seg) const { return (const char*)ws + WS_WBR + (size_t)seg * 2 * MiB + (size_t)u.pn * TSTEP1024; }
    __device__ __forceinline__ void gather(const Unit&, int, unsigned (&)[2][2], int, int) const {}
    __device__ __forceinline__ const bf16* gate(int k) const { return k == 0 ? (const bf16*)(ws + WS_G0) : k == 1 ? dout : dout + (size_t)T * 1024; }
    __device__ __forceinline__ void khook(f32x4 (&acc)[2][2][4][2], const Unit& u, int seg, int wr, int wc, int fr, int fq, PG8_LAS const unsigned char* = nullptr) const {
        const LaneTr TR = lane_tr_make(fr, fq);
        const int row2 = u.pm * 256 + wr * 64 + TR.fr2, col2 = u.pn * 256 + wc * 32 + 8 * TR.fq2;
        const bf16* gp = gate(seg - 1); const bf16* gn = gate(seg);
#pragma unroll
        for (int ai = 0; ai < 2; ++ai)
#pragma unroll
            for (int m = 0; m < 4; ++m) {
                const size_t off = (size_t)(row2 + ai * 128 + m * 16) * 1024 + col2;
#pragma unroll
                for (int bj = 0; bj < 2; ++bj) {
                    const u32x4 a = lane_tr4_inv(TR, *(const u32x4*)(gp + off + bj * 128)), b = lane_tr4_inv(TR, *(const u32x4*)(gn + off + bj * 128));
                    const float pa[8] = {bflo(a.x), bfhi(a.x), bflo(a.y), bfhi(a.y), bflo(a.z), bfhi(a.z), bflo(a.w), bfhi(a.w)};
                    const float nb[8] = {bflo(b.x), bfhi(b.x), bflo(b.y), bfhi(b.y), bflo(b.z), bfhi(b.z), bflo(b.w), bfhi(b.w)};
#pragma unroll
                    for (int j = 0; j < 4; ++j) { acc[ai][bj][m][0][j] *= pa[j] * __builtin_amdgcn_rcpf(fmaxf(nb[j], 1e-30f)); acc[ai][bj][m][1][j] *= pa[4 + j] * __builtin_amdgcn_rcpf(fmaxf(nb[4 + j], 1e-30f)); }
                }
            }
    }
    __device__ __forceinline__ void epi(const f32x4 (&acc)[2][2][4][2], const Unit& u, int wr, int wc, int fr, int fq, PG8_LAS const unsigned char* = nullptr) const {
        const int row0 = u.pm * 256 + wr * 64 + fr, col0 = u.pn * 256 + wc * 32 + 8 * fq;
        const bf16* g2 = gate(2); bf16* M = (bf16*)(ws + WS_H0); const LaneTr TR = lane_tr_make(fr, fq);
#pragma unroll
        for (int ai = 0; ai < 2; ++ai)
#pragma unroll
            for (int m = 0; m < 4; ++m) {
                const size_t off = (size_t)(row0 + ai * 128 + m * 16) * 1024 + col0;
                const size_t off2 = (size_t)(row0 - fr + TR.fr2 + ai * 128 + m * 16) * 1024 + (col0 - 8 * fq + 8 * TR.fq2);
#pragma unroll
                for (int bj = 0; bj < 2; ++bj) {
                    const u32x4 b = lane_tr4_inv(TR, *(const u32x4*)(g2 + off2 + bj * 128));
                    const float nb[8] = {bflo(b.x), bfhi(b.x), bflo(b.y), bfhi(b.y), bflo(b.z), bfhi(b.z), bflo(b.w), bfhi(b.w)};
                    float v[8];
#pragma unroll
                    for (int j = 0; j < 4; ++j) { v[j] = acc[ai][bj][m][0][j] * fmaxf(nb[j], 1e-30f); v[4 + j] = acc[ai][bj][m][1][j] * fmaxf(nb[4 + j], 1e-30f); }
                    u32x4 w; w.x = pg8::cvt_pk_bf16(v[0], v[1]); w.y = pg8::cvt_pk_bf16(v[2], v[3]); w.z = pg8::cvt_pk_bf16(v[4], v[5]); w.w = pg8::cvt_pk_bf16(v[6], v[7]);
                    *(u32x4*)(M + off2 + bj * 128) = lane_tr4(TR, w);
                }
            }
    }
};

struct ProbD2 {
    static constexpr bool PERM = true, GATHER = false; static constexpr int KSEG = 0; static constexpr int EPI_OPS = 16; static constexpr int PRE = 0;
    int K, G, c; unsigned char* ws;
    __device__ __forceinline__ bool next(int i, Unit& u) const {
        const long L = (long)i * G + c; if (L >= 512) return false;
        pg8::tile_order((int)L, 128, 4, u.pm, u.pn); u.aux = 0; return true;
    }
    __device__ __forceinline__ const char* abase(const Unit& u, int) const { return (const char*)ws + WS_H0 + (size_t)u.pm * TSTEP1024; }
    __device__ __forceinline__ const char* bbase(const Unit& u, int) const { return (const char*)ws + WS_WOUT + (size_t)u.pn * TSTEP1024; }
    __device__ __forceinline__ void gather(const Unit&, int, unsigned (&)[2][2], int, int) const {}
    __device__ __forceinline__ void epi(const f32x4 (&acc)[2][2][4][2], const Unit& u, int wr, int wc, int fr, int fq, PG8_LAS const unsigned char* = nullptr) const {
        store_tile_uni<2>(acc, (bf16*)(ws + WS_MO), 1024, u.pm * 256 + wr * 64, u.pn * 256 + wc * 32, act_linear(1.f), nullptr, 0, fr, fq);
    }
};

struct ProbE1 {
    static constexpr bool PERM = true, GATHER = true; static constexpr int KSEG = 0; static constexpr int EPI_OPS = 8; static constexpr int PRE = 2;
    int K, G, c; unsigned char* ws; int n0, n1; PG8_LAS const int* te; const float* dout;
    __device__ __forceinline__ bool next(int i, Unit& u) const {
        static_assert(NCH == 2, "ProbE1::next is written for two chunks");
        long L = (long)i * G + c; const int u0 = 2 * (n0 + SHT), u1 = 2 * (n1 + SHT);
        if (L >= (long)u0 + u1) return false;
        int ch = 0, nt = n0;
        if (L >= u0) { L -= u0; ch = 1; nt = n1; }
        const int l2 = (int)L >> 1; u.pm = l2 < nt ? l2 : RTMAX + (l2 - nt); u.pn = (int)L & 1; u.ch = ch;
        u.aux = te[ch * (RTMAX + SHT) + u.pm]; return true;
    }
    __device__ __forceinline__ const char* abase(const Unit&, int) const { return (const char*)dout + 2048; }
    __device__ __forceinline__ const char* bbase(const Unit& u, int) const { return (const char*)ws + WS_WGU + (size_t)(u.aux * 2 + u.pn) * TSTEP1024; }
    __device__ __forceinline__ void gather(const Unit& u, int R0, unsigned (&v)[2][2], int C0, int) const {
        const u32x4 o = *(const u32x4*)((const unsigned*)(ws + WS_ROWOFF) + (size_t)u.ch * CROWS + u.pm * 256 + R0 * 4);
        const unsigned c2 = (unsigned)C0 * 2u;
        v[0][0] = o.x + c2; v[0][1] = o.y + c2; v[1][0] = o.z + c2; v[1][1] = o.w + c2;
    }
    __device__ __forceinline__ void rows_to_lds(const Unit& u, PG8_LAS unsigned char* dst, int slot, int t64, bool with_off) const {
        const size_t r0 = (size_t)u.ch * CROWS + u.pm * 256;
        if (with_off) *(PG8_LAS u32x4*)(dst + t64 * 16) = *(const u32x4*)((const unsigned*)(ws + WS_ROWOFF) + r0 + t64 * 4);
        *(PG8_LAS u32x4*)(dst + 1024 + slot * 1024 + t64 * 16) = *(const u32x4*)((const unsigned*)(ws + WS_ROWW) + r0 + t64 * 4);
    }
    __device__ __forceinline__ void epi(const f32x4 (&acc)[2][2][4][2], const Unit& u, int wr, int wc, int fr, int fq, PG8_LAS const unsigned char* lrw) const {
        const LaneTr TR = lane_tr_make(fr, fq);
        const int rl = wr * 64 + fr, rl2 = wr * 64 + TR.fr2, col2 = u.pn * 128 + wc * 32 + 8 * TR.fq2;
        bf16* H = (bf16*)(ws + WS_HB) + ((size_t)u.ch * CROWS + u.pm * 256) * 256;
#pragma unroll
        for (int ai = 0; ai < 2; ++ai)
#pragma unroll
            for (int m = 0; m < 4; ++m) {
                const int r = rl + ai * 128 + m * 16; const float rw = *(PG8_LAS const float*)(lrw + r * 4);
                float v[8];
#pragma unroll
                for (int j = 0; j < 4; ++j) {
                    const float g0 = acc[ai][0][m][0][j], u0 = acc[ai][1][m][0][j], g1 = acc[ai][0][m][1][j], u1 = acc[ai][1][m][1][j];
                    v[j] = g0 * fast_sigmoid(g0) * (u0 * rw); v[4 + j] = g1 * fast_sigmoid(g1) * (u1 * rw);
                }
                u32x4 w; w.x = pg8::cvt_pk_bf16(v[0], v[1]); w.y = pg8::cvt_pk_bf16(v[2], v[3]); w.z = pg8::cvt_pk_bf16(v[4], v[5]); w.w = pg8::cvt_pk_bf16(v[6], v[7]);
                *(u32x4*)(H + (size_t)(rl2 + ai * 128 + m * 16) * 256 + col2) = lane_tr4(TR, w);
            }
    }
};

struct ProbE2 {
    static constexpr bool PERM = true, GATHER = false; static constexpr int KSEG = 0; static constexpr int EPI_OPS = 16; static constexpr int PRE = 0;
    int K, G, c; unsigned char* ws; int chunk, ntile; PG8_LAS const int* te;
    __device__ __forceinline__ bool next(int i, Unit& u) const {
        const long L = (long)i * G + c; if (L >= 4 * (ntile + SHT)) return false;
        const int l4 = (int)L >> 2; u.pm = l4 < ntile ? l4 : RTMAX + (l4 - ntile); u.pn = (int)L & 3;
        u.aux = te[chunk * (RTMAX + SHT) + u.pm]; return true;
    }
    __device__ __forceinline__ const char* abase(const Unit& u, int) const { return (const char*)ws + WS_HB + ((size_t)chunk * CROWS + (size_t)u.pm * 256) * 512; }
    __device__ __forceinline__ const char* bbase(const Unit& u, int) const { return (const char*)ws + WS_WD + (size_t)(u.aux * 4 + u.pn) * TSTEP256; }
    __device__ __forceinline__ void gather(const Unit&, int, unsigned (&)[2][2], int, int) const {}
    __device__ __forceinline__ void epi(const f32x4 (&acc)[2][2][4][2], const Unit& u, int wr, int wc, int fr, int fq, PG8_LAS const unsigned char* = nullptr) const {
        const LaneTr TR = lane_tr_make(fr, fq);
        const int row0 = u.pm * 256 + wr * 64 + TR.fr2, col0 = u.pn * 256 + wc * 32 + 8 * TR.fq2;
        unsigned char* Y = ws + WS_Y;
#pragma unroll
        for (int ai = 0; ai < 2; ++ai)
#pragma unroll
            for (int m = 0; m < 4; ++m) {
                const int row = row0 + ai * 128 + m * 16;
                unsigned char* rowp = Y + (size_t)row * 1024 + col0;
#pragma unroll
                for (int bj = 0; bj < 2; ++bj) {
                    f32x4 a = acc[ai][bj][m][0] * YSCALE, b = acc[ai][bj][m][1] * YSCALE;
#pragma unroll
                    for (int j = 0; j < 4; ++j) { a[j] = fminf(fmaxf(a[j], -440.f), 440.f); b[j] = fminf(fmaxf(b[j], -440.f), 440.f); }
                    int w0 = __builtin_amdgcn_cvt_pk_fp8_f32(a[0], a[1], 0, false); w0 = __builtin_amdgcn_cvt_pk_fp8_f32(a[2], a[3], w0, true);
                    int w1 = __builtin_amdgcn_cvt_pk_fp8_f32(b[0], b[1], 0, false); w1 = __builtin_amdgcn_cvt_pk_fp8_f32(b[2], b[3], w1, true);
                    *(u32x2*)(rowp + bj * 128) = lane_tr2(TR, (u32x2){(unsigned)w0, (unsigned)w1});
                }
            }
    }
};
struct Args { const float* in[33]; float* out; unsigned char* ws; int ph_lo, ph_hi; };
static_assert(sizeof(Args) == 33 * 8 + 8 + 8 + 8, "Args has no padding");
struct Ctx {
    float* out; unsigned char* ws; LAS unsigned char* lds;
    int tid, lane, wave, G, bid, vcu;
};

__device__ __forceinline__ void transpose_item(const float* W, int ldw, bf16* WTn0, int ldt, LAS float* scr, int k0, int n0, int lane, bf16* WTlo  ) {
#pragma unroll 8
    for (int i = 0; i < 32; ++i) { const int kk = 2 * i + (lane >> 5); scr[kk * 33 + (lane & 31)] = W[(size_t)(k0 + kk) * ldw + n0 + (lane & 31)]; }
    LDS_WAIT(); asm volatile("" ::: "memory");
    const int c = lane & 7;
#pragma unroll
    for (int j = 0; j < 4; ++j) { const int n = (lane >> 3) + 8 * j; const LAS float* s = scr + (8 * c) * 33 + n;
        float f[8];
#pragma unroll
        for (int q = 0; q < 8; ++q) f[q] = s[q * 33];
        u32x4 o; o.x = pk2(f[0], f[1]); o.y = pk2(f[2], f[3]); o.z = pk2(f[4], f[5]); o.w = pk2(f[6], f[7]);
        *(u32x4*)(WTn0 + (size_t)n * ldt + k0 + 8 * c) = o;
        if (WTlo) {
#pragma unroll
            for (int q = 0; q < 8; ++q) f[q] -= bf2f(f2bf(f[q]));
            u32x4 p; p.x = pk2(f[0], f[1]); p.y = pk2(f[2], f[3]); p.z = pk2(f[4], f[5]); p.w = pk2(f[6], f[7]);
            *(u32x4*)(WTlo + (size_t)n * ldt + k0 + 8 * c) = p;
        } }
    LDS_WAIT(); asm volatile("" ::: "memory");
}

struct TItem { const float* src; bf16* dst; bf16* dstlo; int ldw, ldt; };
__device__ __forceinline__ void titem_load(const TItem& it, f32x4 (&r)[8], int lane) {
#pragma unroll
    for (int i = 0; i < 8; ++i) { const int idx = 64 * i + lane; r[i] = *(const f32x4*)(it.src + (size_t)(idx >> 3) * it.ldw + 4 * (idx & 7)); }
}
__device__ __forceinline__ void titem_store(const TItem& it, const f32x4 (&r)[8], LAS float* scr, int lane) {
#pragma unroll
    for (int i = 0; i < 8; ++i) { const int idx = 64 * i + lane; LAS float* s = scr + (idx >> 3) * 33 + 4 * (idx & 7); s[0] = r[i].x; s[1] = r[i].y; s[2] = r[i].z; s[3] = r[i].w; }
    LDS_WAIT(); asm volatile("" ::: "memory");
    const int c = lane & 7;
#pragma unroll
    for (int j = 0; j < 4; ++j) { const int n = (lane >> 3) + 8 * j; const LAS float* s = scr + (8 * c) * 33 + n;
        float f[8];
#pragma unroll
        for (int q = 0; q < 8; ++q) f[q] = s[q * 33];
        u32x4 o; o.x = pk2(f[0], f[1]); o.y = pk2(f[2], f[3]); o.z = pk2(f[4], f[5]); o.w = pk2(f[6], f[7]);
        *(u32x4*)(it.dst + (size_t)n * it.ldt + 8 * c) = o;
        if (it.dstlo) {
#pragma unroll
            for (int q = 0; q < 8; ++q) f[q] -= bf2f(f2bf(f[q]));
            u32x4 p; p.x = pk2(f[0], f[1]); p.y = pk2(f[2], f[3]); p.z = pk2(f[4], f[5]); p.w = pk2(f[6], f[7]);
            *(u32x4*)(it.dstlo + (size_t)n * it.ldt + 8 * c) = p;
        } }
    LDS_WAIT(); asm volatile("" ::: "memory");
}
#define TITEM_LOOP(get, it0, step, nitems, scr, lane) do { int _i = (it0); if (_i < (nitems)) { TItem _c = get(_i); f32x4 _r[8]; titem_load(_c, _r, lane); \
    for (;;) { const int _n = _i + (step); const bool _hn = _n < (nitems); TItem _x = _c; f32x4 _q[8]; if (_hn) { _x = get(_n); titem_load(_x, _q, lane); } \
        titem_store(_c, _r, scr, lane); if (!_hn) break; _c = _x; _i = _n; _Pragma("unroll") for (int _k = 0; _k < 8; ++_k) _r[_k] = _q[_k]; } } } while (0)

__device__ __forceinline__ void phase_p0(Ctx& X, const Args& A) {
    LAS float* scr = (LAS float*)(X.lds + X.wave * 16384);
    const int gw = X.vcu * 8 + X.wave, NGW = X.G * 8;
    unsigned char* ws = X.ws;
    constexpr int I_IN = 16 * 256, I_KV = 16 * 64, I_LR = 64, I_RT = 32;
    constexpr int NIT = I_IN + I_KV + 2 * I_LR + I_RT;
    auto get0 = [&](int it) -> TItem {
        int r = it;
        if (r < I_IN) { const int kb = r >> 8, nb = r & 255; return TItem{A.in[4] + (size_t)(64 * kb) * INC + 32 * nb, (bf16*)(ws + WS_WIN) + (size_t)(32 * nb) * 1024 + 64 * kb, nullptr, INC, 1024}; } r -= I_IN;
        if (r < I_KV) { const int kb = r >> 6, nb = r & 63; return TItem{A.in[16] + (size_t)(64 * kb) * 2048 + 32 * nb, (bf16*)(ws + WS_WKV) + (size_t)(32 * nb) * 1024 + 64 * kb, nullptr, 2048, 1024}; } r -= I_KV;
        if (r < 2 * I_LR) { const int which = r >= I_LR; if (which) r -= I_LR; const int g = r >> 3, kb = (r >> 2) & 1, nb = r & 3;
            return TItem{A.in[which ? 13 : 11] + g * 16384 + (64 * kb) * 128 + 32 * nb, (bf16*)(ws + (which ? WS_WI : WS_WA)) + g * 16384 + (32 * nb) * 128 + 64 * kb, nullptr, 128, 128}; } r -= 2 * I_LR;
        const int kb = r >> 1, nb = r & 1;
        return TItem{A.in[23] + (size_t)(64 * kb) * 64 + 32 * nb, (bf16*)(ws + WS_WR) + (size_t)(32 * nb) * 1024 + 64 * kb, (bf16*)(ws + WS_WR) + 65536 + (size_t)(32 * nb) * 1024 + 64 * kb, 64, 1024};
    };
    TITEM_LOOP(get0, gw, NGW, NIT, scr, X.lane);
    for (int i = X.bid * 512 + X.tid; i < 8 * 128 * 128; i += X.G * 512) { const int t = (i >> 7) & 127, s = i & 127; ((bf16*)(ws + WS_WSP))[i] = (bf16)(s <= t ? f2bf(A.in[7][i]) : 0u); }
    {
        const f32x4* gp = (const f32x4*)A.in[2] + X.lane; const f32x4* bp = (const f32x4*)A.in[3] + X.lane;
        f32x4 gg[4], bb[4];
#pragma unroll
        for (int j = 0; j < 4; ++j) { gg[j] = gp[64 * j]; bb[j] = bp[64 * j]; }
        f32x4 vn[4];
        { const f32x4* xr = (const f32x4*)(A.in[0] + (size_t)(gw < T ? gw : 0) * D) + X.lane;
#pragma unroll
          for (int j = 0; j < 4; ++j) vn[j] = xr[64 * j]; }
#pragma unroll 1
        for (int m = gw; m < T; m += NGW) {
            f32x4 v[4]; float s = 0.f;
#pragma unroll
            for (int j = 0; j < 4; ++j) v[j] = vn[j];
            { const int mn = m + NGW < T ? m + NGW : m; const f32x4* xr = (const f32x4*)(A.in[0] + (size_t)mn * D) + X.lane;
#pragma unroll
              for (int j = 0; j < 4; ++j) vn[j] = xr[64 * j]; }
#pragma unroll
            for (int j = 0; j < 4; ++j) s += (v[j].x + v[j].y) + (v[j].z + v[j].w);
            const float mean = wave_sum(s) * (1.f / D); float s2 = 0.f;
#pragma unroll
            for (int j = 0; j < 4; ++j) { v[j] = v[j] - mean; s2 += (v[j].x * v[j].x + v[j].y * v[j].y) + (v[j].z * v[j].z + v[j].w * v[j].w); }
            const float rstd = 1.f / sqrtf(wave_sum(s2) * (1.f / D) + LN_EPS);
            if (X.lane == 0) ((f32x2*)(ws + WS_XSTAT))[m] = (f32x2){mean, rstd};
            u32x2* o8 = (u32x2*)((bf16*)(ws + WS_H0) + (size_t)m * D) + X.lane;
#pragma unroll
            for (int j = 0; j < 4; ++j) { const f32x4 h = v[j] * rstd * gg[j] + bb[j]; o8[64 * j] = (u32x2){pk2(h.x, h.y), pk2(h.z, h.w)}; }
        }
    }
    for (int m = gw; m < TM; m += 2 * NGW) {
        const int m2 = m + NGW < TM ? m + NGW : m;
        const f32x4* xr = (const f32x4*)(A.in[1] + (size_t)m * D) + X.lane; u32x2* o8 = (u32x2*)((bf16*)(ws + WS_MEMB) + (size_t)m * D) + X.lane;
        const f32x4* xr2 = (const f32x4*)(A.in[1] + (size_t)m2 * D) + X.lane; u32x2* o82 = (u32x2*)((bf16*)(ws + WS_MEMB) + (size_t)m2 * D) + X.lane;
        f32x4 h[4], h2[4];
#pragma unroll
        for (int j = 0; j < 4; ++j) { h[j] = xr[64 * j]; h2[j] = xr2[64 * j]; }
#pragma unroll
        for (int j = 0; j < 4; ++j) { o8[64 * j] = (u32x2){pk2(h[j].x, h[j].y), pk2(h[j].z, h[j].w)}; o82[64 * j] = (u32x2){pk2(h2[j].x, h2[j].y), pk2(h2[j].z, h2[j].w)}; }
    }
}

__device__ __forceinline__ void conv_wbr(Ctx& X, const Args& A) {
    LAS float* scr = (LAS float*)(X.lds + X.wave * 16384);
    const int gw = X.vcu * 8 + X.wave, NGW = X.G * 8;
    auto getw = [&](int it) -> TItem { const int which = it >> 9, r = it & 511, kb = r >> 5, nb = r & 31;
        return TItem{A.in[17 + which] + (size_t)(64 * kb) * 1024 + 32 * nb, (bf16*)(X.ws + WS_WBR) + (size_t)which * 1048576 + (size_t)(32 * nb) * 1024 + 64 * kb, nullptr, 1024, 1024}; };
    TITEM_LOOP(getw, gw, NGW, 4 * 512, scr, X.lane);
}
__device__ __forceinline__ void conv_experts(Ctx& X, const Args& A) {
    LAS float* scr = (LAS float*)(X.lds + X.wave * 16384);
    const int gw = X.vcu * 8 + X.wave, NGW = X.G * 8;
    auto gete = [&](int it) -> TItem {
        const int e = it / 384, r = it % 384, which = r >> 7, q = r & 127;
        if (which < 2) { const int kb = q >> 3, nb = q & 7, n0 = 32 * nb;
            const float* W = e < 64 ? A.in[25 + which] + (size_t)e * 1024 * 256 : A.in[28 + which];
            return TItem{W + (size_t)(64 * kb) * 256 + n0, (bf16*)(X.ws + WS_WGU) + ((size_t)(e * 2 + (n0 >> 7)) * 256 + which * 128 + (n0 & 127)) * 1024 + 64 * kb, nullptr, 256, 1024}; }
        const int kb = q >> 5, nb = q & 31;
        const float* W = e < 64 ? A.in[27] + (size_t)e * 256 * 1024 : A.in[30];
        return TItem{W + (size_t)(64 * kb) * 1024 + 32 * nb, (bf16*)(X.ws + WS_WD) + ((size_t)e * 1024 + 32 * nb) * 256 + 64 * kb, nullptr, 1024, 256}; };
    TITEM_LOOP(gete, gw, NGW, 65 * 384, scr, X.lane);
}

__device__ __forceinline__ int swz(int r, int ch, int rowbytes) { return r * rowbytes + (((ch & ~15) | ((ch ^ r) & 15)) << 4); }

#define GSWZ(r, ch) ((r) * 256 + ((((ch) ^ ((r) & 15) ^ (((r) >> 4) & 7)) & 15) << 4))
template <bool DRY = false> __device__ __forceinline__ void gmlp_units(Ctx& X, const Args& A) {
    unsigned char* ws = X.ws; LAS unsigned char* lds = X.lds;
    LAS f32x2* st = (LAS f32x2*)(lds + 32768);
    const int w = X.wave, l = X.lane, fr = l & 15, fq = l >> 4;
    int unit = X.bid; if (unit >= 2048) return;
    const int g = unit & 7, c0 = g * 128;
    const int ch = X.tid & 15, s0 = 4 * (X.tid >> 4);
    const int srow = X.tid >> 2, spart = X.tid & 3;
    bf16x8 wfr[4]; float gg[8], bb[8];
    { const bf16* Wg = (const bf16*)(ws + WS_WSP) + g * 16384 + (16 * w + fr) * 128 + 8 * fq;
#pragma unroll
      for (int kk = 0; kk < 4; ++kk) wfr[kk] = *(const bf16x8*)(Wg + 32 * kk);
#pragma unroll
      for (int j = 0; j < 8; ++j) { gg[j] = A.in[5][c0 + ch * 8 + j]; bb[j] = A.in[6][c0 + ch * 8 + j]; } }
    const float bs = A.in[8][g * 128 + 16 * w + fr];
    const LaneTr TR = lane_tr_make(fr, fq);
    f32x2 sp[4]; u32x4 gvq[4]; u32x2 uq[8], un[8];
#define GM_PREFETCH(unit_, udst) do { const int t0_ = ((unit_) >> 3) * 128; \
        _Pragma("unroll") for (int i = 0; i < 4; ++i) sp[i] = ((const f32x2*)(ws + WS_VSTAT))[(size_t)(t0_ + srow) * 16 + i * 4 + spart]; \
        _Pragma("unroll") for (int i = 0; i < 4; ++i) gvq[i] = *(const u32x4*)((const bf16*)(ws + WS_GV) + (size_t)(t0_ + s0 + i) * 1024 + c0 + ch * 8); \
        const bf16* up_ = (const bf16*)(ws + WS_U) + (size_t)(t0_ + 16 * w + TR.fr2) * 1024 + c0 + 4 * TR.fq2; \
        _Pragma("unroll") for (int cb = 0; cb < 8; ++cb) udst[cb] = *(const u32x2*)(up_ + 16 * cb); } while (0)
    GM_PREFETCH(unit, uq);
    for (; unit < 2048; unit += X.G) {
        const int t0 = (unit >> 3) * 128;
        { float s = (sp[0].x + sp[1].x) + (sp[2].x + sp[3].x), q = (sp[0].y + sp[1].y) + (sp[2].y + sp[3].y);
          s += __shfl_xor(s, 1); s += __shfl_xor(s, 2); q += __shfl_xor(q, 1); q += __shfl_xor(q, 2);
          const float mean = s * (1.f / 1024.f), var = q * (1.f / 1024.f) - mean * mean;
          if (spart == 0) st[srow] = (f32x2){mean, 1.f / sqrtf(var + LN_EPS)}; }
        __syncthreads();
        { float y[4][8];
#pragma unroll
          for (int i = 0; i < 4; ++i) { const f32x2 ms = st[s0 + i]; const u32x4 wv = gvq[i];
              const float v[8] = {bflo(wv.x), bfhi(wv.x), bflo(wv.y), bfhi(wv.y), bflo(wv.z), bfhi(wv.z), bflo(wv.w), bfhi(wv.w)};
#pragma unroll
              for (int j = 0; j < 8; ++j) y[i][j] = (v[j] - ms.x) * ms.y * gg[j] + bb[j]; }
#pragma unroll
          for (int j = 0; j < 8; ++j) { const int c = ch * 8 + j;
              *(LAS u32x2*)(lds + GSWZ(c, s0 >> 3) + (s0 & 7) * 2) = (u32x2){pk2(y[0][j], y[1][j]), pk2(y[2][j], y[3][j])}; } }
        const bool has_next = unit + X.G < 2048;
        if (has_next) GM_PREFETCH(unit + X.G, un);
        __syncthreads();
        f32x4 acc[8];
#pragma unroll
        for (int cb = 0; cb < 8; ++cb) acc[cb] = (f32x4){0.f, 0.f, 0.f, 0.f};
        const int kmax = w >> 1;
#pragma unroll
        for (int kk = 0; kk < 4; ++kk) {
            if (kk <= kmax) {
#pragma unroll
                for (int cb = 0; cb < 8; ++cb) {
                    const bf16x8 afr = *(const LAS bf16x8*)(lds + GSWZ(16 * cb + fr, 4 * kk + fq));
                    acc[cb] = __builtin_amdgcn_mfma_f32_16x16x32_bf16(afr, wfr[kk], acc[cb], 0, 0, 0);
                }
            }
        }
        const int t = 16 * w + TR.fr2;
        bf16* up = (bf16*)(ws + WS_U) + (size_t)(t0 + t) * 1024 + c0 + 4 * TR.fq2;
#pragma unroll
        for (int cb = 0; cb < 8; ++cb) {
            const u32x2 uw = lane_tr2_inv(TR, uq[cb]);
            const float y0 = bflo(uw.x) * (acc[cb][0] + bs), y1 = bfhi(uw.x) * (acc[cb][1] + bs), y2 = bflo(uw.y) * (acc[cb][2] + bs), y3 = bfhi(uw.y) * (acc[cb][3] + bs);
            bf16* op = DRY ? (bf16*)(ws + WS_MEMB) + (size_t)((t0 + t) & 4095) * 1024 + c0 + 4 * TR.fq2 : up;
            *(u32x2*)(op + 16 * cb) = lane_tr2(TR, (u32x2){pk2(y0, y1), pk2(y2, y3)});
        }
        if (has_next) {
#pragma unroll
            for (int cb = 0; cb < 8; ++cb) uq[cb] = un[cb]; }
        __syncthreads();
    }
#undef GM_PREFETCH
}

template <bool DRY = false> __device__ __forceinline__ void lru_unit(Ctx& X, const Args& A, int unit) {
    const int b = unit >> 4, g = (unit >> 1) & 7, half = unit & 1, c0 = g * 128, oc0 = c0 + half * 64;
    unsigned char* ws = X.ws; LAS unsigned char* lds = X.lds;
    constexpr int O_XC = 0, O_A = 32768, O_B = 65536, O_RAW = 98304, O_SA = 132096, O_SB = 134144, O_CY = 136192, O_CW = 136448;
    LAS float* La = (LAS float*)(lds + O_A); LAS float* Lb = (LAS float*)(lds + O_B);
    LAS float* SA = (LAS float*)(lds + O_SA); LAS float* SB = (LAS float*)(lds + O_SB); LAS float* CY = (LAS float*)(lds + O_CY); LAS float* CW = (LAS float*)(lds + O_CW);
    const int w = X.wave, l = X.lane, fr = l & 15, fq = l >> 4, ob = w & 3, th = w >> 2;
    const int cch = X.tid & 15;
    const bf16* wpa = (const bf16*)(ws + WS_WA) + g * 16384 + (half * 64 + 16 * ob + fr) * 128 + 8 * fq; const bf16* wpi = (const bf16*)(ws + WS_WI) + g * 16384 + (half * 64 + 16 * ob + fr) * 128 + 8 * fq;
    const int och = oc0 + 16 * ob + fr;
    const float ba = A.in[12][och], bi = A.in[14][och];
    const float lam = A.in[15][och];
    const float sp8 = 8.0f * (lam > 15.f ? __expf(-lam) : log1pf(__expf(-lam)));
    if (X.tid < 64) CY[X.tid] = 0.f;
    for (int i = X.tid; i < 640; i += 512) CW[i] = i < 512 ? A.in[9][(i >> 7) * 1024 + c0 + (i & 127)] : A.in[10][c0 + (i - 512)];
    u32x4 rawq[5];
#define LRU_RAWLOAD(n_) do { const int t0_ = b * SEQ + (n_) * 128; _Pragma("unroll") for (int i = 0; i < 5; ++i) { const int q = X.tid + 512 * i; const int row = q >> 4, ch = q & 15; \
        rawq[i] = (u32x4){0u, 0u, 0u, 0u}; if (q < 131 * 16 && ((n_) > 0 || row >= 3)) rawq[i] = *(const u32x4*)((const bf16*)(ws + WS_LX) + (size_t)(t0_ - 3 + row) * 1024 + c0 + ch * 8); } } while (0)
    LRU_RAWLOAD(0);
    bf16x8 wa[4], wi[4];
#pragma unroll
    for (int kk = 0; kk < 4; ++kk) { wa[kk] = *(const bf16x8*)(wpa + 32 * kk); wi[kk] = *(const bf16x8*)(wpi + 32 * kk); }
    const int o = X.tid & 63, sg = X.tid >> 6;
#pragma unroll 1
    for (int n = 0; n < 16; ++n) {
        const int t0 = b * SEQ + n * 128;
        u32x4 gq[2];
#pragma unroll
        for (int i = 0; i < 2; ++i) { const int q = X.tid + 512 * i; gq[i] = *(const u32x4*)((const bf16*)(ws + WS_LG) + (size_t)(t0 + (q >> 3)) * 1024 + oc0 + (q & 7) * 8); }
#pragma unroll
        for (int i = 0; i < 5; ++i) { const int q = X.tid + 512 * i; if (q < 131 * 16) *(LAS u32x4*)(lds + O_RAW + (q >> 4) * 256 + (q & 15) * 16) = rawq[i]; }
        __syncthreads();
        if (n + 1 < 16) LRU_RAWLOAD(n + 1);
#pragma unroll 1
        for (int ih = 0; ih < 4; ih += 2) {
            float a[2][8];
            { const f32x4 b0 = *(const LAS f32x4*)(CW + 512 + cch * 8), b1 = *(const LAS f32x4*)(CW + 512 + cch * 8 + 4);
#pragma unroll
              for (int i = 0; i < 2; ++i) { a[i][0] = b0.x; a[i][1] = b0.y; a[i][2] = b0.z; a[i][3] = b0.w; a[i][4] = b1.x; a[i][5] = b1.y; a[i][6] = b1.z; a[i][7] = b1.w; } }
#pragma unroll
            for (int k = 0; k < 4; ++k) { const f32x4 w0 = *(const LAS f32x4*)(CW + k * 128 + cch * 8), w1 = *(const LAS f32x4*)(CW + k * 128 + cch * 8 + 4);
                const float cw[8] = {w0.x, w0.y, w0.z, w0.w, w1.x, w1.y, w1.z, w1.w};
#pragma unroll
                for (int i = 0; i < 2; ++i) { const int t = (X.tid + 512 * (ih + i)) >> 4;
                    const u32x4 v = *(const LAS u32x4*)(lds + O_RAW + (t + 3 - k) * 256 + cch * 16);
                    const float xv[8] = {bflo(v.x), bfhi(v.x), bflo(v.y), bfhi(v.y), bflo(v.z), bfhi(v.z), bflo(v.w), bfhi(v.w)};
#pragma unroll
                    for (int j = 0; j < 8; ++j) a[i][j] += cw[j] * xv[j]; } }
#pragma unroll
            for (int i = 0; i < 2; ++i) { const int t = (X.tid + 512 * (ih + i)) >> 4;
                *(LAS u32x4*)(lds + O_XC + swz(t, cch, 256)) = (u32x4){pk2(a[i][0], a[i][1]), pk2(a[i][2], a[i][3]), pk2(a[i][4], a[i][5]), pk2(a[i][6], a[i][7])}; }
        }
        __syncthreads();
#pragma unroll
        for (int i = 0; i < 2; ++i) { const int q = X.tid + 512 * i; *(LAS u32x4*)(lds + O_RAW + (q >> 3) * 128 + (q & 7) * 16) = gq[i]; }
        {
            const int cx = half * 64 + 16 * ob + fr;
#pragma unroll 2
            for (int tb = 0; tb < 4; ++tb) {
                f32x4 pa = (f32x4){0.f, 0.f, 0.f, 0.f}, pi = (f32x4){0.f, 0.f, 0.f, 0.f};
#pragma unroll
                for (int kk = 0; kk < 4; ++kk) { const bf16x8 xa = *(const LAS bf16x8*)(lds + O_XC + swz(64 * th + 16 * tb + fr, 4 * kk + fq, 256));
                    pa = __builtin_amdgcn_mfma_f32_16x16x32_bf16(xa, wa[kk], pa, 0, 0, 0); pi = __builtin_amdgcn_mfma_f32_16x16x32_bf16(xa, wi[kk], pi, 0, 0, 0); }
#pragma unroll
                for (int r = 0; r < 4; ++r) { const int t = 64 * th + 16 * tb + 4 * fq + r;
                    const float ra = fast_sigmoid(pa[r] + ba), ri = fast_sigmoid(pi[r] + bi);
                    const float x2 = -2.f * ra * sp8;
                    const float a = __builtin_amdgcn_exp2f(0.72134752f * x2);
                    const float em = x2 > -0.25f ? -x2 * (1.f + x2 * (0.5f + x2 * (0.16666667f + x2 * 0.041666668f))) : 1.f - a * a;
                    const float mult = __builtin_amdgcn_sqrtf(em);
                    const float xc = bf2f(*(const LAS bf16*)(lds + O_XC + swz(t, cx >> 3, 256) + (cx & 7) * 2));
                    La[t * 64 + 16 * ob + fr] = a; Lb[t * 64 + 16 * ob + fr] = mult * ri * xc; }
            }
        }
        __syncthreads();
        float ac[16], pl[16];
        { float Ag = 1.f, Bc = 0.f;
#pragma unroll
            for (int j = 0; j < 16; ++j) { const float a = La[(16 * sg + j) * 64 + o], bt = Lb[(16 * sg + j) * 64 + o]; Ag *= a; Bc = a * Bc + bt; ac[j] = Ag; pl[j] = Bc; }
            SA[sg * 64 + o] = Ag; SB[sg * 64 + o] = Bc; }
        __syncthreads();
        float h = CY[o];
        for (int s2 = 0; s2 < sg; ++s2) h = SA[s2 * 64 + o] * h + SB[s2 * 64 + o];
        { LAS bf16* yt = (LAS bf16*)(lds + O_RAW) + (16 * sg) * 64 + o; const float hin = h;
#pragma unroll
            for (int j = 0; j < 16; ++j) { h = pl[j] + ac[j] * hin; yt[j * 64] = (bf16)f2bf(h * bf2f(yt[j * 64])); } }
        __syncthreads();
        if (sg == 7) CY[o] = h;
#pragma unroll
        for (int i = 0; i < 2; ++i) { const int q = X.tid + 512 * i; bf16* ob_ = DRY ? (bf16*)(ws + WS_MEMB) + (size_t)((t0 + (q >> 3)) & 4095) * 1024 : (bf16*)(ws + WS_LG) + (size_t)(t0 + (q >> 3)) * 1024;
            *(u32x4*)(ob_ + oc0 + (q & 7) * 8) = *(const LAS u32x4*)(lds + O_RAW + (q >> 3) * 128 + (q & 7) * 16); }
        __syncthreads();
    }
#undef LRU_RAWLOAD
    __syncthreads();
}

__device__ __forceinline__ void attn_unit(Ctx& X, const Args& A, int unit) {
    const int b = unit >> 5, h = (unit >> 3) & 3, qt = unit & 7, t0 = b * SEQ + qt * 256;
    unsigned char* ws = X.ws; LAS unsigned char* lds = X.lds;
    const int w = X.wave, l = X.lane, fr = l & 15, fq = l >> 4;
    int fb[4];
#pragma unroll
    for (int k = 0; k < 4; ++k) fb[k] = fr * 512 + ((((4 * k + fq) ^ fr) & 15) << 4);
    const int wb = (X.tid >> 5) * 512 + (((X.tid & 31) & 16) << 4) + ((((X.tid & 31) ^ (X.tid >> 5)) & 15) << 4);
    const LaneTr TR = lane_tr_make(fr, fq);
    u32x4 qraw[2][8];
#pragma unroll
    for (int rb = 0; rb < 2; ++rb) { const bf16* qrow = (const bf16*)(ws + WS_Q) + (size_t)(t0 + 32 * w + 16 * rb + TR.fr2) * 1024 + h * 256 + 8 * TR.fq2;
#pragma unroll
        for (int kk = 0; kk < 8; ++kk) qraw[rb][kk] = *(const u32x4*)(qrow + 32 * kk); }
#pragma unroll 1
    for (int i0 = 0; i0 < 16; i0 += 8) {
#pragma unroll
        for (int i = 0; i < 8; ++i) { const int q = X.tid + 512 * (i0 + i), rho = q >> 5, ch = q & 31;
            const int key = 32 * (rho >> 5) + 8 * ((rho >> 2) & 3) + 4 * ((rho >> 4) & 1) + (rho & 3);
            *(LAS u32x4*)(lds + wb + (i0 + i) * 8192) = *(const u32x4*)((const bf16*)(ws + WS_KB) + (size_t)(b * 256 + key) * 1024 + h * 256 + ch * 8); }
    }
    __syncthreads();
    bf16x8 pf[2][8]; float inv[2];
    {
        bf16x8 qf[2][8];
#pragma unroll
        for (int rb = 0; rb < 2; ++rb)
#pragma unroll
            for (int kk = 0; kk < 8; ++kk) qf[rb][kk] = __builtin_bit_cast(bf16x8, lane_tr4_inv(TR, qraw[rb][kk]));
        f32x4 s[2][16];
#pragma unroll
        for (int blk = 0; blk < 16; ++blk) { s[0][blk] = (f32x4){0.f, 0.f, 0.f, 0.f}; s[1][blk] = (f32x4){0.f, 0.f, 0.f, 0.f};
#pragma unroll
            for (int kk = 0; kk < 8; ++kk) { const bf16x8 kf = *(const LAS bf16x8*)(lds + fb[kk & 3] + blk * 8192 + (kk >> 2) * 256);
                s[0][blk] = __builtin_amdgcn_mfma_f32_16x16x32_bf16(kf, qf[0][kk], s[0][blk], 0, 0, 0);
                s[1][blk] = __builtin_amdgcn_mfma_f32_16x16x32_bf16(kf, qf[1][kk], s[1][blk], 0, 0, 0); } }
#pragma unroll
        for (int rb = 0; rb < 2; ++rb) {
            float mx = -3.0e38f;
#pragma unroll
            for (int blk = 0; blk < 16; ++blk) mx = fmaxf(fmaxf(fmaxf(s[rb][blk][0], s[rb][blk][1]), fmaxf(s[rb][blk][2], s[rb][blk][3])), mx);
            mx = fmaxf(mx, __shfl_xor(mx, 16)); mx = fmaxf(mx, __shfl_xor(mx, 32));
            float sum = 0.f;
#pragma unroll
            for (int kk = 0; kk < 8; ++kk) { float pe[8];
#pragma unroll
                for (int r = 0; r < 4; ++r) { pe[r] = __builtin_amdgcn_exp2f((s[rb][2 * kk][r] - mx) * 1.4426950408889634f); pe[4 + r] = __builtin_amdgcn_exp2f((s[rb][2 * kk + 1][r] - mx) * 1.4426950408889634f); }
                sum += ((pe[0] + pe[1]) + (pe[2] + pe[3])) + ((pe[4] + pe[5]) + (pe[6] + pe[7]));
                u32x4 pw; pw.x = pk2(pe[0], pe[1]); pw.y = pk2(pe[2], pe[3]); pw.z = pk2(pe[4], pe[5]); pw.w = pk2(pe[6], pe[7]);
                pf[rb][kk] = __builtin_bit_cast(bf16x8, pw); }
            sum += __shfl_xor(sum, 16); sum += __shfl_xor(sum, 32);
            inv[rb] = 1.0f / sum;
            asm volatile("" ::: "memory");
        }
    }
    __syncthreads();
#pragma unroll 1
    for (int i0 = 0; i0 < 16; i0 += 8) {
#pragma unroll
        for (int i = 0; i < 8; ++i) { const int q = X.tid + 512 * (i0 + i), d = q >> 5, ch = q & 31;
            *(LAS u32x4*)(lds + wb + (i0 + i) * 8192) = *(const u32x4*)((const bf16*)(ws + WS_VT) + (size_t)(h * 256 + d) * 4096 + b * 256 + ch * 8); }
    }
    __syncthreads();
#pragma unroll
    for (int db = 0; db < 16; ++db) { f32x4 o0 = (f32x4){0.f, 0.f, 0.f, 0.f}, o1 = (f32x4){0.f, 0.f, 0.f, 0.f};
#pragma unroll
        for (int kk = 0; kk < 8; ++kk) { const bf16x8 vf = *(const LAS bf16x8*)(lds + fb[kk & 3] + db * 8192 + (kk >> 2) * 256);
            o0 = __builtin_amdgcn_mfma_f32_16x16x32_bf16(vf, pf[0][kk], o0, 0, 0, 0); o1 = __builtin_amdgcn_mfma_f32_16x16x32_bf16(vf, pf[1][kk], o1, 0, 0, 0); }
        bf16* orow = (bf16*)(ws + WS_Q) + (size_t)(t0 + 32 * w + TR.fr2) * 1024 + h * 256 + 16 * db + 4 * TR.fq2;
        *(u32x2*)(orow) = lane_tr2(TR, (u32x2){pk2(o0[0] * inv[0], o0[1] * inv[0]), pk2(o0[2] * inv[0], o0[3] * inv[0])});
        *(u32x2*)(orow + 16 * 1024) = lane_tr2(TR, (u32x2){pk2(o1[0] * inv[1], o1[1] * inv[1]), pk2(o1[2] * inv[1], o1[3] * inv[1])}); }
    __syncthreads();
}

__device__ __forceinline__ void route_block(Ctx& X, const Args& A, int blk) {
    unsigned char* ws = X.ws; LAS unsigned char* lds = X.lds;
    LAS float* GB = (LAS float*)(lds + 65536);
    LAS f32x4* ST = (LAS f32x4*)(lds + 81920);
    LAS float* LG = (LAS float*)(lds + 83968);
    LAS int* HI = (LAS int*)(lds + 117248);
    LAS float* RB = (LAS float*)(lds + 117504);
    LAS unsigned long long* KEY = (LAS unsigned long long*)lds;
    const int w = X.wave, l = X.lane, fr = l & 15, fq = l >> 4;
    if (X.tid < 64) { RB[X.tid] = A.in[24][X.tid]; HI[X.tid] = 0; }
    for (int i = X.tid; i < 4096; i += 512) GB[i] = i < 1024 ? A.in[21][i] : i < 2048 ? A.in[22][i - 1024] : i < 3072 ? A.in[2][i - 2048] : A.in[3][i - 3072];
    {
        f32x4 gi[4], bi[4];
#pragma unroll
        for (int j = 0; j < 4; ++j) { gi[j] = ((const f32x4*)A.in[2] + l)[64 * j]; bi[j] = ((const f32x4*)A.in[3] + l)[64 * j]; }
        f32x4 va[4], vb[4]; u32x2 ma[4], mb[4]; f32x2 xa, xb;
#define R1_SLOAD(vd, md, xd, r_) do { const int m = blk * 128 + 16 * w + ((r_) < 16 ? (r_) : 15); const f32x4* xr = (const f32x4*)(A.in[0] + (size_t)m * D) + l; \
            const u32x2* mr = (const u32x2*)((const bf16*)(ws + WS_MO) + (size_t)m * D) + l; xd = ((const f32x2*)(ws + WS_XSTAT))[m]; \
            _Pragma("unroll") for (int j = 0; j < 4; ++j) { vd[j] = xr[64 * j]; md[j] = mr[64 * j]; } } while (0)
        R1_SLOAD(va, ma, xa, 0); R1_SLOAD(vb, mb, xb, 1);
#pragma unroll 1
        for (int r = 0; r < 16; ++r) {
            f32x4 v[4]; u32x2 mq[4]; const f32x2 xs = xa;
#pragma unroll
            for (int j = 0; j < 4; ++j) { v[j] = va[j]; mq[j] = ma[j]; va[j] = vb[j]; ma[j] = mb[j]; }
            xa = xb;
            R1_SLOAD(vb, mb, xb, r + 2);
            float s = 0.f;
#pragma unroll
            for (int j = 0; j < 4; ++j) { const f32x4 mo = (f32x4){bflo(mq[j].x), bfhi(mq[j].x), bflo(mq[j].y), bfhi(mq[j].y)};
                v[j] = DN_ALPHA * ((v[j] - xs.x) * xs.y * gi[j] + bi[j]) + mo; s += (v[j].x + v[j].y) + (v[j].z + v[j].w); }
            const float mean = wave_sum(s) * (1.f / D); float s2 = 0.f;
#pragma unroll
            for (int j = 0; j < 4; ++j) { const f32x4 d = v[j] - mean; s2 += (d.x * d.x + d.y * d.y) + (d.z * d.z + d.w * d.w); }
            const float rstd = 1.f / sqrtf(wave_sum(s2) * (1.f / D) + LN_EPS);
            if (l == 0) ST[16 * w + r] = (f32x4){xs.x, xs.y, mean, rstd};
        }
#undef R1_SLOAD
    }
    __syncthreads();
    {
        f32x4 acc[4];
#pragma unroll
        for (int n = 0; n < 4; ++n) acc[n] = (f32x4){0.f, 0.f, 0.f, 0.f};
        const int row = blk * 128 + 16 * w + fr; const f32x4 st = ST[16 * w + fr];
        const float* tr = A.in[0] + (size_t)row * D + 8 * fq; const bf16* mr = (const bf16*)(ws + WS_MO) + (size_t)row * D + 8 * fq; bf16* hr = (bf16*)X.out + (size_t)row * 2048 + 1024 + 8 * fq;
        u32x4 wq[4]; f32x4 t0, t1, n0, n1; u32x4 m0, mn;
#define R1_WLOAD(c) do { _Pragma("unroll") for (int i = 0; i < 4; ++i) { const int p_ = X.tid + 512 * i; \
            wq[i] = *(const u32x4*)((const bf16*)(ws + WS_WR) + (size_t)(p_ >> 10) * 65536 + (size_t)((p_ >> 4) & 63) * 1024 + (c) * 128 + (p_ & 15) * 8); } } while (0)
#define R1_WSTORE(c) do { _Pragma("unroll") for (int i = 0; i < 4; ++i) { const int p_ = X.tid + 512 * i; \
            *(LAS u32x4*)(lds + ((c) & 1) * 32768 + (p_ >> 10) * 16384 + swz((p_ >> 4) & 63, p_ & 15, 256)) = wq[i]; } } while (0)
        R1_WLOAD(0); t0 = *(const f32x4*)(tr); t1 = *(const f32x4*)(tr + 4); m0 = *(const u32x4*)(mr); R1_WSTORE(0);
        __syncthreads();
#pragma unroll 1
        for (int c = 0; c < 8; ++c) {
            if (c + 1 < 8) R1_WLOAD(c + 1);
            const LAS unsigned char* wb = lds + (c & 1) * 32768;
#pragma unroll
            for (int k = 0; k < 4; ++k) {
                const int kb = c * 128 + 32 * k + 8 * fq;
                { const int kn = (c * 4 + k + 1 < 32) ? (c * 128 + 32 * k + 32) : 0; n0 = *(const f32x4*)(tr + kn); n1 = *(const f32x4*)(tr + kn + 4); mn = *(const u32x4*)(mr + kn); }
                const f32x4 g0 = *(const LAS f32x4*)(GB + kb), g1 = *(const LAS f32x4*)(GB + kb + 4), b0 = *(const LAS f32x4*)(GB + 1024 + kb), b1 = *(const LAS f32x4*)(GB + 1024 + kb + 4);
                const f32x4 i0 = *(const LAS f32x4*)(GB + 2048 + kb), i1 = *(const LAS f32x4*)(GB + 2048 + kb + 4), j0 = *(const LAS f32x4*)(GB + 3072 + kb), j1 = *(const LAS f32x4*)(GB + 3072 + kb + 4);
                const f32x4 ma = (f32x4){bflo(m0.x), bfhi(m0.x), bflo(m0.y), bfhi(m0.y)}, mb = (f32x4){bflo(m0.z), bfhi(m0.z), bflo(m0.w), bfhi(m0.w)};
                const f32x4 ta = DN_ALPHA * ((t0 - st.x) * st.y * i0 + j0) + ma, tb = DN_ALPHA * ((t1 - st.x) * st.y * i1 + j1) + mb;
                const f32x4 h0 = (ta - st.z) * st.w * g0 + b0, h1 = (tb - st.z) * st.w * g1 + b1;
                const unsigned q0 = f2bf(h0.x), q1 = f2bf(h0.y), q2 = f2bf(h0.z), q3 = f2bf(h0.w), q4 = f2bf(h1.x), q5 = f2bf(h1.y), q6 = f2bf(h1.z), q7 = f2bf(h1.w);
                const u32x4 hw = (u32x4){q0 | (q1 << 16), q2 | (q3 << 16), q4 | (q5 << 16), q6 | (q7 << 16)};
                const u32x4 lw = (u32x4){pk2(h0.x - bf2f(q0), h0.y - bf2f(q1)), pk2(h0.z - bf2f(q2), h0.w - bf2f(q3)), pk2(h1.x - bf2f(q4), h1.y - bf2f(q5)), pk2(h1.z - bf2f(q6), h1.w - bf2f(q7))};
                *(u32x4*)(hr + c * 128 + 32 * k) = hw;
                const bf16x8 xh = __builtin_bit_cast(bf16x8, hw), xl = __builtin_bit_cast(bf16x8, lw);
#pragma unroll
                for (int n = 0; n < 4; ++n) { const bf16x8 wh = *(const LAS bf16x8*)(wb + swz(16 * n + fr, 4 * k + fq, 256)), wl = *(const LAS bf16x8*)(wb + 16384 + swz(16 * n + fr, 4 * k + fq, 256));
                    acc[n] = __builtin_amdgcn_mfma_f32_16x16x32_bf16(xh, wh, acc[n], 0, 0, 0);
                    acc[n] = __builtin_amdgcn_mfma_f32_16x16x32_bf16(xh, wl, acc[n], 0, 0, 0);
                    acc[n] = __builtin_amdgcn_mfma_f32_16x16x32_bf16(xl, wh, acc[n], 0, 0, 0); }
                t0 = n0; t1 = n1; m0 = mn;
            }
            if (c + 1 < 8) R1_WSTORE(c + 1);
            __syncthreads();
        }
#undef R1_WLOAD
#undef R1_WSTORE
#pragma unroll
        for (int n = 0; n < 4; ++n)
#pragma unroll
            for (int r = 0; r < 4; ++r) { const int e = 16 * n + fr; const float sg = 1.0f / (1.0f + __expf(-acc[n][r])); const float ch = sg + RB[e];
                const unsigned cb = __builtin_bit_cast(unsigned, ch); const unsigned ob = cb ^ ((cb >> 31) ? 0xffffffffu : 0x80000000u);
                LG[(16 * w + 4 * fq + r) * 65 + e] = ch;
                KEY[(16 * w + 4 * fq + r) * 65 + e] = ((unsigned long long)ob << 32) | (unsigned)(63 - e); }
    }
    __syncthreads();
    const int tok = blk * 128 + X.tid;
    if (X.tid < 128) {
        const LAS float* ch = LG + X.tid * 65; LAS unsigned long long* ky = KEY + X.tid * 65;
        float gs[8];
#pragma unroll
        for (int g = 0; g < 8; ++g) { float m1 = -3.0e38f, m2 = -3.0e38f;
#pragma unroll
            for (int j = 0; j < 8; ++j) { const float v = ch[g * 8 + j]; if (v > m1) { m2 = m1; m1 = v; } else if (v > m2) m2 = v; }
            gs[g] = m1 + m2; }
        unsigned gmask = 0u; int gl[4];
#pragma unroll
        for (int it = 0; it < 4; ++it) { float best = -3.0e38f; int bi = 0;
#pragma unroll
            for (int g = 0; g < 8; ++g) { const bool ok = !((gmask >> g) & 1u) && gs[g] > best; best = ok ? gs[g] : best; bi = ok ? g : bi; }
            gmask |= 1u << bi; gl[it] = bi; }
        int idx[8]; float wt[8]; float wsum = 0.f;
#pragma unroll
        for (int k = 0; k < 8; ++k) { unsigned long long best = 0ull;
#pragma unroll
            for (int q = 0; q < 4; ++q)
#pragma unroll
                for (int j = 0; j < 8; ++j) { const unsigned long long v = ky[gl[q] * 8 + j]; best = v > best ? v : best; }
            const int be = 63 - (int)(best & 63ull); ky[be] = 0ull; idx[k] = be; wt[k] = ch[be] - RB[be]; wsum += wt[k]; }
        const float sc2 = ROUTED_SCALE / wsum;
        int* ip = (int*)(ws + WS_IDX) + (size_t)tok * 8; float* wp = (float*)(ws + WS_WTS) + (size_t)tok * 8; int* rp = (int*)(ws + WS_RK) + (size_t)tok * 8;
#pragma unroll
        for (int k = 0; k < 8; ++k) { ip[k] = idx[k]; wp[k] = wt[k] * sc2; rp[k] = atomicAdd((int*)(HI + idx[k]), 1); }
    }
    __syncthreads();
    if (X.tid < 64) ((int*)(ws + WS_HIST))[blk * 64 + X.tid] = HI[X.tid];
    __syncthreads();
}

__device__ __forceinline__ void place_block(Ctx& X, const Args& A, int blk) {
    unsigned char* ws = X.ws; LAS unsigned char* lds = X.lds;
    LAS int* CNT = (LAS int*)lds; LAS int* PAD = CNT + 64; LAS int* BEF = CNT + 128; LAS int* PST = CNT + 192;
    const int chn = blk / BPC, jj = blk % BPC;
    if (X.tid < 64) { const int* hp = (const int*)(ws + WS_HIST) + (size_t)(chn * BPC) * 64 + X.tid; int cnt = 0, bef = 0;
        for (int j = 0; j < BPC; ++j) { const int v = hp[j * 64]; cnt += v; bef += (j < jj) ? v : 0; }
        CNT[X.tid] = cnt; PAD[X.tid] = (cnt + 255) & ~255; BEF[X.tid] = bef; }
    __syncthreads();
    if (X.tid == 0) { int ps = 0; for (int e = 0; e < 64; ++e) { PST[e] = ps; ps += PAD[e]; } PST[64] = ps; }
    __syncthreads();
    unsigned* rowoff = (unsigned*)(ws + WS_ROWOFF) + (size_t)chn * CROWS; float* roww = (float*)(ws + WS_ROWW) + (size_t)chn * CROWS;
#define ROWOFF_IDX(d) ((((d) >> 8) << 8) + (((d) & 63) << 2) + (((d) >> 6) & 3))
    if (X.tid < 128) { const int tok = blk * 128 + X.tid;
        const int* ip = (const int*)(ws + WS_IDX) + (size_t)tok * 8; const float* wp = (const float*)(ws + WS_WTS) + (size_t)tok * 8; const int* rp = (const int*)(ws + WS_RK) + (size_t)tok * 8;
        int* pp = (int*)(ws + WS_POS) + (size_t)tok * 8;
#pragma unroll
        for (int k = 0; k < 8; ++k) { const int e = ip[k]; const int dest = PST[e] + BEF[e] + rp[k]; rowoff[ROWOFF_IDX(dest)] = (unsigned)tok * 4096u; roww[dest] = wp[k]; pp[k] = dest; } }
    if (jj == 0) {
        for (int e = 0; e < 64; ++e) { const int st = PST[e] + CNT[e], en = PST[e] + PAD[e]; if (st + X.tid < en) { const int d = st + X.tid; rowoff[ROWOFF_IDX(d)] = (unsigned)(chn * CT) * 4096u; roww[d] = 0.f; } }
        int* te = (int*)(ws + WS_TILEE) + chn * (RTMAX + SHT);
        if (X.tid < 64) { for (int tl = PST[X.tid] >> 8; tl < (PST[X.tid] + PAD[X.tid]) >> 8; ++tl) te[tl] = X.tid; }
        if (X.tid < SHT) te[RTMAX + X.tid] = 64;
        if (X.tid == 0) ((int*)(ws + WS_NTILE))[chn] = PST[64] >> 8;
    }
    if (X.tid < 128) { const int i = jj * 128 + X.tid, d = RTMAX * 256 + i; rowoff[ROWOFF_IDX(d)] = (unsigned)(chn * CT + i) * 4096u; roww[d] = 1.0f; }
    __syncthreads();
}

template <bool DRY = false> __device__ __forceinline__ void combine_rows(Ctx& X, const Args& A, int chn) {
    unsigned char* ws = X.ws; int l_ = X.lane; asm volatile("" : "+v"(l_)); const int l = l_; const int gw = X.vcu * 8 + X.wave, NGW = X.G * 8;
    f32x4 g2[4], b2[4];
#pragma unroll
    for (int j = 0; j < 4; ++j) { g2[j] = ((const f32x4*)A.in[31] + l)[64 * j]; b2[j] = ((const f32x4*)A.in[32] + l)[64 * j]; }
    const unsigned char* Y = ws + WS_Y;
    const int nrows = (CT - gw + NGW - 1) / NGW;
    if (nrows <= 0) return;
#define F_ROW(i_) (gw + ((i_) < nrows ? (i_) : nrows - 1) * NGW)
#define F_LOADPOS(dst, i_) do { const int* pp_ = (const int*)(ws + WS_POS) + (size_t)(chn * CT + F_ROW(i_)) * 8; _Pragma("unroll") for (int k = 0; k < 8; ++k) dst[k] = __builtin_amdgcn_readfirstlane(pp_[k]); } while (0)
#define F_LOADROW(yd, hd, pos, i_) do { const int r_ = F_ROW(i_); \
        const u32x2* hq_ = (const u32x2*)((const bf16*)X.out + (size_t)(chn * CT + r_) * 2048 + 1024) + l;     \
        _Pragma("unroll") for (int j = 0; j < 4; ++j) hd[j] = hq_[64 * j]; \
        _Pragma("unroll") for (int k = 0; k < 9; ++k) { const int row_ = k < 8 ? pos[k < 8 ? k : 0] : RTMAX * 256 + r_; const unsigned* yr_ = (const unsigned*)(Y + (size_t)row_ * 1024) + l; \
            _Pragma("unroll") for (int j = 0; j < 4; ++j) yd[k][j] = yr_[64 * j]; } } while (0)
    int pc[8], pn[8];
    unsigned yc[9][4], yn[9][4]; u32x2 hc[4], hn[4];
    F_LOADPOS(pc, 0); F_LOADROW(yc, hc, pc, 0); F_LOADPOS(pn, 1);
#pragma unroll 1
    for (int i = 0; i < nrows; ++i) {
        F_LOADROW(yn, hn, pn, i + 1);
        F_LOADPOS(pc, i + 2);
        const int m = chn * CT + gw + i * NGW;
        f32x4 v[4]; float s, mean, s2, rstd;
#pragma unroll
        for (int j = 0; j < 4; ++j) v[j] = DN_ALPHA * (f32x4){bflo(hc[j].x), bfhi(hc[j].x), bflo(hc[j].y), bfhi(hc[j].y)};
        f32x4 ys[4] = {(f32x4){0.f, 0.f, 0.f, 0.f}, (f32x4){0.f, 0.f, 0.f, 0.f}, (f32x4){0.f, 0.f, 0.f, 0.f}, (f32x4){0.f, 0.f, 0.f, 0.f}};
#pragma unroll
        for (int k = 0; k < 9; ++k)
#pragma unroll
            for (int j = 0; j < 4; ++j) { const int y = (int)yc[k][j];
                ys[j].x += __builtin_amdgcn_cvt_f32_fp8(y, 0); ys[j].y += __builtin_amdgcn_cvt_f32_fp8(y, 1); ys[j].z += __builtin_amdgcn_cvt_f32_fp8(y, 2); ys[j].w += __builtin_amdgcn_cvt_f32_fp8(y, 3); }
#pragma unroll
        for (int j = 0; j < 4; ++j) v[j] += ys[j] * (1.0f / YSCALE);
        s = 0.f;
#pragma unroll
        for (int j = 0; j < 4; ++j) s += (v[j].x + v[j].y) + (v[j].z + v[j].w);
        mean = wave_sum(s) * (1.f / D); s2 = 0.f;
#pragma unroll
        for (int j = 0; j < 4; ++j) { v[j] = v[j] - mean; s2 += (v[j].x * v[j].x + v[j].y * v[j].y) + (v[j].z * v[j].z + v[j].w * v[j].w); }
        rstd = 1.f / sqrtf(wave_sum(s2) * (1.f / D) + LN_EPS);
        f32x4* xr = (f32x4*)(X.out + (size_t)m * D) + l;
#pragma unroll
        for (int j = 0; j < 4; ++j) { f32x4* orow = DRY ? (f32x4*)(ws + WS_HB + (size_t)chn * CROWS * 512 + (size_t)(gw + i * NGW) * 4096) + l : xr; orow[64 * j] = v[j] * rstd * g2[j] + b2[j]; }
#pragma unroll
        for (int k = 0; k < 9; ++k)
#pragma unroll
            for (int j = 0; j < 4; ++j) yc[k][j] = yn[k][j];
#pragma unroll
        for (int j = 0; j < 4; ++j) hc[j] = hn[j];
#pragma unroll
        for (int k = 0; k < 8; ++k) { const int t_ = pn[k]; pn[k] = pc[k]; pc[k] = t_; }
    }
#undef F_ROW
#undef F_LOADPOS
#undef F_LOADROW
}
#if MK_DEBUG
__device__ __forceinline__ unsigned hsh(unsigned x) { x ^= x >> 16; x *= 0x7feb352dU; x ^= x >> 15; x *= 0x846ca68bU; x ^= x >> 16; return x; }
__device__ __forceinline__ void dbg_fail(unsigned char* ws, int code) { atomicMin((int*)ws, code); }
__device__ __forceinline__ bool closef(float got, float ex, float rel, float ab) { return fabsf(got - ex) <= rel * fabsf(ex) + ab; }
__device__ __forceinline__ float rbf(float x) { return bf2f(f2bf(x)); }
__device__ __forceinline__ float wave_max(float v) {
#pragma unroll
    for (int o = 1; o < 64; o <<= 1) v = fmaxf(v, __shfl_xor(v, o));
    return v;
}
#define DBG_EXP(ws) ((float*)((ws) + 65536))

__device__ __forceinline__ void chk_B(Ctx& X, const Args& A) {
    unsigned char* ws = X.ws; const int gw = X.bid * 8 + X.wave, NGW = X.G * 8, l = X.lane;
    for (int s = gw; s < 4096; s += NGW) {
        const int t = hsh(2 * s + 1) % T, c = hsh(2 * s + 2) % 8192;
        float acc = 0.f;
        for (int k = l; k < 1024; k += 64) acc += bf2f(((const bf16*)(ws + WS_H0))[(size_t)t * 1024 + k]) * rbf(A.in[4][(size_t)k * 8192 + c]);
        const float z = wave_sum(acc); const int reg = c >> 10, cc = c & 1023;
        const float ex = (reg == 0 || reg == 1 || reg == 3) ? gelu_tanh(z) : reg == 2 ? z : reg == 4 ? z * 0.0625f : 1.f / (1.f + __expf(-z));
        const bf16* buf = reg == 0 ? (const bf16*)(ws + WS_U) : reg == 1 ? (const bf16*)(ws + WS_GV) : reg == 2 ? (const bf16*)(ws + WS_LX) : reg == 3 ? (const bf16*)(ws + WS_LG) : reg == 4 ? (const bf16*)(ws + WS_Q) :
                          reg == 5 ? (const bf16*)(ws + WS_G0) : reg == 6 ? (const bf16*)X.out : (const bf16*)X.out + (size_t)T * 1024;
        const float got = bf2f(buf[(size_t)t * 1024 + cc]);
        if (!closef(got, ex, 0.02f, 0.01f)) { dbg_fail(ws, 10 + reg); }
    }
    for (int s = gw; s < 1024; s += NGW) {
        const int m = hsh(3 * s + 7) % TM, c = hsh(3 * s + 8) % 2048;
        float acc = 0.f;
        for (int k = l; k < 1024; k += 64) acc += rbf(A.in[1][(size_t)m * 1024 + k]) * rbf(A.in[16][(size_t)k * 2048 + c]);
        const float z = wave_sum(acc);
        const float got = c < 1024 ? bf2f(((const bf16*)(ws + WS_KB))[(size_t)m * 1024 + c]) : bf2f(((const bf16*)(ws + WS_VT))[(size_t)(c - 1024) * 4096 + m]);
        if (!closef(got, z, 0.02f, 0.01f)) dbg_fail(ws, c < 1024 ? 18 : 19);
    }
    for (int s = gw; s < 512; s += NGW) {
        const int t = hsh(5 * s + 3) % T; float a = 0.f, q = 0.f;
        for (int k = l; k < 1024; k += 64) { const float v = bf2f(((const bf16*)(ws + WS_GV))[(size_t)t * 1024 + k]); a += v; q += v * v; }
        a = wave_sum(a); q = wave_sum(q);
        float pa = 0.f, pq = 0.f; if (l < 16) { const f32x2 p = ((const f32x2*)(ws + WS_VSTAT))[(size_t)t * 16 + l]; pa = p.x; pq = p.y; }
        pa = wave_sum(pa); pq = wave_sum(pq);
        if (!closef(pa, a, 0.01f, 0.5f) || !closef(pq, q, 0.01f, 0.5f)) dbg_fail(ws, 9);
    }
}

__device__ __forceinline__ void chk_C_pre(Ctx& X, const Args& A) {
    unsigned char* ws = X.ws; const int gw = X.bid * 8 + X.wave, NGW = X.G * 8, l = X.lane;
    float* EX = DBG_EXP(ws);
    for (int s = gw; s < 3 * 512; s += NGW) {
        const int kind = s / 512, si = s % 512;
        if (kind == 0) {
            const int t = hsh(7 * si + 1) % T, c = hsh(7 * si + 2) % 1024, g = c >> 7, t0 = t & ~127, tl = t - t0;
            float acc = 0.f;
            for (int sr = 0; sr <= tl; ++sr) {
                float a = 0.f, q = 0.f;
                for (int k = l; k < 1024; k += 64) { const float v = bf2f(((const bf16*)(ws + WS_GV))[(size_t)(t0 + sr) * 1024 + k]); a += v; q += v * v; }
                a = wave_sum(a); q = wave_sum(q);
                const float mean = a * (1.f / 1024.f), var = q * (1.f / 1024.f) - mean * mean, rstd = 1.f / sqrtf(var + LN_EPS);
                const float vn = (bf2f(((const bf16*)(ws + WS_GV))[(size_t)(t0 + sr) * 1024 + c]) - mean) * rstd * A.in[5][c] + A.in[6][c];
                acc += A.in[7][(g * 128 + tl) * 128 + sr] * vn;
            }
            EX[s] = bf2f(((const bf16*)(ws + WS_U))[(size_t)t * 1024 + c]) * (acc + A.in[8][g * 128 + tl]);
        } else if (kind == 1) {
            if (si >= 64) { EX[s] = 0.f; continue; }
            const int b = hsh(11 * si + 1) % NB, ch = hsh(11 * si + 2) % 1024, ts = hsh(11 * si + 3) % SEQ, g = ch >> 7, o = ch & 127;
            float xh[2][3] = {{0.f, 0.f, 0.f}, {0.f, 0.f, 0.f}}; float h = 0.f;
            const float lam = A.in[15][ch], sp = log1pf(__expf(-lam)), ba = A.in[12][ch], bi = A.in[14][ch];
            float cw[2][4], cb[2], wa[2], wi[2];
#pragma unroll
            for (int q = 0; q < 2; ++q) { const int i = g * 128 + l + 64 * q; cb[q] = A.in[10][i];
#pragma unroll
                for (int k = 0; k < 4; ++k) cw[q][k] = A.in[9][k * 1024 + i];
                wa[q] = rbf(A.in[11][(size_t)g * 16384 + (l + 64 * q) * 128 + o]); wi[q] = rbf(A.in[13][(size_t)g * 16384 + (l + 64 * q) * 128 + o]); }
            for (int t = 0; t <= ts; ++t) {
                float xc[2]; float pa = 0.f, pi = 0.f;
#pragma unroll
                for (int q = 0; q < 2; ++q) { const float x0 = bf2f(((const bf16*)(ws + WS_LX))[(size_t)(b * SEQ + t) * 1024 + g * 128 + l + 64 * q]);
                    xc[q] = rbf(cb[q] + cw[q][0] * x0 + cw[q][1] * xh[q][0] + cw[q][2] * xh[q][1] + cw[q][3] * xh[q][2]);
                    xh[q][2] = xh[q][1]; xh[q][1] = xh[q][0]; xh[q][0] = x0; pa += xc[q] * wa[q]; pi += xc[q] * wi[q]; }
                pa = wave_sum(pa); pi = wave_sum(pi);
                const float xo = __shfl(o < 64 ? xc[0] : xc[1], o & 63);
                const float r = 1.f / (1.f + __expf(-(pa + ba))), ii = 1.f / (1.f + __expf(-(pi + bi)));
                const float la = -8.f * r * sp, a = __expf(la), mult = sqrtf(-expm1f(2.f * la));
                h = a * h + mult * ii * xo;
            }
            EX[s] = h * bf2f(((const bf16*)(ws + WS_LG))[(size_t)(b * SEQ + ts) * 1024 + ch]);
        } else {
            const int t = hsh(13 * si + 1) % T, c = hsh(13 * si + 2) % 1024, hh = c >> 8, b = t / SEQ;
            float sc[4];
#pragma unroll
            for (int j = 0; j < 4; ++j) { const int m = l + 64 * j; float a = 0.f;
                for (int dd = 0; dd < 256; ++dd) a += bf2f(((const bf16*)(ws + WS_Q))[(size_t)t * 1024 + hh * 256 + dd]) * bf2f(((const bf16*)(ws + WS_KB))[(size_t)(b * 256 + m) * 1024 + hh * 256 + dd]);
                sc[j] = a; }
            const float mx = wave_max(fmaxf(fmaxf(sc[0], sc[1]), fmaxf(sc[2], sc[3])));
            float sum = 0.f, ov = 0.f;
#pragma unroll
            for (int j = 0; j < 4; ++j) { const float p = __expf(sc[j] - mx); sum += p; ov += p * bf2f(((const bf16*)(ws + WS_VT))[(size_t)c * 4096 + b * 256 + l + 64 * j]); }
            sum = wave_sum(sum); ov = wave_sum(ov);
            EX[s] = ov / sum;
        }
    }
}
__device__ __forceinline__ void chk_C_post(Ctx& X, const Args& A) {
    unsigned char* ws = X.ws; const float* EX = DBG_EXP(ws);
    for (int s = X.bid * 512 + X.tid; s < 3 * 512; s += X.G * 512) {
        const int kind = s / 512, si = s % 512; float got;
        if (kind == 0) { const int t = hsh(7 * si + 1) % T, c = hsh(7 * si + 2) % 1024; got = bf2f(((const bf16*)(ws + WS_U))[(size_t)t * 1024 + c]); }
        else if (kind == 1) { if (si >= 64) continue; const int b = hsh(11 * si + 1) % NB, ch = hsh(11 * si + 2) % 1024, ts = hsh(11 * si + 3) % SEQ; got = bf2f(((const bf16*)(ws + WS_LG))[(size_t)(b * SEQ + ts) * 1024 + ch]); }
        else { const int t = hsh(13 * si + 1) % T, c = hsh(13 * si + 2) % 1024; got = bf2f(((const bf16*)(ws + WS_Q))[(size_t)t * 1024 + c]); }
        if (!closef(got, EX[s], 0.04f, kind == 2 ? 0.004f : 0.02f)) dbg_fail(ws, 20 + kind);
    }
}
__device__ __forceinline__ void chk_D1(Ctx& X, const Args& A) {
    unsigned char* ws = X.ws; const int gw = X.bid * 8 + X.wave, NGW = X.G * 8, l = X.lane;
    for (int s = gw; s < 2048; s += NGW) {
        const int t = hsh(17 * s + 1) % T, c = hsh(17 * s + 2) % 1024; float ex = 0.f;
#pragma unroll
        for (int k = 0; k < 3; ++k) {
            const bf16* Y = (const bf16*)(ws + (k == 0 ? WS_U : k == 1 ? WS_LG : WS_Q)); const bf16* Gk = k == 0 ? (const bf16*)(ws + WS_G0) : k == 1 ? (const bf16*)X.out : (const bf16*)X.out + (size_t)T * 1024;
            float acc = 0.f;
            for (int j = l; j < 1024; j += 64) acc += bf2f(Y[(size_t)t * 1024 + j]) * rbf(A.in[17 + k][(size_t)j * 1024 + c]);
            ex += bf2f(Gk[(size_t)t * 1024 + c]) * wave_sum(acc);
        }
        const float got = bf2f(((const bf16*)(ws + WS_H0))[(size_t)t * 1024 + c]);
        if (!closef(got, ex, 0.02f, 0.01f)) dbg_fail(ws, 30);
    }
}
__device__ __forceinline__ void chk_D2(Ctx& X, const Args& A) {
    unsigned char* ws = X.ws; const int gw = X.bid * 8 + X.wave, NGW = X.G * 8, l = X.lane;
    for (int s = gw; s < 2048; s += NGW) {
        const int t = hsh(19 * s + 1) % T, c = hsh(19 * s + 2) % 1024;
        float a = 0.f, q = 0.f, acc = 0.f;
        for (int j = l; j < 1024; j += 64) { const float v = A.in[0][(size_t)t * 1024 + j]; a += v; q += v * v; acc += bf2f(((const bf16*)(ws + WS_H0))[(size_t)t * 1024 + j]) * rbf(A.in[20][(size_t)j * 1024 + c]); }
        a = wave_sum(a); q = wave_sum(q); acc = wave_sum(acc);
        const float mean = a * (1.f / 1024.f), var = q * (1.f / 1024.f) - mean * mean, rstd = 1.f / sqrtf(var + LN_EPS);
        const float ex = DN_ALPHA * ((A.in[0][(size_t)t * 1024 + c] - mean) * rstd * A.in[2][c] + A.in[3][c]) + acc;
        if (!closef(X.out[(size_t)t * 1024 + c], ex, 0.01f, 0.01f)) dbg_fail(ws, 31);
    }
}
__device__ __forceinline__ void chk_R1(Ctx& X, const Args& A) {
    unsigned char* ws = X.ws; const int gw = X.bid * 8 + X.wave, NGW = X.G * 8, l = X.lane;
    LAS float* hb = (LAS float*)(X.lds + X.wave * 8192); LAS float* cs = hb + 1024; LAS float* ss = cs + 64;
    int nmis = 0;
    for (int s = gw; s < 2048; s += NGW) {
        const int t = hsh(23 * s + 1) % T;
        float a = 0.f, q = 0.f;
        for (int j = l; j < 1024; j += 64) { const float v = X.out[(size_t)t * 1024 + j]; a += v; q += v * v; }
        a = wave_sum(a); q = wave_sum(q);
        const float mean = a * (1.f / 1024.f), var = q * (1.f / 1024.f) - mean * mean, rstd = 1.f / sqrtf(var + LN_EPS);
        bool badh = false;
        for (int j = l; j < 1024; j += 64) { const float h1 = (X.out[(size_t)t * 1024 + j] - mean) * rstd * A.in[21][j] + A.in[22][j]; hb[j] = h1;
            if (!closef(bf2f(((const bf16*)(ws + WS_H1))[(size_t)t * 1024 + j]), h1, 0.01f, 0.003f)) badh = true; }
        if (__any(badh)) dbg_fail(ws, 39);
        LDS_WAIT();
        float lg = 0.f;
        for (int k = 0; k < 1024; ++k) lg += hb[k] * A.in[23][k * 64 + l];
        const float sg = 1.f / (1.f + __expf(-lg)); ss[l] = sg; cs[l] = sg + A.in[24][l];
        LDS_WAIT();
        unsigned long long sel = 0ull, ksel = 0ull; float wsum = 0.f;
        {
            float gs[8]; unsigned gmask = 0u;
            for (int g = 0; g < 8; ++g) { float m1 = -3e38f, m2 = -3e38f; for (int j = 0; j < 8; ++j) { const float v = cs[g * 8 + j]; if (v > m1) { m2 = m1; m1 = v; } else if (v > m2) m2 = v; } gs[g] = m1 + m2; }
            for (int it = 0; it < 4; ++it) { float best = -3e38f; int bi = 0; for (int g = 0; g < 8; ++g) if (!((gmask >> g) & 1u) && gs[g] > best) { best = gs[g]; bi = g; } gmask |= 1u << bi; }
            for (int k = 0; k < 8; ++k) { float best = -3e38f; int be = 0; for (int e = 0; e < 64; ++e) { const float v = cs[e]; if (((gmask >> (e >> 3)) & 1u) && !((sel >> e) & 1ull) && v > best) { best = v; be = e; } } sel |= 1ull << be; wsum += ss[be]; }
        }
        const int* ip = (const int*)(ws + WS_IDX) + (size_t)t * 8; const float* wp = (const float*)(ws + WS_WTS) + (size_t)t * 8;
        bool wbad = false;
        for (int k = 0; k < 8; ++k) { const int e = ip[k]; if (e < 0 || e > 63) { dbg_fail(ws, 42); continue; } ksel |= 1ull << e; if (!closef(wp[k], ss[e] / wsum * ROUTED_SCALE, 0.01f, 1e-4f)) wbad = true; }
        if (ksel != sel) ++nmis; else if (wbad) dbg_fail(ws, 41);
        LDS_WAIT();
    }
    if (nmis > 0 && l == 0) atomicAdd((int*)ws + 4, nmis);
}
__device__ __forceinline__ void chk_R2(Ctx& X, const Args& A) {
    unsigned char* ws = X.ws;
    if (X.bid == 0 && X.tid == 0 && ((const int*)ws)[4] > 100) dbg_fail(ws, 40);
    for (int s = X.bid * 512 + X.tid; s < 16384; s += X.G * 512) {
        const int tok = hsh(29 * s + 1) % T, k = hsh(29 * s + 2) % 8, chn = tok / CT;
        const int dest = ((const int*)(ws + WS_POS))[tok * 8 + k], e = ((const int*)(ws + WS_IDX))[tok * 8 + k];
        const int nt = ((const int*)(ws + WS_NTILE))[chn];
        if (nt < CT / 32 || nt > RTMAX || dest < 0 || dest >= nt * 256) { dbg_fail(ws, 50); continue; }
        const unsigned ro = ((const unsigned*)(ws + WS_ROWOFF))[(size_t)chn * CROWS + ROWOFF_IDX(dest)];
        if (ro != (unsigned)tok * 2048u) dbg_fail(ws, 51);
        if (((const float*)(ws + WS_ROWW))[(size_t)chn * CROWS + dest] != ((const float*)(ws + WS_WTS))[tok * 8 + k]) dbg_fail(ws, 52);
        if (((const int*)(ws + WS_TILEE))[chn * (RTMAX + SHT) + (dest >> 8)] != e) dbg_fail(ws, 53);
    }
}
__device__ __forceinline__ void chk_E(Ctx& X, const Args& A, int chn, int which) {
    unsigned char* ws = X.ws; const int gw = X.bid * 8 + X.wave, NGW = X.G * 8, l = X.lane;
    const int nt = ((const int*)(ws + WS_NTILE))[chn];
    for (int s = gw; s < 2048; s += NGW) {
        const int ti = hsh(31 * s + 1 + chn) % (nt + SHT), tile = ti < nt ? ti : RTMAX + (ti - nt), row = tile * 256 + hsh(31 * s + 2) % 256;
        const int e = ((const int*)(ws + WS_TILEE))[chn * (RTMAX + SHT) + tile];
        if (e < 0 || e > 64) { dbg_fail(ws, 59); continue; }
        if (which == 0) {
            const int col = hsh(31 * s + 3) % 256;
            const unsigned tok = ((const unsigned*)(ws + WS_ROWOFF))[(size_t)chn * CROWS + ROWOFF_IDX(row)] / 2048u;
            const float* Wg = e < 64 ? A.in[25] + (size_t)e * 262144 : A.in[28]; const float* Wu = e < 64 ? A.in[26] + (size_t)e * 262144 : A.in[29];
            float ag = 0.f, au = 0.f;
            for (int k = l; k < 1024; k += 64) { const float hv = bf2f(((const bf16*)(ws + WS_H1))[(size_t)tok * 1024 + k]); ag += hv * rbf(Wg[(size_t)k * 256 + col]); au += hv * rbf(Wu[(size_t)k * 256 + col]); }
            ag = wave_sum(ag); au = wave_sum(au);
            const float ex = ag / (1.f + __expf(-ag)) * au;
            if (!closef(bf2f(((const bf16*)(ws + WS_HB))[((size_t)chn * CROWS + row) * 256 + col]), ex * ((const float*)(ws + WS_ROWW))[(size_t)chn * CROWS + row], 0.03f, 0.003f)) dbg_fail(ws, 60 + chn);
        } else {
            const int col = hsh(31 * s + 3) % 1024;
            const float* Wd = e < 64 ? A.in[27] + (size_t)e * 262144 : A.in[30];
            float acc = 0.f;
            for (int j = l; j < 256; j += 64) acc += bf2f(((const bf16*)(ws + WS_HB))[((size_t)chn * CROWS + row) * 256 + j]) * rbf(Wd[(size_t)j * 1024 + col]);
            acc = wave_sum(acc);
            { const int yw = ((const int*)(ws + WS_Y))[((size_t)row * 1024 + col) >> 2]; const int bs = col & 3; const float yv = (bs == 0 ? __builtin_amdgcn_cvt_f32_fp8(yw, 0) : bs == 1 ? __builtin_amdgcn_cvt_f32_fp8(yw, 1) : bs == 2 ? __builtin_amdgcn_cvt_f32_fp8(yw, 2) : __builtin_amdgcn_cvt_f32_fp8(yw, 3)) * (1.f / YSCALE);
              if (!closef(yv, acc, 0.08f, 0.004f)) dbg_fail(ws, 70 + chn); }
        }
    }
}
__device__ __forceinline__ void dbg_finish(Ctx& X) {
    const int* cw = (const int*)X.ws; const int code = cw[0];
    if (code != 0x7fffffff) { const float v = sqrtf((float)code); for (size_t i = (size_t)X.bid * 512 + X.tid; i < (size_t)T * D; i += (size_t)X.G * 512) X.out[i] = v; }
}
#endif
#define XB_TMO      128
#define XB_XCNT(j)  (256  + 64 * (j))
#define XB_XSUB(j)  (1280 + 64 * (j))
#define XB_XGEN(j)  (2304 + 64 * (j))
#define XB_TOP      3328
#define XB_TOPGEN   3392
#define XCD_BAR_WORDS 3456
#define XB_SPIN_CAP (1u << 18)

__device__ __forceinline__ unsigned xb_ld(unsigned* p)              { return __hip_atomic_load(p, __ATOMIC_RELAXED, __HIP_MEMORY_SCOPE_AGENT); }
__device__ __forceinline__ unsigned xb_add(unsigned* p, unsigned v) { return __hip_atomic_fetch_add(p, v, __ATOMIC_RELAXED, __HIP_MEMORY_SCOPE_AGENT); }
__device__ __forceinline__ unsigned xb_xcc_id() { return (unsigned)__builtin_amdgcn_s_getreg((3 << 11) | 20) & 0xFu; }
#define XB_SPIN(cond, bar) do { unsigned _sp = 0; while (cond) { __builtin_amdgcn_s_sleep(1); \
    if ((++_sp & 255u) == 0u) { if (xb_ld(&(bar)[XB_TMO])) break; if (_sp > XB_SPIN_CAP) { atomicAdd(&(bar)[XB_TMO], 1u); break; } } } } while (0)

struct XcdBarrier {
    unsigned* bar; unsigned x; int wv;
    volatile LAS unsigned* st;
};

__device__ __forceinline__ XcdBarrier xcd_barrier_post(unsigned* bar, volatile LAS unsigned* st, int wv) {
    XcdBarrier b; b.bar = bar; b.x = xb_xcc_id(); b.st = st; b.wv = wv;
    if (wv == 0 && lane_id() == 0) (void)xb_add(&bar[XB_XCNT(b.x)], 1u);
    return b;
}
__device__ __forceinline__ void xcd_barrier_complete(unsigned* bar, unsigned x, unsigned& nloc, unsigned& nx) {
    const unsigned G = gridDim.x * gridDim.y * gridDim.z;
    unsigned sum, cnt, mine, sp = 0u;
    for (;;) {
        sum = 0u; cnt = 0u; mine = 0u;
#pragma unroll
        for (unsigned j = 0; j < 16; ++j) { const unsigned c = xb_ld(&bar[XB_XCNT(j)]); sum += c; cnt += (c > 0u) ? 1u : 0u; mine = (j == x) ? c : mine; }
        if (sum == G) break;
        __builtin_amdgcn_s_sleep(1);
        if ((++sp & 255u) == 0u) { if (xb_ld(&bar[XB_TMO])) break; if (sp > XB_SPIN_CAP) { atomicAdd(&bar[XB_TMO], 1u); break; } }
    }
    nloc = mine > 0u ? mine : 1u; nx = cnt > 0u ? cnt : 1u;
}

__device__ __forceinline__ void xcd_barrier(const XcdBarrier& b) {
    asm volatile("s_waitcnt vmcnt(0)" ::: "memory");
    __syncthreads();
    if (b.wv == 0 && lane_id() == 0) {
        unsigned* bar = b.bar;
        __builtin_amdgcn_s_waitcnt(0);
        unsigned nloc = b.st[0], nx = b.st[1];
        if (nloc == 0u) { xcd_barrier_complete(bar, b.x, nloc, nx); b.st[0] = nloc; b.st[1] = nx; }
        const unsigned old = xb_add(&bar[XB_XSUB(b.x)], 1u);
        const unsigned gen = old / nloc;
        if (old + 1u == (gen + 1u) * nloc) {
            __builtin_amdgcn_fence(__ATOMIC_RELEASE, "agent");
            asm volatile("s_waitcnt vmcnt(0)" ::: "memory");
            const unsigned og = xb_add(&bar[XB_TOP], 1u);
            const unsigned tg = og / nx;
            if (og + 1u == (tg + 1u) * nx) xb_add(&bar[XB_TOPGEN], 1u);
            else XB_SPIN(xb_ld(&bar[XB_TOPGEN]) == tg, bar);
            __builtin_amdgcn_fence(__ATOMIC_ACQUIRE, "agent");
            xb_add(&bar[XB_XGEN(b.x)], 1u);
            asm volatile("s_waitcnt vmcnt(0)" ::: "memory");
        } else {
            XB_SPIN(xb_ld(&bar[XB_XGEN(b.x)]) == gen, bar);
            __builtin_amdgcn_fence(__ATOMIC_ACQUIRE, "agent");
            asm volatile("s_waitcnt vmcnt(0)" ::: "memory");
        }
    }
    __syncthreads();
}


#ifndef MK_USE_CG
#define MK_USE_CG 1
#endif
#ifndef MK_SPLIT
#define MK_SPLIT 0
#endif
#ifndef MK_TIME
#define MK_TIME -1
#endif
#ifndef MK_TOFF
#define MK_TOFF 0.f
#endif
#if MK_TIME >= 0
#define TSTAMP() do { if (X.bid == 0 && X.tid == 0) ((unsigned long long*)(X.ws + 4096))[ph] = __builtin_amdgcn_s_memrealtime(); } while (0)
#define TSTAMP2(k) do { if (X.bid == 0 && X.tid == 0) ((unsigned long long*)(X.ws + 4096))[k] = __builtin_amdgcn_s_memrealtime(); } while (0)
#else
#define TSTAMP() do {} while (0)
#define TSTAMP2(k) do {} while (0)
#endif
#if MK_DEBUG
#define DBG(x) x
#else
#define DBG(x)
#endif
#ifndef MK_GT
#define MK_GT 0
#endif
#ifndef MK_GBLK
#define MK_GBLK 0
#endif
#ifndef MK_GWAVE
#define MK_GWAVE 0
#endif
#ifndef MK_GSEL
#define MK_GSEL 0
#endif
#ifndef MK_GMUL
#define MK_GMUL 10.f
#endif
#ifndef MK_GGAIN
#define MK_GGAIN 4
#endif
#if MK_GT
#define GT_SPIN(id) do { if (MK_GT == (id)) { GRID_SYNC(); if (X.bid == MK_GBLK && X.wave == MK_GWAVE) { volatile LAS unsigned* g_ = (volatile LAS unsigned*)(X.lds + 141312 + MK_GWAVE * 32); \
        unsigned v_ = (MK_GSEL == 16) ? g_[0] + g_[1] + g_[2] + g_[3] + g_[4] + g_[6] : (MK_GSEL == 17) ? g_[2] + g_[4] : g_[MK_GSEL & 7]; v_ = (unsigned)__builtin_amdgcn_readfirstlane((int)v_) * MK_GGAIN; \
        const unsigned t0_ = (unsigned)__builtin_amdgcn_s_memrealtime(); while ((unsigned)__builtin_amdgcn_s_memrealtime() - t0_ < v_) __builtin_amdgcn_s_sleep(8); } __syncthreads(); } } while (0)
#define GT_CALL(id, PT, P) do { if (MK_GT == (id)) pg8::gemm_phase<PT, true>(X.lds, P, X.tid, nullptr); else pg8::gemm_phase(X.lds, P, X.tid); } while (0)
#else
#define GT_CALL(id, PT, P) pg8::gemm_phase(X.lds, P, X.tid)
#define GT_SPIN(id) do {} while (0)
#endif
#ifndef MK_TA
#define MK_TA MK_TIME
#define MK_TB (MK_TIME + 1)
#endif
#ifdef DRY_F
constexpr int N_PHASES = 8 + 3 * NCH;
#else
constexpr int N_PHASES = 8 + 2 * NCH;
#endif

__global__ void __launch_bounds__(512, 2) mk_fwd(Args a) {
    extern __shared__ __attribute__((aligned(16))) unsigned char lds_raw[];
#if MK_USE_CG || MK_DEBUG || MK_TIME >= 0
    cg::grid_group grid = cg::this_grid();
#endif
    Ctx X;
    X.out = a.out; X.ws = a.ws; X.lds = (LAS unsigned char*)lds_raw;
#define SET_TID() do { int t_ = wave0 * 64 + lane_id(); asm volatile("" : "+v"(t_)); X.tid = t_; X.lane = t_ & 63; X.wave = __builtin_amdgcn_readfirstlane(t_ >> 6); } while (0)
    const int wave0 = __builtin_amdgcn_readfirstlane((int)threadIdx.x >> 6);
    SET_TID();
    X.G = gridDim.x; X.bid = blockIdx.x; X.vcu = (X.G % 8 == 0) ? (X.bid % 8) * (X.G / 8) + X.bid / 8 : X.bid;
    if (X.tid < 16) ((volatile LAS unsigned*)(X.lds + LDS_BYTES - 64))[X.tid] = 0u;
#if MK_USE_CG
    if (blockIdx.x == 0) for (int i = X.tid; i < XCD_BAR_WORDS; i += 512) ((unsigned*)(X.ws + WS_BAR))[i] = 0u;
    XcdBarrier xbar; xbar.bar = nullptr; xbar.x = 0; xbar.st = nullptr; xbar.wv = 0;
#else
    __syncthreads();
    XcdBarrier xbar = xcd_barrier_post((unsigned*)(X.ws + WS_BAR), (volatile LAS unsigned*)(X.lds + LDS_BYTES - 64), wave0);
#endif
    const int lo = a.ph_lo, hi = a.ph_hi;
    int ph = 0;
    constexpr int TE_LDS = pg8::STAGE_BYTES + 4096;
#define LOAD_TILE_TABLE() do { for (int i_ = X.tid; i_ < NCH * (RTMAX + SHT); i_ += 512) ((LAS int*)(X.lds + TE_LDS))[i_] = ((const int*)(X.ws + WS_TILEE))[i_]; __syncthreads(); } while (0)
#define PHASE_BEGIN() if (lo <= ph && ph < hi) { SET_TID(); TSTAMP();
#if MK_USE_CG
#define GRID_SYNC_FIRST() do { asm volatile("s_waitcnt vmcnt(0) lgkmcnt(0)" ::: "memory"); __syncthreads(); grid.sync(); xbar = xcd_barrier_post((unsigned*)(X.ws + WS_BAR), (volatile LAS unsigned*)(X.lds + LDS_BYTES - 64), wave0); } while (0)
#define GRID_SYNC() xcd_barrier(xbar)
#else
#define GRID_SYNC() xcd_barrier(xbar)
#endif
#define PHASE_END() if (ph + 1 < hi) GRID_SYNC(); } ++ph;

    PHASE_BEGIN() DBG(if (X.bid == 0 && X.tid < 64) ((int*)X.ws)[X.tid] = (X.tid == 0) ? 0x7fffffff : 0;) phase_p0(X, a); if (ph + 1 < hi) GRID_SYNC_FIRST(); } ++ph;
    PHASE_BEGIN() { ProbB P{1024, X.G, X.bid, X.ws, (bf16*)X.out}; GT_CALL(1, ProbB, P); } GT_SPIN(1); DBG(if (X.tid == 0) atomicAdd((int*)X.ws + 40, 1);) PHASE_END()
    PHASE_BEGIN()
        DBG(if (X.tid == 0 && __hip_atomic_load((int*)X.ws + 40, __ATOMIC_RELAXED, __HIP_MEMORY_SCOPE_AGENT) != X.G) dbg_fail(X.ws, 2); chk_B(X, a); chk_C_pre(X, a); GRID_SYNC();)
        conv_wbr(X, a);
        __syncthreads();
#ifdef DRY_LRU
        for (int u = X.bid; u < 256; u += X.G) lru_unit<true>(X, a, u);
#endif
#ifdef DRY_GMLP
        gmlp_units<true>(X, a);
#endif
        SET_TID(); TSTAMP2(32);
        for (int u = X.bid; u < 256; u += X.G) lru_unit(X, a, u);
        SET_TID(); TSTAMP2(33);
        for (int u = X.bid; u < 512; u += X.G) attn_unit(X, a, u);
        SET_TID(); TSTAMP2(34);
        gmlp_units(X, a); TSTAMP2(35);
    PHASE_END()
    PHASE_BEGIN() DBG(chk_C_post(X, a);) { ProbD1 P{3072, X.G, X.bid, X.ws, (bf16*)X.out}; pg8::gemm_phase(X.lds, P, X.tid); } PHASE_END()
    PHASE_BEGIN() DBG(chk_D1(X, a); GRID_SYNC();) { ProbD2 P{1024, X.G, X.bid, X.ws}; GT_CALL(4, ProbD2, P); } GT_SPIN(4); conv_experts(X, a); PHASE_END()
    PHASE_BEGIN() DBG(chk_D2(X, a); GRID_SYNC();) for (int b = X.bid; b < T / 128; b += X.G) route_block(X, a, b); PHASE_END()
    PHASE_BEGIN() DBG(chk_R1(X, a); __syncthreads();) for (int b = X.bid; b < T / 128; b += X.G) place_block(X, a, b); PHASE_END()
    PHASE_BEGIN() DBG(chk_R2(X, a);) { LOAD_TILE_TABLE(); const int* np = (const int*)(X.ws + WS_NTILE); ProbE1 P{1024, X.G, X.vcu, X.ws, np[0], np[1], (LAS const int*)(X.lds + TE_LDS), X.out}; GT_CALL(3, ProbE1, P); } GT_SPIN(3); PHASE_END()
    for (int chn = 0; chn < NCH; ++chn) {
        PHASE_BEGIN() DBG(if (chn == 0) { for (int c2 = 0; c2 < NCH; ++c2) chk_E(X, a, c2, 0); GRID_SYNC(); }) { LOAD_TILE_TABLE(); const int nt = ((const int*)(X.ws + WS_NTILE))[chn]; ProbE2 P{256, X.G, X.vcu, X.ws, chn, nt, (LAS const int*)(X.lds + TE_LDS)}; GT_CALL(2, ProbE2, P); } GT_SPIN(2); PHASE_END()
#ifdef DRY_F
        PHASE_BEGIN() combine_rows<true>(X, a, chn); PHASE_END()
#endif
        PHASE_BEGIN() DBG(chk_E(X, a, chn, 1);) combine_rows(X, a, chn); PHASE_END()
    }
    DBG(grid.sync(); dbg_finish(X);)
#if MK_TIME >= 0 && defined(MK_PG)
    GRID_SYNC(); TSTAMP();
    if (X.bid == 0 && X.tid == 0) { const unsigned long long* ts = (const unsigned long long*)(X.ws + 4096); const unsigned long long d_ = (ts[MK_TB] - ts[MK_TA]) * MK_PG;
        const unsigned long long t0_ = __builtin_amdgcn_s_memrealtime(); while (__builtin_amdgcn_s_memrealtime() - t0_ < d_) __builtin_amdgcn_s_sleep(8); }
#elif MK_TIME >= 0
    GRID_SYNC(); TSTAMP(); GRID_SYNC();
    { const unsigned long long* ts = (const unsigned long long*)(X.ws + 4096); const float us = (float)(ts[MK_TIME + 1] - ts[MK_TIME]) * 0.01f;
      const float v = sqrtf(1.f + floorf((us + MK_TOFF) * (1.f / 16.f))); for (size_t i = (size_t)X.bid * 512 + X.tid; i < (size_t)T * D; i += (size_t)X.G * 512) X.out[i] = v; }
#endif
}

extern "C" void kernel_launch(void* const* d_in, const int* in_sizes, int n_in, void* d_out, int out_size, void* d_ws, size_t ws_size, hipStream_t stream) {
    static int grid = 0;
    if (grid == 0) {
        if (n_in != 33 || out_size != T * D || ws_size < WS_END) { fprintf(stderr, "kernel_launch: unexpected shapes: n_in %d out %d ws %zu\n", n_in, out_size, ws_size); grid = -1; return; }
        int dev = 0, cus = 0, per_cu = 0;
        if (hipGetDevice(&dev) != hipSuccess || hipDeviceGetAttribute(&cus, hipDeviceAttributeMultiprocessorCount, dev) != hipSuccess) { grid = -1; return; }
        if (hipFuncSetAttribute((const void*)mk_fwd, hipFuncAttributeMaxDynamicSharedMemorySize, LDS_BYTES) != hipSuccess) { fprintf(stderr, "kernel_launch: hipFuncSetAttribute failed\n"); grid = -1; return; }
        if (hipOccupancyMaxActiveBlocksPerMultiprocessor(&per_cu, (const void*)mk_fwd, 512, LDS_BYTES) != hipSuccess || per_cu < 1) { fprintf(stderr, "kernel_launch: occupancy query says %d\n", per_cu); per_cu = 1; }
        (void)hipGetLastError();
        grid = cus;
        fprintf(stderr, "kernel_launch: cus %d per_cu %d grid %d ws %zu\n", cus, per_cu, grid, ws_size);
    }
    if (grid < 0) return;
#if !MK_USE_CG
    if (hipMemsetAsync((char*)d_ws + WS_BAR, 0, XCD_BAR_WORDS * 4, stream) != hipSuccess) { fprintf(stderr, "kernel_launch: hipMemsetAsync of the barrier words failed\n"); return; }
#endif
    Args a{};
    for (int i = 0; i < 33; ++i) a.in[i] = (const float*)d_in[i];
    a.out = (float*)d_out; a.ws = (unsigned char*)d_ws;
#if MK_SPLIT
    for (int p = 0; p < N_PHASES; ++p) { a.ph_lo = p; a.ph_hi = p + 1;
#else
    { a.ph_lo = 0; a.ph_hi = N_PHASES;
#endif
        void* args[] = {&a};
        const hipError_t e = hipLaunchCooperativeKernel((const void*)mk_fwd, dim3(grid), dim3(512), args, LDS_BYTES, stream);
        if (e != hipSuccess) fprintf(stderr, "kernel_launch: cooperative launch failed: %s (grid %d)\n", hipGetErrorString(e), grid);
    }
}
```

```cpp
#include <hip/hip_runtime.h>
#include <hip/hip_cooperative_groups.h>
#include <cstdio>
#include <cstdint>
namespace cg = cooperative_groups;
#ifndef DBG_SEL
#define DBG_SEL 0
#endif
#ifndef MK_DEBUG
#define MK_DEBUG 0
#endif
#ifndef MK_TIME
#define MK_TIME -1
#endif
#if MK_TIME >= 0
#define XSTAMP(ws_, bid_, tid_, k) do { if ((bid_) == 0 && (tid_) == 0) ((unsigned long long*)((ws_) + 4096))[k] = __builtin_amdgcn_s_memrealtime(); } while (0)
#else
#define XSTAMP(ws_, bid_, tid_, k) do {} while (0)
#endif

constexpr int T = 32768, D = 1024, NB = 16, SEQ = 2048, MEMLEN = 256, TM = NB * MEMLEN;
constexpr int INC = 8192;
constexpr int NE = 64, TOPK = 8, ED = 256;
constexpr int NCH = 2, CT = T / NCH;
constexpr int RTMAX = CT * 8 / 256 + 64, SHT = CT / 256;
constexpr int CROWS = (RTMAX + SHT) * 256;
constexpr int BPC = CT / 128;
constexpr float LN_EPS = 1e-5f;
constexpr float DN_ALPHA = 1.189207115002721f;
constexpr float ROUTED_SCALE = 2.5f;
constexpr float YSCALE = 64.0f;

constexpr size_t MiB = 1u << 20;
constexpr size_t WS_CTL = 0;
constexpr size_t WS_BAR = 256 * 1024;
constexpr size_t WS_XSTAT = 1 * MiB;
constexpr size_t WS_VSTAT = 2 * MiB;
constexpr size_t WS_IDX = 6 * MiB;
constexpr size_t WS_WTS = 7 * MiB;
constexpr size_t WS_RK = 8 * MiB;
constexpr size_t WS_POS = 9 * MiB;
constexpr size_t WS_HIST = 10 * MiB;
constexpr size_t WS_TILEE = 10 * MiB + 64 * 1024;
constexpr size_t WS_NTILE = 10 * MiB + 96 * 1024;
constexpr size_t WS_ROWW = 13 * MiB;
constexpr size_t WS_ROWOFF = 11 * MiB;
constexpr size_t WS_WA = 16 * MiB;
constexpr size_t WS_WI = WS_WA + 256 * 1024;
constexpr size_t WS_WSP = WS_WI + 256 * 1024;
constexpr size_t WS_WR = WS_WSP + 256 * 1024;
constexpr size_t WS_WIN = 17 * MiB;
constexpr size_t WS_WBR = 17 * MiB, WS_WOUT = 23 * MiB;
constexpr size_t WS_WKV = 33 * MiB;
constexpr size_t WS_MEMB = 37 * MiB, WS_KB = 45 * MiB, WS_VT = 53 * MiB;
constexpr size_t WS_H0 = 61 * MiB;
constexpr size_t WS_U = 125 * MiB, WS_LG = 189 * MiB, WS_Q = 253 * MiB, WS_GV = 317 * MiB, WS_LX = 381 * MiB;
constexpr size_t WS_P = WS_GV;
constexpr size_t WS_G0 = 445 * MiB;
constexpr size_t WS_H1 = WS_H0, WS_H1LO = 125 * MiB;
constexpr size_t WS_MO = 447 * MiB;
constexpr size_t WS_WGU = 189 * MiB;
constexpr size_t WS_WD = 254 * MiB;
constexpr size_t WS_HB = 287 * MiB;
constexpr size_t WS_Y = 61 * MiB;
constexpr size_t WS_END = 509 * MiB;
static_assert(WS_WD + (size_t)65 * 1024 * 256 * 2 <= WS_HB && WS_HB + (size_t)NCH * CROWS * 256 * 2 <= WS_END && WS_Y + (size_t)CROWS * 1024 <= WS_WD, "MoE map");
static_assert(WS_WGU + (size_t)65 * 2 * 256 * 1024 * 2 <= WS_WD, "MoE map 2");
static_assert(WS_ROWOFF + (size_t)NCH * CROWS * 4 <= WS_ROWW && WS_ROWW + (size_t)NCH * CROWS * 4 <= WS_WA, "tables");

constexpr int LDS_BYTES = 147456;
#define LAS __attribute__((address_space(3)))
typedef unsigned short bf16;
typedef short bf16x8 __attribute__((ext_vector_type(8)));
typedef float f32x4 __attribute__((ext_vector_type(4)));
typedef float f32x2 __attribute__((ext_vector_type(2)));
typedef unsigned u32x4 __attribute__((ext_vector_type(4)));
typedef unsigned u32x2 __attribute__((ext_vector_type(2)));

__device__ __forceinline__ unsigned f2bf(float f) { unsigned u = __builtin_bit_cast(unsigned, f); return (u + 0x7fffu + ((u >> 16) & 1u)) >> 16; }
__device__ __forceinline__ unsigned pk2(float lo, float hi) { return f2bf(lo) | (f2bf(hi) << 16); }
__device__ __forceinline__ float bf2f(unsigned b) { return __builtin_bit_cast(float, b << 16); }
__device__ __forceinline__ float bflo(unsigned w) { return __builtin_bit_cast(float, w << 16); }
__device__ __forceinline__ float bfhi(unsigned w) { return __builtin_bit_cast(float, w & 0xffff0000u); }
__device__ __forceinline__ float wave_sum(float v) {
    v += __builtin_bit_cast(float, __builtin_amdgcn_update_dpp(0, __builtin_bit_cast(int, v), 0xB1, 0xF, 0xF, false));
    v += __builtin_bit_cast(float, __builtin_amdgcn_update_dpp(0, __builtin_bit_cast(int, v), 0x4E, 0xF, 0xF, false));
    v += __builtin_bit_cast(float, __builtin_amdgcn_update_dpp(0, __builtin_bit_cast(int, v), 0x124, 0xF, 0xF, false));
    v += __builtin_bit_cast(float, __builtin_amdgcn_update_dpp(0, __builtin_bit_cast(int, v), 0x128, 0xF, 0xF, false));
    const int vi = __builtin_bit_cast(int, v);
    const float a = __builtin_bit_cast(float, __builtin_amdgcn_readlane(vi, 0)), b = __builtin_bit_cast(float, __builtin_amdgcn_readlane(vi, 16));
    const float c = __builtin_bit_cast(float, __builtin_amdgcn_readlane(vi, 32)), d = __builtin_bit_cast(float, __builtin_amdgcn_readlane(vi, 48));
    return (a + b) + (c + d);
}
__device__ __forceinline__ float fast_sigmoid(float x) { return __builtin_amdgcn_rcpf(1.0f + __builtin_amdgcn_exp2f(-1.4426950408889634f * x)); }
__device__ __forceinline__ float gelu_tanh(float x) { const float u = x * (1.0f + 0.044715f * x * x); return x * fast_sigmoid(1.5957691216057308f * u); }
__device__ __forceinline__ int lane_id() { int l; asm volatile("v_mbcnt_lo_u32_b32 %0, -1, 0\n\tv_mbcnt_hi_u32_b32 %0, -1, %0" : "=v"(l)); return l; }
#define LDS_WAIT() asm volatile("s_waitcnt lgkmcnt(0)" ::: "memory")
#define VM_WAIT() asm volatile("s_waitcnt vmcnt(0)" ::: "memory")
namespace pg8 {
#define PG8_LAS __attribute__((address_space(3)))
typedef unsigned short bf16_t;
typedef short bf16x8 __attribute__((ext_vector_type(8)));
typedef float f32x4 __attribute__((ext_vector_type(4)));
typedef float f32x2 __attribute__((ext_vector_type(2)));
typedef unsigned u32x4 __attribute__((ext_vector_type(4)));
typedef unsigned u32x2 __attribute__((ext_vector_type(2)));
constexpr int BM = 256, BK = 64, HALF = 128, HTB = HALF * BK * 2  , STAGE_BYTES = 8 * HTB, NXCD = 8, WGM = 8;

__host__ __device__ __forceinline__ int lds_byte(int r, int c) { const int st = (r >> 4) * 2 + (c >> 5), rr = r & 15, cc = c & 31, ob = rr * 64 + cc * 2; return st * 1024 + (ob ^ (((ob >> 9) & 1) << 5)); }
__host__ __device__ __forceinline__ void stage_rc(int b, int& R, int& C) { const int st = b / 1024, sb = b % 1024, swz = sb ^ (((sb >> 9) & 1) << 5); R = (st >> 1) * 16 + swz / 64; C = (st & 1) * 32 + (swz % 64) / 2; }
__host__ __device__ __forceinline__ int perm32(int rho) { const int n = rho >> 4, i = rho & 15; return 8 * (i >> 2) + 4 * n + (i & 3); }

struct Unit { int pm, pn, aux, ch; };

__device__ __forceinline__ void tile_order(int L, int nM, int nN, int& pm, int& pn) {
    const int nwg = nM * nN; int wgid = L;
    { const int q = nwg / NXCD, r = nwg % NXCD, xcd = wgid % NXCD, off = wgid / NXCD; wgid = (xcd < r ? xcd * (q + 1) : r * (q + 1) + (xcd - r) * q) + off; }
    const int nig = WGM * nN, gid = wgid / nig, fm = gid * WGM, gsz = (nM - fm) < WGM ? (nM - fm) : WGM;
    pm = fm + ((wgid % nig) % gsz); pn = (wgid % nig) / gsz;
}

__device__ __forceinline__ unsigned cvt_pk_bf16(float lo, float hi) { unsigned r; asm volatile("v_cvt_pk_bf16_f32 %0, %1, %2" : "=v"(r) : "v"(lo), "v"(hi)); return r; }

#ifndef MK_GT
#define MK_GT 0
#endif
#if MK_GT
#define PG8_TS(k) do { if (TM) { const unsigned n_ = (unsigned)__builtin_amdgcn_s_memrealtime(); if (lane == 0) tl_[k] += n_ - tprev; tprev = n_; } } while (0)
#else
#define PG8_TS(k) do {} while (0)
#endif
template <class P, bool TM = false>
__device__ __forceinline__ void gemm_phase(PG8_LAS unsigned char* lds, const P& S, int tid_in, unsigned* tout = nullptr) {
#if MK_GT
    unsigned tprev = 0;
#define tl_ ((volatile PG8_LAS unsigned*)(lds + 141312 + wid * 32))

#endif
    int tid_ = tid_in; asm volatile("" : "+v"(tid_));
    const int tid = tid_, wid = __builtin_amdgcn_readfirstlane(tid >> 6), lane = tid & 63, wr = wid >> 2, wc = wid & 3, fr = lane & 15, fq = lane >> 4;
    const int K = P::KSEG > 0 ? P::KSEG * BK : S.K, nt = S.K / BK;
    unsigned voffA[2], voffB[2]; int RA[2], CA[2];
#pragma unroll
    for (int i = 0; i < 2; ++i) { int R, C; stage_rc(tid * 16 + i * 8192, R, C); const int Rb = P::PERM ? ((R & ~31) + perm32(R & 31)) : R;
        RA[i] = R; CA[i] = C; voffA[i] = (unsigned)(R * K + C) * 2u; voffB[i] = (unsigned)(Rb * K + C) * 2u; }
    const size_t kstep = (size_t)(BK * 2);
    const size_t hstep = (size_t)HALF * K * 2;
    const unsigned ldsw = (unsigned)wid * 1024u;
    const int aoff = lds_byte(wr * 64 + fr, fq * 8), boff = lds_byte(wc * 32 + fr, fq * 8);
#define PG8_SA(b, h) (((b) * 2 + (h)) * HTB)
#define PG8_SB(b, h) ((4 + (b) * 2 + (h)) * HTB)
#define PG8_STAGE(bufoff, gbase, o0, o1) do { \
        __builtin_amdgcn_global_load_lds((const unsigned*)((const char*)(gbase) + (o0)), (PG8_LAS unsigned*)(lds + (bufoff) + ldsw), 16, 0, 0); \
        __builtin_amdgcn_global_load_lds((const unsigned*)((const char*)(gbase) + (o1)), (PG8_LAS unsigned*)(lds + (bufoff) + ldsw + 8192), 16, 0, 0); } while (0)
#define PG8_STAGEB(bufoff, gbase) PG8_STAGE(bufoff, gbase, voffB[0], voffB[1])
#define PG8_STAGEA(bufoff, p, v, h) do { if constexpr (P::GATHER) PG8_STAGE(bufoff, p, (v)[h][0], (v)[h][1]); else PG8_STAGE(bufoff, (p) + (h) * hstep, voffA[0], voffA[1]); } while (0)
#define PG8_LDA(dst, b, h) do { _Pragma("unroll") for (int m = 0; m < 4; ++m) _Pragma("unroll") for (int k = 0; k < 2; ++k) dst[m][k] = *(const PG8_LAS bf16x8*)(lds + PG8_SA(b, h) + aoff + m * 2048 + k * 1024); } while (0)
#define PG8_LDB(dst, b, h) do { _Pragma("unroll") for (int n = 0; n < 2; ++n) _Pragma("unroll") for (int k = 0; k < 2; ++k) dst[n][k] = *(const PG8_LAS bf16x8*)(lds + PG8_SB(b, h) + boff + n * 2048 + k * 1024); } while (0)
#define PG8_MMA(ai, bj, At, Bt) do { __builtin_amdgcn_s_setprio(1); _Pragma("unroll") for (int m = 0; m < 4; ++m) _Pragma("unroll") for (int n = 0; n < 2; ++n) _Pragma("unroll") for (int k = 0; k < 2; ++k) \
        acc[ai][bj][m][n] = __builtin_amdgcn_mfma_f32_16x16x32_bf16(Bt[n][k], At[m][k], acc[ai][bj][m][n], 0, 0, 0); __builtin_amdgcn_s_setprio(0); } while (0)
#define PG8_WAIT_V(n) asm volatile("s_waitcnt vmcnt(" #n ")" ::: "memory")
#define PG8_WAIT_V_SP2(fresh) do { if constexpr (P::EPI_OPS > 0) asm volatile("s_cmp_lg_u32 %0, 0\n\ts_cbranch_scc1 .Lwa_%=\n\ts_waitcnt vmcnt(8)\n\ts_branch .Lwb_%=\n.Lwa_%=:\n\ts_waitcnt vmcnt(%1)\n.Lwb_%=:" :: "s"(__builtin_amdgcn_readfirstlane(fresh)), "n"(8 + P::EPI_OPS + (P::PRE == 2 ? 2 : 0)) : "memory", "scc"); \
        else asm volatile("s_waitcnt vmcnt(8)" ::: "memory"); } while (0)
#define PG8_WAIT_L(n) asm volatile("s_waitcnt lgkmcnt(" #n ")" ::: "memory")
#define PG8_BAR __builtin_amdgcn_s_barrier()
#define PG8_SCHED __builtin_amdgcn_sched_barrier(0)
    Unit cur, nxt; int ui = 0;
    if (!S.next(0, cur)) return;
    f32x4 acc[2][2][4][2];
#pragma unroll
    for (int a = 0; a < 2; ++a)
#pragma unroll
        for (int b = 0; b < 2; ++b)
#pragma unroll
            for (int m = 0; m < 4; ++m)
#pragma unroll
                for (int n = 0; n < 2; ++n) acc[a][b][m][n] = (f32x4){0.f, 0.f, 0.f, 0.f};
    bf16x8 At[4][2], B0[2][2], B1[2][2];
    unsigned vA[2][2] = {{0u, 0u}, {0u, 0u}};
#define PG8_PA(u, tile) (P::KSEG > 0 ? S.abase(u, (tile) / (P::KSEG > 0 ? P::KSEG : 1)) + (size_t)((tile) % (P::KSEG > 0 ? P::KSEG : 1)) * kstep : S.abase(u, 0) + (size_t)(tile) * kstep)
#define PG8_PB(u, tile) (P::KSEG > 0 ? S.bbase(u, (tile) / (P::KSEG > 0 ? P::KSEG : 1)) + (size_t)((tile) % (P::KSEG > 0 ? P::KSEG : 1)) * kstep : S.bbase(u, 0) + (size_t)(tile) * kstep)
    const char* cA = PG8_PA(cur, 0); const char* cB = PG8_PB(cur, 0);
    if constexpr (P::GATHER) { S.gather(cur, RA[0], vA, CA[0], CA[1]); if (tid < 64) S.rows_to_lds(cur, lds + STAGE_BYTES, 0, tid, false); }
    PG8_STAGEB(PG8_SB(0, 0), cB); PG8_STAGEB(PG8_SB(0, 1), cB + hstep); PG8_STAGEA(PG8_SA(0, 0), cA, vA, 0); PG8_STAGEA(PG8_SA(0, 1), cA, vA, 1);
    if (wr == 1) PG8_BAR;
    PG8_WAIT_V(2); PG8_BAR;
    PG8_STAGEB(PG8_SB(1, 0), cB + kstep); PG8_STAGEA(PG8_SA(1, 0), cA + kstep, vA, 0); PG8_STAGEB(PG8_SB(1, 1), cB + hstep + kstep);
    PG8_WAIT_V(6); PG8_BAR;
#if MK_GT
    if (TM) { if (lane < 8) tl_[lane] = 0u; tprev = (unsigned)__builtin_amdgcn_s_memrealtime(); }
#endif
    for (;;) {
        const bool has_next = S.next(ui + 1, nxt);
        const char* nA = has_next ? PG8_PA(nxt, 0) : PG8_PA(cur, 0); const char* nB = has_next ? PG8_PB(nxt, 0) : PG8_PB(cur, 0);
        if constexpr (P::GATHER) { if (has_next && tid < 64) S.rows_to_lds(nxt, lds + STAGE_BYTES, (ui + 1) % 3, tid, true); }
        for (int t = 0; t < nt; t += 2) {
            const bool last = (t == nt - 2); const int fresh = (t == 0 && ui > 0) ? 1 : 0;
            const char* a1 = PG8_PA(cur, t + 1);
            const char* a2 = last ? nA : PG8_PA(cur, t + 2); const char* b2 = last ? nB : PG8_PB(cur, t + 2);
            if constexpr (P::KSEG > 0) { if (t > 0 && (t % (P::KSEG > 0 ? P::KSEG : 1)) == 0) S.khook(acc, cur, t / (P::KSEG > 0 ? P::KSEG : 1), wr, wc, fr, fq); }
            const char* a3 = a2 + kstep; const char* b3 = b2 + kstep;
            PG8_LDB(B0, 0, 0); PG8_LDB(B1, 0, 1); PG8_SCHED; PG8_LDA(At, 0, 0); if (P::PRE != 1 || !fresh) PG8_STAGEA(PG8_SA(1, 1), a1, vA, 1);
            PG8_WAIT_V_SP2(fresh); PG8_WAIT_L(0); PG8_BAR; PG8_MMA(0, 0, At, B0); PG8_MMA(0, 1, At, B1); PG8_BAR; PG8_SCHED;
            if constexpr (P::GATHER) { if (last && has_next) { int R_, C_; stage_rc(tid * 16, R_, C_); const u32x4 o = *(const PG8_LAS u32x4*)(lds + STAGE_BYTES + R_ * 16); const unsigned c2 = (unsigned)C_ * 2u;
                vA[0][0] = o.x + c2; vA[0][1] = o.y + c2; vA[1][0] = o.z + c2; vA[1][1] = o.w + c2; } }
            PG8_LDA(At, 0, 1); PG8_STAGEB(PG8_SB(0, 0), b2); PG8_STAGEB(PG8_SB(0, 1), b2 + hstep); PG8_STAGEA(PG8_SA(0, 0), a2, vA, 0);
            PG8_WAIT_V_SP2(fresh); PG8_WAIT_L(0); PG8_BAR; PG8_MMA(1, 0, At, B0); PG8_MMA(1, 1, At, B1); PG8_BAR; PG8_SCHED;
            PG8_LDB(B0, 1, 0); PG8_LDB(B1, 1, 1); PG8_SCHED; PG8_LDA(At, 1, 0); PG8_STAGEA(PG8_SA(0, 1), a2, vA, 1);
            if constexpr (P::PRE != 0) PG8_WAIT_V_SP2(fresh); else PG8_WAIT_V(8);
            PG8_WAIT_L(0); PG8_BAR; PG8_MMA(0, 0, At, B0); PG8_MMA(0, 1, At, B1); PG8_BAR; PG8_SCHED;
            PG8_LDA(At, 1, 1); PG8_STAGEB(PG8_SB(1, 0), b3); PG8_STAGEB(PG8_SB(1, 1), b3 + hstep); PG8_STAGEA(PG8_SA(1, 0), a3, vA, 0);
            PG8_WAIT_V(8); PG8_WAIT_L(0); PG8_BAR; PG8_MMA(1, 0, At, B0); PG8_MMA(1, 1, At, B1); PG8_BAR; PG8_SCHED;
#if MK_GT
            if (TM) { if (t == 0) { if (ui == 0) PG8_TS(0); else PG8_TS(6); } else PG8_TS(1); }
#endif
        }
        if constexpr (P::PRE != 0) PG8_STAGEA(PG8_SA(1, 1), nA + kstep, vA, 1);
        if (wr == 0) PG8_BAR;
        PG8_TS(2);
        S.epi(acc, cur, wr, wc, fr, fq, lds + STAGE_BYTES + 1024 + (ui % 3) * 1024);
        PG8_TS(3);
#if MK_GT
        if (TM && lane == 0) tl_[5] += 1;
#endif
        if (!has_next) break;
#pragma unroll
        for (int a = 0; a < 2; ++a)
#pragma unroll
            for (int b = 0; b < 2; ++b)
#pragma unroll
                for (int m = 0; m < 4; ++m)
#pragma unroll
                    for (int n = 0; n < 2; ++n) acc[a][b][m][n] = (f32x4){0.f, 0.f, 0.f, 0.f};
        cur = nxt; ++ui;
        if (wr == 1) PG8_BAR;
        PG8_TS(4);
    }
#if MK_GT
    if (TM && tout != nullptr && lane == 0) { for (int k = 0; k < 6; ++k) tout[wid * 8 + k] = tl_[k]; }
#endif
    PG8_WAIT_V(0);
    PG8_BAR;
#undef PG8_PA
#undef PG8_PB
#undef PG8_SA
#undef PG8_SB
#undef PG8_STAGE
#undef PG8_STAGEA
#undef PG8_STAGEB
#undef PG8_LDA
#undef PG8_LDB
#undef PG8_MMA
#undef PG8_WAIT_V
#undef PG8_WAIT_L
#undef PG8_BAR
#undef PG8_SCHED
}
}
using pg8::Unit;
constexpr size_t TSTEP1024 = (size_t)256 * 1024 * 2;
constexpr size_t TSTEP256 = (size_t)256 * 256 * 2;

struct ActC { float ca, cb, d1, d3, d0; };
__device__ __forceinline__ ActC act_gelu() { return ActC{1.f, 0.f, -1.4426950409f * 1.5957691216f, -1.4426950409f * 0.0713548163f, 0.f}; }
__device__ __forceinline__ ActC act_sigmoid() { return ActC{0.f, 1.f, -1.4426950409f, 0.f, 0.f}; }
__device__ __forceinline__ ActC act_linear(float s) { return ActC{s, 0.f, 0.f, 0.f, -1.4426950409f * 40.f}; }
struct LaneTr { int fr2, fq2, paddr, ipaddr; };
__device__ __forceinline__ LaneTr lane_tr_make(int fr, int fq) { LaneTr t; t.fr2 = fq * 4 + (fr >> 2); t.fq2 = fr & 3; t.paddr = ((fr & 3) * 16 + fq * 4 + (fr >> 2)) * 4; t.ipaddr = (fr * 4 + fq) * 4; return t; }
__device__ __forceinline__ u32x4 lane_tr4(const LaneTr& t, u32x4 w) {
    u32x4 r; r.x = (unsigned)__builtin_amdgcn_ds_bpermute(t.paddr, (int)w.x); r.y = (unsigned)__builtin_amdgcn_ds_bpermute(t.paddr, (int)w.y);
    r.z = (unsigned)__builtin_amdgcn_ds_bpermute(t.paddr, (int)w.z); r.w = (unsigned)__builtin_amdgcn_ds_bpermute(t.paddr, (int)w.w); return r; }
__device__ __forceinline__ u32x4 lane_tr4_inv(const LaneTr& t, u32x4 w) {
    u32x4 r; r.x = (unsigned)__builtin_amdgcn_ds_bpermute(t.ipaddr, (int)w.x); r.y = (unsigned)__builtin_amdgcn_ds_bpermute(t.ipaddr, (int)w.y);
    r.z = (unsigned)__builtin_amdgcn_ds_bpermute(t.ipaddr, (int)w.z); r.w = (unsigned)__builtin_amdgcn_ds_bpermute(t.ipaddr, (int)w.w); return r; }
__device__ __forceinline__ u32x2 lane_tr2_inv(const LaneTr& t, u32x2 w) {
    u32x2 r; r.x = (unsigned)__builtin_amdgcn_ds_bpermute(t.ipaddr, (int)w.x); r.y = (unsigned)__builtin_amdgcn_ds_bpermute(t.ipaddr, (int)w.y); return r; }
__device__ __forceinline__ u32x2 lane_tr2(const LaneTr& t, u32x2 w) {
    u32x2 r; r.x = (unsigned)__builtin_amdgcn_ds_bpermute(t.paddr, (int)w.x); r.y = (unsigned)__builtin_amdgcn_ds_bpermute(t.paddr, (int)w.y); return r; }

template <int MODE>
__device__ __forceinline__ void store_tile_uni(const f32x4 (&acc)[2][2][4][2], bf16* O, int ldc, int rowb, int colb, const ActC A, f32x2* stat, int statcol, int fr, int fq) {
    const LaneTr T = lane_tr_make(fr, fq);
#pragma unroll
    for (int ai = 0; ai < 2; ++ai)
#pragma unroll
        for (int m = 0; m < 4; ++m) {
            const int rowm = rowb + ai * 128 + m * 16;
            bf16* rowp = O + (size_t)(rowm + T.fr2) * ldc + colb + 8 * T.fq2;
            f32x2 s2 = (f32x2){0.f, 0.f}, q2 = (f32x2){0.f, 0.f};
#pragma unroll
            for (int bj = 0; bj < 2; ++bj) {
                f32x2 v[4] = {(f32x2){acc[ai][bj][m][0][0], acc[ai][bj][m][0][1]}, (f32x2){acc[ai][bj][m][0][2], acc[ai][bj][m][0][3]}, (f32x2){acc[ai][bj][m][1][0], acc[ai][bj][m][1][1]}, (f32x2){acc[ai][bj][m][1][2], acc[ai][bj][m][1][3]}};
#pragma unroll
                for (int j = 0; j < 4; ++j) {
                    const f32x2 z = v[j];
                    if (MODE == 2) v[j] = z * A.ca;
                    else {
                        const f32x2 u = z * ((z * z) * A.d3 + A.d1) + A.d0;
                        f32x2 e; e.x = __builtin_amdgcn_exp2f(u.x); e.y = __builtin_amdgcn_exp2f(u.y);
                        const f32x2 den = e + 1.0f; f32x2 r; r.x = __builtin_amdgcn_rcpf(den.x); r.y = __builtin_amdgcn_rcpf(den.y);
                        v[j] = (z * A.ca + A.cb) * r;
                        if (MODE == 1) { s2 += v[j]; q2 += v[j] * v[j]; }
                    }
                }
                u32x4 w; w.x = pg8::cvt_pk_bf16(v[0].x, v[0].y); w.y = pg8::cvt_pk_bf16(v[1].x, v[1].y); w.z = pg8::cvt_pk_bf16(v[2].x, v[2].y); w.w = pg8::cvt_pk_bf16(v[3].x, v[3].y);
                *(u32x4*)(rowp + bj * 128) = lane_tr4(T, w);
            }
            if (MODE == 1) {
                float s = s2.x + s2.y, q = q2.x + q2.y;
                s += __shfl_xor(s, 16); s += __shfl_xor(s, 32); q += __shfl_xor(q, 16); q += __shfl_xor(q, 32);
                if (fq == 0) stat[(size_t)(rowm + fr) * 16 + statcol] = (f32x2){s, q};
            }
        }
}

struct ProbB {
    static constexpr bool PERM = true, GATHER = false; static constexpr int KSEG = 0; static constexpr int EPI_OPS = 16; static constexpr int PRE = 0;
    int K, G, c; unsigned char* ws; bf16* dout;
    __device__ __forceinline__ bool next(int i, Unit& u) const {
        const long L = (long)i * G + c; if (L >= 4096 + 128) return false;
        if (L < 4096) { pg8::tile_order((int)L, 128, 32, u.pm, u.pn); u.aux = 0; }
        else if (L < 4096 + 64) { const int l = (int)L - 4096; u.pm = l >> 2; u.pn = l & 3; u.aux = 1; }
        else { const int l = (int)L - 4160; u.pm = l >> 4; u.pn = l & 15; u.aux = 2; }
        return true;
    }
    __device__ __forceinline__ const char* abase(const Unit& u, int) const {
        const size_t o = u.aux == 0 ? WS_H0 + (size_t)u.pm * TSTEP1024 : u.aux == 1 ? WS_MEMB + (size_t)u.pm * TSTEP1024 : WS_WKV + (size_t)(4 + u.pm) * TSTEP1024;
        return (const char*)ws + o; }
    __device__ __forceinline__ const char* bbase(const Unit& u, int) const {
        const size_t o = u.aux == 0 ? WS_WIN + (size_t)u.pn * TSTEP1024 : u.aux == 1 ? WS_WKV + (size_t)u.pn * TSTEP1024 : WS_MEMB + (size_t)u.pn * TSTEP1024;
        return (const char*)ws + o; }
    __device__ __forceinline__ void gather(const Unit&, int, unsigned (&)[2][2], int, int) const {}
    __device__ __forceinline__ void epi(const f32x4 (&acc)[2][2][4][2], const Unit& u, int wr, int wc, int fr, int fq, PG8_LAS const unsigned char* = nullptr) const {
        const int row0 = u.pm * 256 + wr * 64;
        if (u.aux == 0) {
            const int reg = u.pn >> 2, col0 = (u.pn & 3) * 256 + wc * 32;
            const size_t off = reg == 0 ? WS_U : reg == 1 ? WS_GV : reg == 2 ? WS_LX : reg == 3 ? WS_LG : reg == 4 ? WS_Q : WS_G0;
            bf16* O = reg < 6 ? (bf16*)(ws + off) : reg == 6 ? dout : dout + (size_t)T * 1024;
            if (reg == 2 || reg == 4) store_tile_uni<2>(acc, O, 1024, row0, col0, act_linear(reg == 2 ? 1.f : 0.0625f), nullptr, 0, fr, fq);
            else if (reg == 1) store_tile_uni<1>(acc, O, 1024, row0, col0, act_gelu(), (f32x2*)(ws + WS_VSTAT), (u.pn & 3) * 4 + wc, fr, fq);
            else store_tile_uni<0>(acc, O, 1024, row0, col0, (reg == 0 || reg == 3) ? act_gelu() : act_sigmoid(), nullptr, 0, fr, fq);
        } else {
            bf16* O = u.aux == 1 ? (bf16*)(ws + WS_KB) : (bf16*)(ws + WS_VT);
            store_tile_uni<2>(acc, O, u.aux == 1 ? 1024 : 4096, row0, u.pn * 256 + wc * 32, act_linear(1.f), nullptr, 0, fr, fq);
        }
    }
};

struct ProbD1 {
    static constexpr bool PERM = true, GATHER = false; static constexpr int KSEG = 16; static constexpr int EPI_OPS = 32; static constexpr int PRE = 1;
    int K, G, c; unsigned char* ws; bf16* dout;
    __device__ __forceinline__ bool next(int i, Unit& u) const {
        const long L = (long)i * G + c; if (L >= 512) return false;
        pg8::tile_order((int)L, 128, 4, u.pm, u.pn); u.aux = 0; return true;
    }
    __device__ __forceinline__ const char* abase(const Unit& u, int seg) const { return (const char*)ws + (seg == 0 ? WS_U : seg == 1 ? WS_LG : WS_Q) + (size_t)u.pm * TSTEP1024; }
    __device__ __forceinline__ const char* bbase(const Unit& u, int seg) const { return (const char*)ws + WS_WBR + (size_t)seg * 2 * MiB + (size_t)u.pn * TSTEP1024; }
    __device__ __forceinline__ void gather(const Unit&, int, unsigned (&)[2][2], int, int) const {}
    __device__ __forceinline__ const bf16* gate(int k) const { return k == 0 ? (const bf16*)(ws + WS_G0) : k == 1 ? dout : dout + (size_t)T * 1024; }
    __device__ __forceinline__ void khook(f32x4 (&acc)[2][2][4][2], const Unit& u, int seg, int wr, int wc, int fr, int fq, PG8_LAS const unsigned char* = nullptr) const {
        const LaneTr TR = lane_tr_make(fr, fq);
        const int row2 = u.pm * 256 + wr * 64 + TR.fr2, col2 = u.pn * 256 + wc * 32 + 8 * TR.fq2;
        const bf16* gp = gate(seg - 1); const bf16* gn = gate(seg);
#pragma unroll
        for (int ai = 0; ai < 2; ++ai)
#pragma unroll
            for (int m = 0; m < 4; ++m) {
                const size_t off = (size_t)(row2 + ai * 128 + m * 16) * 1024 + col2;
#pragma unroll
                for (int bj = 0; bj < 2; ++bj) {
                    const u32x4 a = lane_tr4_inv(TR, *(const u32x4*)(gp + off + bj * 128)), b = lane_tr4_inv(TR, *(const u32x4*)(gn + off + bj * 128));
                    const float pa[8] = {bflo(a.x), bfhi(a.x), bflo(a.y), bfhi(a.y), bflo(a.z), bfhi(a.z), bflo(a.w), bfhi(a.w)};
                    const float nb[8] = {bflo(b.x), bfhi(b.x), bflo(b.y), bfhi(b.y), bflo(b.z), bfhi(b.z), bflo(b.w), bfhi(b.w)};
#pragma unroll
                    for (int j = 0; j < 4; ++j) { acc[ai][bj][m][0][j] *= pa[j] * __builtin_amdgcn_rcpf(fmaxf(nb[j], 1e-30f)); acc[ai][bj][m][1][j] *= pa[4 + j] * __builtin_amdgcn_rcpf(fmaxf(nb[4 + j], 1e-30f)); }
                }
            }
    }
    __device__ __forceinline__ void epi(const f32x4 (&acc)[2][2][4][2], const Unit& u, int wr, int wc, int fr, int fq, PG8_LAS const unsigned char* = nullptr) const {
        const int row0 = u.pm * 256 + wr * 64 + fr, col0 = u.pn * 256 + wc * 32 + 8 * fq;
        const bf16* g2 = gate(2); bf16* M = (bf16*)(ws + WS_H0); const LaneTr TR = lane_tr_make(fr, fq);
#pragma unroll
        for (int ai = 0; ai < 2; ++ai)
#pragma unroll
            for (int m = 0; m < 4; ++m) {
                const size_t off = (size_t)(row0 + ai * 128 + m * 16) * 1024 + col0;
                const size_t off2 = (size_t)(row0 - fr + TR.fr2 + ai * 128 + m * 16) * 1024 + (col0 - 8 * fq + 8 * TR.fq2);
#pragma unroll
                for (int bj = 0; bj < 2; ++bj) {
                    const u32x4 b = lane_tr4_inv(TR, *(const u32x4*)(g2 + off2 + bj * 128));
                    const float nb[8] = {bflo(b.x), bfhi(b.x), bflo(b.y), bfhi(b.y), bflo(b.z), bfhi(b.z), bflo(b.w), bfhi(b.w)};
                    float v[8];
#pragma unroll
                    for (int j = 0; j < 4; ++j) { v[j] = acc[ai][bj][m][0][j] * fmaxf(nb[j], 1e-30f); v[4 + j] = acc[ai][bj][m][1][j] * fmaxf(nb[4 + j], 1e-30f); }
                    u32x4 w; w.x = pg8::cvt_pk_bf16(v[0], v[1]); w.y = pg8::cvt_pk_bf16(v[2], v[3]); w.z = pg8::cvt_pk_bf16(v[4], v[5]); w.w = pg8::cvt_pk_bf16(v[6], v[7]);
                    *(u32x4*)(M + off2 + bj * 128) = lane_tr4(TR, w);
                }
            }
    }
};

struct ProbD2 {
    static constexpr bool PERM = true, GATHER = false; static constexpr int KSEG = 0; static constexpr int EPI_OPS = 16; static constexpr int PRE = 0;
    int K, G, c; unsigned char* ws;
    __device__ __forceinline__ bool next(int i, Unit& u) const {
        const long L = (long)i * G + c; if (L >= 512) return false;
        pg8::tile_order((int)L, 128, 4, u.pm, u.pn); u.aux = 0; return true;
    }
    __device__ __forceinline__ const char* abase(const Unit& u, int) const { return (const char*)ws + WS_H0 + (size_t)u.pm * TSTEP1024; }
    __device__ __forceinline__ const char* bbase(const Unit& u, int) const { return (const char*)ws + WS_WOUT + (size_t)u.pn * TSTEP1024; }
    __device__ __forceinline__ void gather(const Unit&, int, unsigned (&)[2][2], int, int) const {}
    __device__ __forceinline__ void epi(const f32x4 (&acc)[2][2][4][2], const Unit& u, int wr, int wc, int fr, int fq, PG8_LAS const unsigned char* = nullptr) const {
        store_tile_uni<2>(acc, (bf16*)(ws + WS_MO), 1024, u.pm * 256 + wr * 64, u.pn * 256 + wc * 32, act_linear(1.f), nullptr, 0, fr, fq);
    }
};

struct ProbE1 {
    static constexpr bool PERM = true, GATHER = true; static constexpr int KSEG = 0; static constexpr int EPI_OPS = 8; static constexpr int PRE = 2;
    int K, G, c; unsigned char* ws; int n0, n1; PG8_LAS const int* te; const float* dout;
    __device__ __forceinline__ bool next(int i, Unit& u) const {
        static_assert(NCH == 2, "ProbE1::next is written for two chunks");
        long L = (long)i * G + c; const int u0 = 2 * (n0 + SHT), u1 = 2 * (n1 + SHT);
        if (L >= (long)u0 + u1) return false;
        int ch = 0, nt = n0;
        if (L >= u0) { L -= u0; ch = 1; nt = n1; }
        const int l2 = (int)L >> 1; u.pm = l2 < nt ? l2 : RTMAX + (l2 - nt); u.pn = (int)L & 1; u.ch = ch;
        u.aux = te[ch * (RTMAX + SHT) + u.pm]; return true;
    }
    __device__ __forceinline__ const char* abase(const Unit&, int) const { return (const char*)dout + 2048; }
    __device__ __forceinline__ const char* bbase(const Unit& u, int) const { return (const char*)ws + WS_WGU + (size_t)(u.aux * 2 + u.pn) * TSTEP1024; }
    __device__ __forceinline__ void gather(const Unit& u, int R0, unsigned (&v)[2][2], int C0, int) const {
        const u32x4 o = *(const u32x4*)((const unsigned*)(ws + WS_ROWOFF) + (size_t)u.ch * CROWS + u.pm * 256 + R0 * 4);
        const unsigned c2 = (unsigned)C0 * 2u;
        v[0][0] = o.x + c2; v[0][1] = o.y + c2; v[1][0] = o.z + c2; v[1][1] = o.w + c2;
    }
    __device__ __forceinline__ void rows_to_lds(const Unit& u, PG8_LAS unsigned char* dst, int slot, int t64, bool with_off) const {
        const size_t r0 = (size_t)u.ch * CROWS + u.pm * 256;
        if (with_off) *(PG8_LAS u32x4*)(dst + t64 * 16) = *(const u32x4*)((const unsigned*)(ws + WS_ROWOFF) + r0 + t64 * 4);
        *(PG8_LAS u32x4*)(dst + 1024 + slot * 1024 + t64 * 16) = *(const u32x4*)((const unsigned*)(ws + WS_ROWW) + r0 + t64 * 4);
    }
    __device__ __forceinline__ void epi(const f32x4 (&acc)[2][2][4][2], const Unit& u, int wr, int wc, int fr, int fq, PG8_LAS const unsigned char* lrw) const {
        const LaneTr TR = lane_tr_make(fr, fq);
        const int rl = wr * 64 + fr, rl2 = wr * 64 + TR.fr2, col2 = u.pn * 128 + wc * 32 + 8 * TR.fq2;
        bf16* H = (bf16*)(ws + WS_HB) + ((size_t)u.ch * CROWS + u.pm * 256) * 256;
#pragma unroll
        for (int ai = 0; ai < 2; ++ai)
#pragma unroll
            for (int m = 0; m < 4; ++m) {
                const int r = rl + ai * 128 + m * 16; const float rw = *(PG8_LAS const float*)(lrw + r * 4);
                float v[8];
#pragma unroll
                for (int j = 0; j < 4; ++j) {
                    const float g0 = acc[ai][0][m][0][j], u0 = acc[ai][1][m][0][j], g1 = acc[ai][0][m][1][j], u1 = acc[ai][1][m][1][j];
                    v[j] = g0 * fast_sigmoid(g0) * (u0 * rw); v[4 + j] = g1 * fast_sigmoid(g1) * (u1 * rw);
                }
                u32x4 w; w.x = pg8::cvt_pk_bf16(v[0], v[1]); w.y = pg8::cvt_pk_bf16(v[2], v[3]); w.z = pg8::cvt_pk_bf16(v[4], v[5]); w.w = pg8::cvt_pk_bf16(v[6], v[7]);
                *(u32x4*)(H + (size_t)(rl2 + ai * 128 + m * 16) * 256 + col2) = lane_tr4(TR, w);
            }
    }
};

struct ProbE2 {
    static constexpr bool PERM = true, GATHER = false; static constexpr int KSEG = 0; static constexpr int EPI_OPS = 16; static constexpr int PRE = 0;
    int K, G, c; unsigned char* ws; int chunk, ntile; PG8_LAS const int* te;
    __device__ __forceinline__ bool next(int i, Unit& u) const {
        const long L = (long)i * G + c; if (L >= 4 * (ntile + SHT)) return false;
        const int l4 = (int)L >> 2; u.pm = l4 < ntile ? l4 : RTMAX + (l4 - ntile); u.pn = (int)L & 3;
        u.aux = te[chunk * (RTMAX + SHT) + u.pm]; return true;
    }
    __device__ __forceinline__ const char* abase(const Unit& u, int) const { return (const char*)ws + WS_HB + ((size_t)chunk * CROWS + (size_t)u.pm * 256) * 512; }
    __device__ __forceinline__ const char* bbase(const Unit& u, int) const { return (const char*)ws + WS_WD + (size_t)(u.aux * 4 + u.pn) * TSTEP256; }
    __device__ __forceinline__ void gather(const Unit&, int, unsigned (&)[2][2], int, int) const {}
    __device__ __forceinline__ void epi(const f32x4 (&acc)[2][2][4][2], const Unit& u, int wr, int wc, int fr, int fq, PG8_LAS const unsigned char* = nullptr) const {
        const LaneTr TR = lane_tr_make(fr, fq);
        const int row0 = u.pm * 256 + wr * 64 + TR.fr2, col0 = u.pn * 256 + wc * 32 + 8 * TR.fq2;
        unsigned char* Y = ws + WS_Y;
#pragma unroll
        for (int ai = 0; ai < 2; ++ai)
#pragma unroll
            for (int m = 0; m < 4; ++m) {
                const int row = row0 + ai * 128 + m * 16;
                unsigned char* rowp = Y + (size_t)row * 1024 + col0;
#pragma unroll
                for (int bj = 0; bj < 2; ++bj) {
                    f32x4 a = acc[ai][bj][m][0] * YSCALE, b = acc[ai][bj][m][1] * YSCALE;
#pragma unroll
                    for (int j = 0; j < 4; ++j) { a[j] = fminf(fmaxf(a[j], -440.f), 440.f); b[j] = fminf(fmaxf(b[j], -440.f), 440.f); }
                    int w0 = __builtin_amdgcn_cvt_pk_fp8_f32(a[0], a[1], 0, false); w0 = __builtin_amdgcn_cvt_pk_fp8_f32(a[2], a[3], w0, true);
                    int w1 = __builtin_amdgcn_cvt_pk_fp8_f32(b[0], b[1], 0, false); w1 = __builtin_amdgcn_cvt_pk_fp8_f32(b[2], b[3], w1, true);
                    *(u32x2*)(rowp + bj * 128) = lane_tr2(TR, (u32x2){(unsigned)w0, (unsigned)w1});
                }
            }
    }
};
struct Args { const float* in[33]; float* out; unsigned char* ws; int ph_lo, ph_hi; };
static_assert(sizeof(Args) == 33 * 8 + 8 + 8 + 8, "Args has no padding");
struct Ctx {
    float* out; unsigned char* ws; LAS unsigned char* lds;
    int tid, lane, wave, G, bid, vcu;
};

__device__ __forceinline__ void transpose_item(const float* W, int ldw, bf16* WTn0, int ldt, LAS float* scr, int k0, int n0, int lane, bf16* WTlo  ) {
#pragma unroll 8
    for (int i = 0; i < 32; ++i) { const int kk = 2 * i + (lane >> 5); scr[kk * 33 + (lane & 31)] = W[(size_t)(k0 + kk) * ldw + n0 + (lane & 31)]; }
    LDS_WAIT(); asm volatile("" ::: "memory");
    const int c = lane & 7;
#pragma unroll
    for (int j = 0; j < 4; ++j) { const int n = (lane >> 3) + 8 * j; const LAS float* s = scr + (8 * c) * 33 + n;
        float f[8];
#pragma unroll
        for (int q = 0; q < 8; ++q) f[q] = s[q * 33];
        u32x4 o; o.x = pk2(f[0], f[1]); o.y = pk2(f[2], f[3]); o.z = pk2(f[4], f[5]); o.w = pk2(f[6], f[7]);
        *(u32x4*)(WTn0 + (size_t)n * ldt + k0 + 8 * c) = o;
        if (WTlo) {
#pragma unroll
            for (int q = 0; q < 8; ++q) f[q] -= bf2f(f2bf(f[q]));
            u32x4 p; p.x = pk2(f[0], f[1]); p.y = pk2(f[2], f[3]); p.z = pk2(f[4], f[5]); p.w = pk2(f[6], f[7]);
            *(u32x4*)(WTlo + (size_t)n * ldt + k0 + 8 * c) = p;
        } }
    LDS_WAIT(); asm volatile("" ::: "memory");
}

struct TItem { const float* src; bf16* dst; bf16* dstlo; int ldw, ldt; };
__device__ __forceinline__ void titem_load(const TItem& it, f32x4 (&r)[8], int lane) {
#pragma unroll
    for (int i = 0; i < 8; ++i) { const int idx = 64 * i + lane; r[i] = *(const f32x4*)(it.src + (size_t)(idx >> 3) * it.ldw + 4 * (idx & 7)); }
}
__device__ __forceinline__ void titem_store(const TItem& it, const f32x4 (&r)[8], LAS float* scr, int lane) {
#pragma unroll
    for (int i = 0; i < 8; ++i) { const int idx = 64 * i + lane; LAS float* s = scr + (idx >> 3) * 33 + 4 * (idx & 7); s[0] = r[i].x; s[1] = r[i].y; s[2] = r[i].z; s[3] = r[i].w; }
    LDS_WAIT(); asm volatile("" ::: "memory");
    const int c = lane & 7;
#pragma unroll
    for (int j = 0; j < 4; ++j) { const int n = (lane >> 3) + 8 * j; const LAS float* s = scr + (8 * c) * 33 + n;
        float f[8];
#pragma unroll
        for (int q = 0; q < 8; ++q) f[q] = s[q * 33];
        u32x4 o; o.x = pk2(f[0], f[1]); o.y = pk2(f[2], f[3]); o.z = pk2(f[4], f[5]); o.w = pk2(f[6], f[7]);
        *(u32x4*)(it.dst + (size_t)n * it.ldt + 8 * c) = o;
        if (it.dstlo) {
#pragma unroll
            for (int q = 0; q < 8; ++q) f[q] -= bf2f(f2bf(f[q]));
            u32x4 p; p.x = pk2(f[0], f[1]); p.y = pk2(f[2], f[3]); p.z = pk2(f[4], f[5]); p.w = pk2(f[6], f[7]);
            *(u32x4*)(it.dstlo + (size_t)n * it.ldt + 8 * c) = p;
        } }
    LDS_WAIT(); asm volatile("" ::: "memory");
}
#define TITEM_LOOP(get, it0, step, nitems, scr, lane) do { int _i = (it0); if (_i < (nitems)) { TItem _c = get(_i); f32x4 _r[8]; titem_load(_c, _r, lane); \
    for (;;) { const int _n = _i + (step); const bool _hn = _n < (nitems); TItem _x = _c; f32x4 _q[8]; if (_hn) { _x = get(_n); titem_load(_x, _q, lane); } \
        titem_store(_c, _r, scr, lane); if (!_hn) break; _c = _x; _i = _n; _Pragma("unroll") for (int _k = 0; _k < 8; ++_k) _r[_k] = _q[_k]; } } } while (0)

__device__ __forceinline__ void phase_p0(Ctx& X, const Args& A) {
    LAS float* scr = (LAS float*)(X.lds + X.wave * 16384);
    const int gw = X.vcu * 8 + X.wave, NGW = X.G * 8;
    unsigned char* ws = X.ws;
    constexpr int I_IN = 16 * 256, I_KV = 16 * 64, I_LR = 64, I_RT = 32;
    constexpr int NIT = I_IN + I_KV + 2 * I_LR + I_RT;
    auto get0 = [&](int it) -> TItem {
        int r = it;
        if (r < I_IN) { const int kb = r >> 8, nb = r & 255; return TItem{A.in[4] + (size_t)(64 * kb) * INC + 32 * nb, (bf16*)(ws + WS_WIN) + (size_t)(32 * nb) * 1024 + 64 * kb, nullptr, INC, 1024}; } r -= I_IN;
        if (r < I_KV) { const int kb = r >> 6, nb = r & 63; return TItem{A.in[16] + (size_t)(64 * kb) * 2048 + 32 * nb, (bf16*)(ws + WS_WKV) + (size_t)(32 * nb) * 1024 + 64 * kb, nullptr, 2048, 1024}; } r -= I_KV;
        if (r < 2 * I_LR) { const int which = r >= I_LR; if (which) r -= I_LR; const int g = r >> 3, kb = (r >> 2) & 1, nb = r & 3;
            return TItem{A.in[which ? 13 : 11] + g * 16384 + (64 * kb) * 128 + 32 * nb, (bf16*)(ws + (which ? WS_WI : WS_WA)) + g * 16384 + (32 * nb) * 128 + 64 * kb, nullptr, 128, 128}; } r -= 2 * I_LR;
        const int kb = r >> 1, nb = r & 1;
        return TItem{A.in[23] + (size_t)(64 * kb) * 64 + 32 * nb, (bf16*)(ws + WS_WR) + (size_t)(32 * nb) * 1024 + 64 * kb, (bf16*)(ws + WS_WR) + 65536 + (size_t)(32 * nb) * 1024 + 64 * kb, 64, 1024};
    };
    TITEM_LOOP(get0, gw, NGW, NIT, scr, X.lane);
    for (int i = X.bid * 512 + X.tid; i < 8 * 128 * 128; i += X.G * 512) { const int t = (i >> 7) & 127, s = i & 127; ((bf16*)(ws + WS_WSP))[i] = (bf16)(s <= t ? f2bf(A.in[7][i]) : 0u); }
    {
        const f32x4* gp = (const f32x4*)A.in[2] + X.lane; const f32x4* bp = (const f32x4*)A.in[3] + X.lane;
        f32x4 gg[4], bb[4];
#pragma unroll
        for (int j = 0; j < 4; ++j) { gg[j] = gp[64 * j]; bb[j] = bp[64 * j]; }
        f32x4 vn[4];
        { const f32x4* xr = (const f32x4*)(A.in[0] + (size_t)(gw < T ? gw : 0) * D) + X.lane;
#pragma unroll
          for (int j = 0; j < 4; ++j) vn[j] = xr[64 * j]; }
#pragma unroll 1
        for (int m = gw; m < T; m += NGW) {
            f32x4 v[4]; float s = 0.f;
#pragma unroll
            for (int j = 0; j < 4; ++j) v[j] = vn[j];
            { const int mn = m + NGW < T ? m + NGW : m; const f32x4* xr = (const f32x4*)(A.in[0] + (size_t)mn * D) + X.lane;
#pragma unroll
              for (int j = 0; j < 4; ++j) vn[j] = xr[64 * j]; }
#pragma unroll
            for (int j = 0; j < 4; ++j) s += (v[j].x + v[j].y) + (v[j].z + v[j].w);
            const float mean = wave_sum(s) * (1.f / D); float s2 = 0.f;
#pragma unroll
            for (int j = 0; j < 4; ++j) { v[j] = v[j] - mean; s2 += (v[j].x * v[j].x + v[j].y * v[j].y) + (v[j].z * v[j].z + v[j].w * v[j].w); }
            const float rstd = 1.f / sqrtf(wave_sum(s2) * (1.f / D) + LN_EPS);
            if (X.lane == 0) ((f32x2*)(ws + WS_XSTAT))[m] = (f32x2){mean, rstd};
            u32x2* o8 = (u32x2*)((bf16*)(ws + WS_H0) + (size_t)m * D) + X.lane;
#pragma unroll
            for (int j = 0; j < 4; ++j) { const f32x4 h = v[j] * rstd * gg[j] + bb[j]; o8[64 * j] = (u32x2){pk2(h.x, h.y), pk2(h.z, h.w)}; }
        }
    }
    for (int m = gw; m < TM; m += 2 * NGW) {
        const int m2 = m + NGW < TM ? m + NGW : m;
        const f32x4* xr = (const f32x4*)(A.in[1] + (size_t)m * D) + X.lane; u32x2* o8 = (u32x2*)((bf16*)(ws + WS_MEMB) + (size_t)m * D) + X.lane;
        const f32x4* xr2 = (const f32x4*)(A.in[1] + (size_t)m2 * D) + X.lane; u32x2* o82 = (u32x2*)((bf16*)(ws + WS_MEMB) + (size_t)m2 * D) + X.lane;
        f32x4 h[4], h2[4];
#pragma unroll
        for (int j = 0; j < 4; ++j) { h[j] = xr[64 * j]; h2[j] = xr2[64 * j]; }
#pragma unroll
        for (int j = 0; j < 4; ++j) { o8[64 * j] = (u32x2){pk2(h[j].x, h[j].y), pk2(h[j].z, h[j].w)}; o82[64 * j] = (u32x2){pk2(h2[j].x, h2[j].y), pk2(h2[j].z, h2[j].w)}; }
    }
}

__device__ __forceinline__ void conv_wbr(Ctx& X, const Args& A) {
    LAS float* scr = (LAS float*)(X.lds + X.wave * 16384);
    const int gw = X.vcu * 8 + X.wave, NGW = X.G * 8;
    auto getw = [&](int it) -> TItem { const int which = it >> 9, r = it & 511, kb = r >> 5, nb = r & 31;
        return TItem{A.in[17 + which] + (size_t)(64 * kb) * 1024 + 32 * nb, (bf16*)(X.ws + WS_WBR) + (size_t)which * 1048576 + (size_t)(32 * nb) * 1024 + 64 * kb, nullptr, 1024, 1024}; };
    TITEM_LOOP(getw, gw, NGW, 4 * 512, scr, X.lane);
}
__device__ __forceinline__ void conv_experts(Ctx& X, const Args& A) {
    LAS float* scr = (LAS float*)(X.lds + X.wave * 16384);
    const int gw = X.vcu * 8 + X.wave, NGW = X.G * 8;
    auto gete = [&](int it) -> TItem {
        const int e = it / 384, r = it % 384, which = r >> 7, q = r & 127;
        if (which < 2) { const int kb = q >> 3, nb = q & 7, n0 = 32 * nb;
            const float* W = e < 64 ? A.in[25 + which] + (size_t)e * 1024 * 256 : A.in[28 + which];
            return TItem{W + (size_t)(64 * kb) * 256 + n0, (bf16*)(X.ws + WS_WGU) + ((size_t)(e * 2 + (n0 >> 7)) * 256 + which * 128 + (n0 & 127)) * 1024 + 64 * kb, nullptr, 256, 1024}; }
        const int kb = q >> 5, nb = q & 31;
        const float* W = e < 64 ? A.in[27] + (size_t)e * 256 * 1024 : A.in[30];
        return TItem{W + (size_t)(64 * kb) * 1024 + 32 * nb, (bf16*)(X.ws + WS_WD) + ((size_t)e * 1024 + 32 * nb) * 256 + 64 * kb, nullptr, 1024, 256}; };
    TITEM_LOOP(gete, gw, NGW, 65 * 384, scr, X.lane);
}

__device__ __forceinline__ int swz(int r, int ch, int rowbytes) { return r * rowbytes + (((ch & ~15) | ((ch ^ r) & 15)) << 4); }

#define GSWZ(r, ch) ((r) * 256 + ((((ch) ^ ((r) & 15) ^ (((r) >> 4) & 7)) & 15) << 4))
template <bool DRY = false> __device__ __forceinline__ void gmlp_units(Ctx& X, const Args& A) {
    unsigned char* ws = X.ws; LAS unsigned char* lds = X.lds;
    LAS f32x2* st = (LAS f32x2*)(lds + 32768);
    const int w = X.wave, l = X.lane, fr = l & 15, fq = l >> 4;
    int unit = X.bid; if (unit >= 2048) return;
    const int g = unit & 7, c0 = g * 128;
    const int ch = X.tid & 15, s0 = 4 * (X.tid >> 4);
    const int srow = X.tid >> 2, spart = X.tid & 3;
    bf16x8 wfr[4]; float gg[8], bb[8];
    { const bf16* Wg = (const bf16*)(ws + WS_WSP) + g * 16384 + (16 * w + fr) * 128 + 8 * fq;
#pragma unroll
      for (int kk = 0; kk < 4; ++kk) wfr[kk] = *(const bf16x8*)(Wg + 32 * kk);
#pragma unroll
      for (int j = 0; j < 8; ++j) { gg[j] = A.in[5][c0 + ch * 8 + j]; bb[j] = A.in[6][c0 + ch * 8 + j]; } }
    const float bs = A.in[8][g * 128 + 16 * w + fr];
    const LaneTr TR = lane_tr_make(fr, fq);
    f32x2 sp[4]; u32x4 gvq[4]; u32x2 uq[8], un[8];
#define GM_PREFETCH(unit_, udst) do { const int t0_ = ((unit_) >> 3) * 128; \
        _Pragma("unroll") for (int i = 0; i < 4; ++i) sp[i] = ((const f32x2*)(ws + WS_VSTAT))[(size_t)(t0_ + srow) * 16 + i * 4 + spart]; \
        _Pragma("unroll") for (int i = 0; i < 4; ++i) gvq[i] = *(const u32x4*)((const bf16*)(ws + WS_GV) + (size_t)(t0_ + s0 + i) * 1024 + c0 + ch * 8); \
        const bf16* up_ = (const bf16*)(ws + WS_U) + (size_t)(t0_ + 16 * w + TR.fr2) * 1024 + c0 + 4 * TR.fq2; \
        _Pragma("unroll") for (int cb = 0; cb < 8; ++cb) udst[cb] = *(const u32x2*)(up_ + 16 * cb); } while (0)
    GM_PREFETCH(unit, uq);
    for (; unit < 2048; unit += X.G) {
        const int t0 = (unit >> 3) * 128;
        { float s = (sp[0].x + sp[1].x) + (sp[2].x + sp[3].x), q = (sp[0].y + sp[1].y) + (sp[2].y + sp[3].y);
          s += __shfl_xor(s, 1); s += __shfl_xor(s, 2); q += __shfl_xor(q, 1); q += __shfl_xor(q, 2);
          const float mean = s * (1.f / 1024.f), var = q * (1.f / 1024.f) - mean * mean;
          if (spart == 0) st[srow] = (f32x2){mean, 1.f / sqrtf(var + LN_EPS)}; }
        __syncthreads();
        { float y[4][8];
#pragma unroll
          for (int i = 0; i < 4; ++i) { const f32x2 ms = st[s0 + i]; const u32x4 wv = gvq[i];
              const float v[8] = {bflo(wv.x), bfhi(wv.x), bflo(wv.y), bfhi(wv.y), bflo(wv.z), bfhi(wv.z), bflo(wv.w), bfhi(wv.w)};
#pragma unroll
              for (int j = 0; j < 8; ++j) y[i][j] = (v[j] - ms.x) * ms.y * gg[j] + bb[j]; }
#pragma unroll
          for (int j = 0; j < 8; ++j) { const int c = ch * 8 + j;
              *(LAS u32x2*)(lds + GSWZ(c, s0 >> 3) + (s0 & 7) * 2) = (u32x2){pk2(y[0][j], y[1][j]), pk2(y[2][j], y[3][j])}; } }
        const bool has_next = unit + X.G < 2048;
        if (has_next) GM_PREFETCH(unit + X.G, un);
        __syncthreads();
        f32x4 acc[8];
#pragma unroll
        for (int cb = 0; cb < 8; ++cb) acc[cb] = (f32x4){0.f, 0.f, 0.f, 0.f};
        const int kmax = w >> 1;
#pragma unroll
        for (int kk = 0; kk < 4; ++kk) {
            if (kk <= kmax) {
#pragma unroll
                for (int cb = 0; cb < 8; ++cb) {
                    const bf16x8 afr = *(const LAS bf16x8*)(lds + GSWZ(16 * cb + fr, 4 * kk + fq));
                    acc[cb] = __builtin_amdgcn_mfma_f32_16x16x32_bf16(afr, wfr[kk], acc[cb], 0, 0, 0);
                }
            }
        }
        const int t = 16 * w + TR.fr2;
        bf16* up = (bf16*)(ws + WS_U) + (size_t)(t0 + t) * 1024 + c0 + 4 * TR.fq2;
#pragma unroll
        for (int cb = 0; cb < 8; ++cb) {
            const u32x2 uw = lane_tr2_inv(TR, uq[cb]);
            const float y0 = bflo(uw.x) * (acc[cb][0] + bs), y1 = bfhi(uw.x) * (acc[cb][1] + bs), y2 = bflo(uw.y) * (acc[cb][2] + bs), y3 = bfhi(uw.y) * (acc[cb][3] + bs);
            bf16* op = DRY ? (bf16*)(ws + WS_MEMB) + (size_t)((t0 + t) & 4095) * 1024 + c0 + 4 * TR.fq2 : up;
            *(u32x2*)(op + 16 * cb) = lane_tr2(TR, (u32x2){pk2(y0, y1), pk2(y2, y3)});
        }
        if (has_next) {
#pragma unroll
            for (int cb = 0; cb < 8; ++cb) uq[cb] = un[cb]; }
        __syncthreads();
    }
#undef GM_PREFETCH
}

template <bool DRY = false> __device__ __forceinline__ void lru_unit(Ctx& X, const Args& A, int unit) {
    const int b = unit >> 4, g = (unit >> 1) & 7, half = unit & 1, c0 = g * 128, oc0 = c0 + half * 64;
    unsigned char* ws = X.ws; LAS unsigned char* lds = X.lds;
    constexpr int O_XC = 0, O_A = 32768, O_B = 65536, O_RAW = 98304, O_SA = 132096, O_SB = 134144, O_CY = 136192, O_CW = 136448;
    LAS float* La = (LAS float*)(lds + O_A); LAS float* Lb = (LAS float*)(lds + O_B);
    LAS float* SA = (LAS float*)(lds + O_SA); LAS float* SB = (LAS float*)(lds + O_SB); LAS float* CY = (LAS float*)(lds + O_CY); LAS float* CW = (LAS float*)(lds + O_CW);
    const int w = X.wave, l = X.lane, fr = l & 15, fq = l >> 4, ob = w & 3, th = w >> 2;
    const int cch = X.tid & 15;
    const bf16* wpa = (const bf16*)(ws + WS_WA) + g * 16384 + (half * 64 + 16 * ob + fr) * 128 + 8 * fq; const bf16* wpi = (const bf16*)(ws + WS_WI) + g * 16384 + (half * 64 + 16 * ob + fr) * 128 + 8 * fq;
    const int och = oc0 + 16 * ob + fr;
    const float ba = A.in[12][och], bi = A.in[14][och];
    const float lam = A.in[15][och];
    const float sp8 = 8.0f * (lam > 15.f ? __expf(-lam) : log1pf(__expf(-lam)));
    if (X.tid < 64) CY[X.tid] = 0.f;
    for (int i = X.tid; i < 640; i += 512) CW[i] = i < 512 ? A.in[9][(i >> 7) * 1024 + c0 + (i & 127)] : A.in[10][c0 + (i - 512)];
    u32x4 rawq[5];
#define LRU_RAWLOAD(n_) do { const int t0_ = b * SEQ + (n_) * 128; _Pragma("unroll") for (int i = 0; i < 5; ++i) { const int q = X.tid + 512 * i; const int row = q >> 4, ch = q & 15; \
        rawq[i] = (u32x4){0u, 0u, 0u, 0u}; if (q < 131 * 16 && ((n_) > 0 || row >= 3)) rawq[i] = *(const u32x4*)((const bf16*)(ws + WS_LX) + (size_t)(t0_ - 3 + row) * 1024 + c0 + ch * 8); } } while (0)
    LRU_RAWLOAD(0);
    bf16x8 wa[4], wi[4];
#pragma unroll
    for (int kk = 0; kk < 4; ++kk) { wa[kk] = *(const bf16x8*)(wpa + 32 * kk); wi[kk] = *(const bf16x8*)(wpi + 32 * kk); }
    const int o = X.tid & 63, sg = X.tid >> 6;
#pragma unroll 1
    for (int n = 0; n < 16; ++n) {
        const int t0 = b * SEQ + n * 128;
        u32x4 gq[2];
#pragma unroll
        for (int i = 0; i < 2; ++i) { const int q = X.tid + 512 * i; gq[i] = *(const u32x4*)((const bf16*)(ws + WS_LG) + (size_t)(t0 + (q >> 3)) * 1024 + oc0 + (q & 7) * 8); }
#pragma unroll
        for (int i = 0; i < 5; ++i) { const int q = X.tid + 512 * i; if (q < 131 * 16) *(LAS u32x4*)(lds + O_RAW + (q >> 4) * 256 + (q & 15) * 16) = rawq[i]; }
        __syncthreads();
        if (n + 1 < 16) LRU_RAWLOAD(n + 1);
#pragma unroll 1
        for (int ih = 0; ih < 4; ih += 2) {
            float a[2][8];
            { const f32x4 b0 = *(const LAS f32x4*)(CW + 512 + cch * 8), b1 = *(const LAS f32x4*)(CW + 512 + cch * 8 + 4);
#pragma unroll
              for (int i = 0; i < 2; ++i) { a[i][0] = b0.x; a[i][1] = b0.y; a[i][2] = b0.z; a[i][3] = b0.w; a[i][4] = b1.x; a[i][5] = b1.y; a[i][6] = b1.z; a[i][7] = b1.w; } }
#pragma unroll
            for (int k = 0; k < 4; ++k) { const f32x4 w0 = *(const LAS f32x4*)(CW + k * 128 + cch * 8), w1 = *(const LAS f32x4*)(CW + k * 128 + cch * 8 + 4);
                const float cw[8] = {w0.x, w0.y, w0.z, w0.w, w1.x, w1.y, w1.z, w1.w};
#pragma unroll
                for (int i = 0; i < 2; ++i) { const int t = (X.tid + 512 * (ih + i)) >> 4;
                    const u32x4 v = *(const LAS u32x4*)(lds + O_RAW + (t + 3 - k) * 256 + cch * 16);
                    const float xv[8] = {bflo(v.x), bfhi(v.x), bflo(v.y), bfhi(v.y), bflo(v.z), bfhi(v.z), bflo(v.w), bfhi(v.w)};
#pragma unroll
                    for (int j = 0; j < 8; ++j) a[i][j] += cw[j] * xv[j]; } }
#pragma unroll
            for (int i = 0; i < 2; ++i) { const int t = (X.tid + 512 * (ih + i)) >> 4;
                *(LAS u32x4*)(lds + O_XC + swz(t, cch, 256)) = (u32x4){pk2(a[i][0], a[i][1]), pk2(a[i][2], a[i][3]), pk2(a[i][4], a[i][5]), pk2(a[i][6], a[i][7])}; }
        }
        __syncthreads();
#pragma unroll
        for (int i = 0; i < 2; ++i) { const int q = X.tid + 512 * i; *(LAS u32x4*)(lds + O_RAW + (q >> 3) * 128 + (q & 7) * 16) = gq[i]; }
        {
            const int cx = half * 64 + 16 * ob + fr;
#pragma unroll 2
            for (int tb = 0; tb < 4; ++tb) {
                f32x4 pa = (f32x4){0.f, 0.f, 0.f, 0.f}, pi = (f32x4){0.f, 0.f, 0.f, 0.f};
#pragma unroll
                for (int kk = 0; kk < 4; ++kk) { const bf16x8 xa = *(const LAS bf16x8*)(lds + O_XC + swz(64 * th + 16 * tb + fr, 4 * kk + fq, 256));
                    pa = __builtin_amdgcn_mfma_f32_16x16x32_bf16(xa, wa[kk], pa, 0, 0, 0); pi = __builtin_amdgcn_mfma_f32_16x16x32_bf16(xa, wi[kk], pi, 0, 0, 0); }
#pragma unroll
                for (int r = 0; r < 4; ++r) { const int t = 64 * th + 16 * tb + 4 * fq + r;
                    const float ra = fast_sigmoid(pa[r] + ba), ri = fast_sigmoid(pi[r] + bi);
                    const float x2 = -2.f * ra * sp8;
                    const float a = __builtin_amdgcn_exp2f(0.72134752f * x2);
                    const float em = x2 > -0.25f ? -x2 * (1.f + x2 * (0.5f + x2 * (0.16666667f + x2 * 0.041666668f))) : 1.f - a * a;
                    const float mult = __builtin_amdgcn_sqrtf(em);
                    const float xc = bf2f(*(const LAS bf16*)(lds + O_XC + swz(t, cx >> 3, 256) + (cx & 7) * 2));
                    La[t * 64 + 16 * ob + fr] = a; Lb[t * 64 + 16 * ob + fr] = mult * ri * xc; }
            }
        }
        __syncthreads();
        float ac[16], pl[16];
        { float Ag = 1.f, Bc = 0.f;
#pragma unroll
            for (int j = 0; j < 16; ++j) { const float a = La[(16 * sg + j) * 64 + o], bt = Lb[(16 * sg + j) * 64 + o]; Ag *= a; Bc = a * Bc + bt; ac[j] = Ag; pl[j] = Bc; }
            SA[sg * 64 + o] = Ag; SB[sg * 64 + o] = Bc; }
        __syncthreads();
        float h = CY[o];
        for (int s2 = 0; s2 < sg; ++s2) h = SA[s2 * 64 + o] * h + SB[s2 * 64 + o];
        { LAS bf16* yt = (LAS bf16*)(lds + O_RAW) + (16 * sg) * 64 + o; const float hin = h;
#pragma unroll
            for (int j = 0; j < 16; ++j) { h = pl[j] + ac[j] * hin; yt[j * 64] = (bf16)f2bf(h * bf2f(yt[j * 64])); } }
        __syncthreads();
        if (sg == 7) CY[o] = h;
#pragma unroll
        for (int i = 0; i < 2; ++i) { const int q = X.tid + 512 * i; bf16* ob_ = DRY ? (bf16*)(ws + WS_MEMB) + (size_t)((t0 + (q >> 3)) & 4095) * 1024 : (bf16*)(ws + WS_LG) + (size_t)(t0 + (q >> 3)) * 1024;
            *(u32x4*)(ob_ + oc0 + (q & 7) * 8) = *(const LAS u32x4*)(lds + O_RAW + (q >> 3) * 128 + (q & 7) * 16); }
        __syncthreads();
    }
#undef LRU_RAWLOAD
    __syncthreads();
}

__device__ __forceinline__ void attn_unit(Ctx& X, const Args& A, int unit) {
    const int b = unit >> 5, h = (unit >> 3) & 3, qt = unit & 7, t0 = b * SEQ + qt * 256;
    unsigned char* ws = X.ws; LAS unsigned char* lds = X.lds;
    const int w = X.wave, l = X.lane, fr = l & 15, fq = l >> 4;
    int fb[4];
#pragma unroll
    for (int k = 0; k < 4; ++k) fb[k] = fr * 512 + ((((4 * k + fq) ^ fr) & 15) << 4);
    const int wb = (X.tid >> 5) * 512 + (((X.tid & 31) & 16) << 4) + ((((X.tid & 31) ^ (X.tid >> 5)) & 15) << 4);
    const LaneTr TR = lane_tr_make(fr, fq);
    u32x4 qraw[2][8];
#pragma unroll
    for (int rb = 0; rb < 2; ++rb) { const bf16* qrow = (const bf16*)(ws + WS_Q) + (size_t)(t0 + 32 * w + 16 * rb + TR.fr2) * 1024 + h * 256 + 8 * TR.fq2;
#pragma unroll
        for (int kk = 0; kk < 8; ++kk) qraw[rb][kk] = *(const u32x4*)(qrow + 32 * kk); }
#pragma unroll 1
    for (int i0 = 0; i0 < 16; i0 += 8) {
#pragma unroll
        for (int i = 0; i < 8; ++i) { const int q = X.tid + 512 * (i0 + i), rho = q >> 5, ch = q & 31;
            const int key = 32 * (rho >> 5) + 8 * ((rho >> 2) & 3) + 4 * ((rho >> 4) & 1) + (rho & 3);
            *(LAS u32x4*)(lds + wb + (i0 + i) * 8192) = *(const u32x4*)((const bf16*)(ws + WS_KB) + (size_t)(b * 256 + key) * 1024 + h * 256 + ch * 8); }
    }
    __syncthreads();
    bf16x8 pf[2][8]; float inv[2];
    {
        bf16x8 qf[2][8];
#pragma unroll
        for (int rb = 0; rb < 2; ++rb)
#pragma unroll
            for (int kk = 0; kk < 8; ++kk) qf[rb][kk] = __builtin_bit_cast(bf16x8, lane_tr4_inv(TR, qraw[rb][kk]));
        f32x4 s[2][16];
#pragma unroll
        for (int blk = 0; blk < 16; ++blk) { s[0][blk] = (f32x4){0.f, 0.f, 0.f, 0.f}; s[1][blk] = (f32x4){0.f, 0.f, 0.f, 0.f};
#pragma unroll
            for (int kk = 0; kk < 8; ++kk) { const bf16x8 kf = *(const LAS bf16x8*)(lds + fb[kk & 3] + blk * 8192 + (kk >> 2) * 256);
                s[0][blk] = __builtin_amdgcn_mfma_f32_16x16x32_bf16(kf, qf[0][kk], s[0][blk], 0, 0, 0);
                s[1][blk] = __builtin_amdgcn_mfma_f32_16x16x32_bf16(kf, qf[1][kk], s[1][blk], 0, 0, 0); } }
#pragma unroll
        for (int rb = 0; rb < 2; ++rb) {
            float mx = -3.0e38f;
#pragma unroll
            for (int blk = 0; blk < 16; ++blk) mx = fmaxf(fmaxf(fmaxf(s[rb][blk][0], s[rb][blk][1]), fmaxf(s[rb][blk][2], s[rb][blk][3])), mx);
            mx = fmaxf(mx, __shfl_xor(mx, 16)); mx = fmaxf(mx, __shfl_xor(mx, 32));
            float sum = 0.f;
#pragma unroll
            for (int kk = 0; kk < 8; ++kk) { float pe[8];
#pragma unroll
                for (int r = 0; r < 4; ++r) { pe[r] = __builtin_amdgcn_exp2f((s[rb][2 * kk][r] - mx) * 1.4426950408889634f); pe[4 + r] = __builtin_amdgcn_exp2f((s[rb][2 * kk + 1][r] - mx) * 1.4426950408889634f); }
                sum += ((pe[0] + pe[1]) + (pe[2] + pe[3])) + ((pe[4] + pe[5]) + (pe[6] + pe[7]));
                u32x4 pw; pw.x = pk2(pe[0], pe[1]); pw.y = pk2(pe[2], pe[3]); pw.z = pk2(pe[4], pe[5]); pw.w = pk2(pe[6], pe[7]);
                pf[rb][kk] = __builtin_bit_cast(bf16x8, pw); }
            sum += __shfl_xor(sum, 16); sum += __shfl_xor(sum, 32);
            inv[rb] = 1.0f / sum;
            asm volatile("" ::: "memory");
        }
    }
    __syncthreads();
#pragma unroll 1
    for (int i0 = 0; i0 < 16; i0 += 8) {
#pragma unroll
        for (int i = 0; i < 8; ++i) { const int q = X.tid + 512 * (i0 + i), d = q >> 5, ch = q & 31;
            *(LAS u32x4*)(lds + wb + (i0 + i) * 8192) = *(const u32x4*)((const bf16*)(ws + WS_VT) + (size_t)(h * 256 + d) * 4096 + b * 256 + ch * 8); }
    }
    __syncthreads();
#pragma unroll
    for (int db = 0; db < 16; ++db) { f32x4 o0 = (f32x4){0.f, 0.f, 0.f, 0.f}, o1 = (f32x4){0.f, 0.f, 0.f, 0.f};
#pragma unroll
        for (int kk = 0; kk < 8; ++kk) { const bf16x8 vf = *(const LAS bf16x8*)(lds + fb[kk & 3] + db * 8192 + (kk >> 2) * 256);
            o0 = __builtin_amdgcn_mfma_f32_16x16x32_bf16(vf, pf[0][kk], o0, 0, 0, 0); o1 = __builtin_amdgcn_mfma_f32_16x16x32_bf16(vf, pf[1][kk], o1, 0, 0, 0); }
        bf16* orow = (bf16*)(ws + WS_Q) + (size_t)(t0 + 32 * w + TR.fr2) * 1024 + h * 256 + 16 * db + 4 * TR.fq2;
        *(u32x2*)(orow) = lane_tr2(TR, (u32x2){pk2(o0[0] * inv[0], o0[1] * inv[0]), pk2(o0[2] * inv[0], o0[3] * inv[0])});
        *(u32x2*)(orow + 16 * 1024) = lane_tr2(TR, (u32x2){pk2(o1[0] * inv[1], o1[1] * inv[1]), pk2(o1[2] * inv[1], o1[3] * inv[1])}); }
    __syncthreads();
}

__device__ __forceinline__ void route_block(Ctx& X, const Args& A, int blk) {
    unsigned char* ws = X.ws; LAS unsigned char* lds = X.lds;
    LAS float* GB = (LAS float*)(lds + 65536);
    LAS f32x4* ST = (LAS f32x4*)(lds + 81920);
    LAS float* LG = (LAS float*)(lds + 83968);
    LAS int* HI = (LAS int*)(lds + 117248);
    LAS float* RB = (LAS float*)(lds + 117504);
    LAS unsigned long long* KEY = (LAS unsigned long long*)lds;
    const int w = X.wave, l = X.lane, fr = l & 15, fq = l >> 4;
    if (X.tid < 64) { RB[X.tid] = A.in[24][X.tid]; HI[X.tid] = 0; }
    for (int i = X.tid; i < 4096; i += 512) GB[i] = i < 1024 ? A.in[21][i] : i < 2048 ? A.in[22][i - 1024] : i < 3072 ? A.in[2][i - 2048] : A.in[3][i - 3072];
    {
        f32x4 gi[4], bi[4];
#pragma unroll
        for (int j = 0; j < 4; ++j) { gi[j] = ((const f32x4*)A.in[2] + l)[64 * j]; bi[j] = ((const f32x4*)A.in[3] + l)[64 * j]; }
        f32x4 va[4], vb[4]; u32x2 ma[4], mb[4]; f32x2 xa, xb;
#define R1_SLOAD(vd, md, xd, r_) do { const int m = blk * 128 + 16 * w + ((r_) < 16 ? (r_) : 15); const f32x4* xr = (const f32x4*)(A.in[0] + (size_t)m * D) + l; \
            const u32x2* mr = (const u32x2*)((const bf16*)(ws + WS_MO) + (size_t)m * D) + l; xd = ((const f32x2*)(ws + WS_XSTAT))[m]; \
            _Pragma("unroll") for (int j = 0; j < 4; ++j) { vd[j] = xr[64 * j]; md[j] = mr[64 * j]; } } while (0)
        R1_SLOAD(va, ma, xa, 0); R1_SLOAD(vb, mb, xb, 1);
#pragma unroll 1
        for (int r = 0; r < 16; ++r) {
            f32x4 v[4]; u32x2 mq[4]; const f32x2 xs = xa;
#pragma unroll
            for (int j = 0; j < 4; ++j) { v[j] = va[j]; mq[j] = ma[j]; va[j] = vb[j]; ma[j] = mb[j]; }
            xa = xb;
            R1_SLOAD(vb, mb, xb, r + 2);
            float s = 0.f;
#pragma unroll
            for (int j = 0; j < 4; ++j) { const f32x4 mo = (f32x4){bflo(mq[j].x), bfhi(mq[j].x), bflo(mq[j].y), bfhi(mq[j].y)};
                v[j] = DN_ALPHA * ((v[j] - xs.x) * xs.y * gi[j] + bi[j]) + mo; s += (v[j].x + v[j].y) + (v[j].z + v[j].w); }
            const float mean = wave_sum(s) * (1.f / D); float s2 = 0.f;
#pragma unroll
            for (int j = 0; j < 4; ++j) { const f32x4 d = v[j] - mean; s2 += (d.x * d.x + d.y * d.y) + (d.z * d.z + d.w * d.w); }
            const float rstd = 1.f / sqrtf(wave_sum(s2) * (1.f / D) + LN_EPS);
            if (l == 0) ST[16 * w + r] = (f32x4){xs.x, xs.y, mean, rstd};
        }
#undef R1_SLOAD
    }
    __syncthreads();
    {
        f32x4 acc[4];
#pragma unroll
        for (int n = 0; n < 4; ++n) acc[n] = (f32x4){0.f, 0.f, 0.f, 0.f};
        const int row = blk * 128 + 16 * w + fr; const f32x4 st = ST[16 * w + fr];
        const float* tr = A.in[0] + (size_t)row * D + 8 * fq; const bf16* mr = (const bf16*)(ws + WS_MO) + (size_t)row * D + 8 * fq; bf16* hr = (bf16*)X.out + (size_t)row * 2048 + 1024 + 8 * fq;
        u32x4 wq[4]; f32x4 t0, t1, n0, n1; u32x4 m0, mn;
#define R1_WLOAD(c) do { _Pragma("unroll") for (int i = 0; i < 4; ++i) { const int p_ = X.tid + 512 * i; \
            wq[i] = *(const u32x4*)((const bf16*)(ws + WS_WR) + (size_t)(p_ >> 10) * 65536 + (size_t)((p_ >> 4) & 63) * 1024 + (c) * 128 + (p_ & 15) * 8); } } while (0)
#define R1_WSTORE(c) do { _Pragma("unroll") for (int i = 0; i < 4; ++i) { const int p_ = X.tid + 512 * i; \
            *(LAS u32x4*)(lds + ((c) & 1) * 32768 + (p_ >> 10) * 16384 + swz((p_ >> 4) & 63, p_ & 15, 256)) = wq[i]; } } while (0)
        R1_WLOAD(0); t0 = *(const f32x4*)(tr); t1 = *(const f32x4*)(tr + 4); m0 = *(const u32x4*)(mr); R1_WSTORE(0);
        __syncthreads();
#pragma unroll 1
        for (int c = 0; c < 8; ++c) {
            if (c + 1 < 8) R1_WLOAD(c + 1);
            const LAS unsigned char* wb = lds + (c & 1) * 32768;
#pragma unroll
            for (int k = 0; k < 4; ++k) {
                const int kb = c * 128 + 32 * k + 8 * fq;
                { const int kn = (c * 4 + k + 1 < 32) ? (c * 128 + 32 * k + 32) : 0; n0 = *(const f32x4*)(tr + kn); n1 = *(const f32x4*)(tr + kn + 4); mn = *(const u32x4*)(mr + kn); }
                const f32x4 g0 = *(const LAS f32x4*)(GB + kb), g1 = *(const LAS f32x4*)(GB + kb + 4), b0 = *(const LAS f32x4*)(GB + 1024 + kb), b1 = *(const LAS f32x4*)(GB + 1024 + kb + 4);
                const f32x4 i0 = *(const LAS f32x4*)(GB + 2048 + kb), i1 = *(const LAS f32x4*)(GB + 2048 + kb + 4), j0 = *(const LAS f32x4*)(GB + 3072 + kb), j1 = *(const LAS f32x4*)(GB + 3072 + kb + 4);
                const f32x4 ma = (f32x4){bflo(m0.x), bfhi(m0.x), bflo(m0.y), bfhi(m0.y)}, mb = (f32x4){bflo(m0.z), bfhi(m0.z), bflo(m0.w), bfhi(m0.w)};
                const f32x4 ta = DN_ALPHA * ((t0 - st.x) * st.y * i0 + j0) + ma, tb = DN_ALPHA * ((t1 - st.x) * st.y * i1 + j1) + mb;
                const f32x4 h0 = (ta - st.z) * st.w * g0 + b0, h1 = (tb - st.z) * st.w * g1 + b1;
                const unsigned q0 = f2bf(h0.x), q1 = f2bf(h0.y), q2 = f2bf(h0.z), q3 = f2bf(h0.w), q4 = f2bf(h1.x), q5 = f2bf(h1.y), q6 = f2bf(h1.z), q7 = f2bf(h1.w);
                const u32x4 hw = (u32x4){q0 | (q1 << 16), q2 | (q3 << 16), q4 | (q5 << 16), q6 | (q7 << 16)};
                const u32x4 lw = (u32x4){pk2(h0.x - bf2f(q0), h0.y - bf2f(q1)), pk2(h0.z - bf2f(q2), h0.w - bf2f(q3)), pk2(h1.x - bf2f(q4), h1.y - bf2f(q5)), pk2(h1.z - bf2f(q6), h1.w - bf2f(q7))};
                *(u32x4*)(hr + c * 128 + 32 * k) = hw;
                const bf16x8 xh = __builtin_bit_cast(bf16x8, hw), xl = __builtin_bit_cast(bf16x8, lw);
#pragma unroll
                for (int n = 0; n < 4; ++n) { const bf16x8 wh = *(const LAS bf16x8*)(wb + swz(16 * n + fr, 4 * k + fq, 256)), wl = *(const LAS bf16x8*)(wb + 16384 + swz(16 * n + fr, 4 * k + fq, 256));
                    acc[n] = __builtin_amdgcn_mfma_f32_16x16x32_bf16(xh, wh, acc[n], 0, 0, 0);
                    acc[n] = __builtin_amdgcn_mfma_f32_16x16x32_bf16(xh, wl, acc[n], 0, 0, 0);
                    acc[n] = __builtin_amdgcn_mfma_f32_16x16x32_bf16(xl, wh, acc[n], 0, 0, 0); }
                t0 = n0; t1 = n1; m0 = mn;
            }
            if (c + 1 < 8) R1_WSTORE(c + 1);
            __syncthreads();
        }
#undef R1_WLOAD
#undef R1_WSTORE
#pragma unroll
        for (int n = 0; n < 4; ++n)
#pragma unroll
            for (int r = 0; r < 4; ++r) { const int e = 16 * n + fr; const float sg = 1.0f / (1.0f + __expf(-acc[n][r])); const float ch = sg + RB[e];
                const unsigned cb = __builtin_bit_cast(unsigned, ch); const unsigned ob = cb ^ ((cb >> 31) ? 0xffffffffu : 0x80000000u);
                LG[(16 * w + 4 * fq + r) * 65 + e] = ch;
                KEY[(16 * w + 4 * fq + r) * 65 + e] = ((unsigned long long)ob << 32) | (unsigned)(63 - e); }
    }
    __syncthreads();
    {
        const int tq = X.tid >> 2, part = X.tid & 3, tok = blk * 128 + tq;
        const LAS float* ch = LG + tq * 65; const LAS unsigned long long* ky = KEY + tq * 65;
        float g2[2];
#pragma unroll
        for (int i = 0; i < 2; ++i) { float m1 = -3.0e38f, m2 = -3.0e38f;
#pragma unroll
            for (int j = 0; j < 8; ++j) { const float v = ch[(2 * part + i) * 8 + j]; if (v > m1) { m2 = m1; m1 = v; } else if (v > m2) m2 = v; }
            g2[i] = m1 + m2; }
        float gs[8];
#pragma unroll
        for (int q = 0; q < 4; ++q) { gs[2 * q] = __shfl(g2[0], (X.lane & ~3) | q); gs[2 * q + 1] = __shfl(g2[1], (X.lane & ~3) | q); }
        unsigned gmask = 0u; int mygrp = 0;
#pragma unroll
        for (int it = 0; it < 4; ++it) { float best = -3.0e38f; int bi = 0;
#pragma unroll
            for (int g = 0; g < 8; ++g) { const bool ok = !((gmask >> g) & 1u) && gs[g] > best; best = ok ? gs[g] : best; bi = ok ? g : bi; }
            gmask |= 1u << bi; mygrp = (it == part) ? bi : mygrp; }
        unsigned long long kk[8];
#pragma unroll
        for (int j = 0; j < 8; ++j) kk[j] = ky[mygrp * 8 + j];
        int idx[8]; float wt[8]; float wsum = 0.f;
#pragma unroll
        for (int k = 0; k < 8; ++k) { unsigned long long best = 0ull;
#pragma unroll
            for (int j = 0; j < 8; ++j) best = kk[j] > best ? kk[j] : best;
            { unsigned lo = (unsigned)best, hi = (unsigned)(best >> 32);
              unsigned long long o = ((unsigned long long)(unsigned)__shfl_xor((int)hi, 1) << 32) | (unsigned)__shfl_xor((int)lo, 1); best = o > best ? o : best;
              lo = (unsigned)best; hi = (unsigned)(best >> 32);
              o = ((unsigned long long)(unsigned)__shfl_xor((int)hi, 2) << 32) | (unsigned)__shfl_xor((int)lo, 2); best = o > best ? o : best; }
            const int be = 63 - (int)(best & 63ull);
#pragma unroll
            for (int j = 0; j < 8; ++j) kk[j] = (kk[j] == best) ? 0ull : kk[j];
            idx[k] = be; wt[k] = ch[be] - RB[be]; wsum += wt[k]; }
        const float sc2 = ROUTED_SCALE / wsum;
        int* ip = (int*)(ws + WS_IDX) + (size_t)tok * 8; float* wp = (float*)(ws + WS_WTS) + (size_t)tok * 8; int* rp = (int*)(ws + WS_RK) + (size_t)tok * 8;
#pragma unroll
        for (int i = 0; i < 2; ++i) { const int k = 2 * part + i;
            int ik = idx[0]; float wk = wt[0];
#pragma unroll
            for (int q = 1; q < 8; ++q) { ik = (k == q) ? idx[q] : ik; wk = (k == q) ? wt[q] : wk; }
            ip[k] = ik; wp[k] = wk * sc2; rp[k] = atomicAdd((int*)(HI + ik), 1); }
    }
    __syncthreads();
    if (X.tid < 64) ((int*)(ws + WS_HIST))[blk * 64 + X.tid] = HI[X.tid];
    __syncthreads();
}

__device__ __forceinline__ void place_block(Ctx& X, const Args& A, int blk) {
    unsigned char* ws = X.ws; LAS unsigned char* lds = X.lds;
    LAS int* CNT = (LAS int*)lds; LAS int* PAD = CNT + 64; LAS int* BEF = CNT + 128; LAS int* PST = CNT + 192;
    const int chn = blk / BPC, jj = blk % BPC;
    if (X.tid < 64) { const int* hp = (const int*)(ws + WS_HIST) + (size_t)(chn * BPC) * 64 + X.tid; int cnt = 0, bef = 0;
        for (int j = 0; j < BPC; ++j) { const int v = hp[j * 64]; cnt += v; bef += (j < jj) ? v : 0; }
        CNT[X.tid] = cnt; PAD[X.tid] = (cnt + 255) & ~255; BEF[X.tid] = bef; }
    __syncthreads();
    if (X.tid == 0) { int ps = 0; for (int e = 0; e < 64; ++e) { PST[e] = ps; ps += PAD[e]; } PST[64] = ps; }
    __syncthreads();
    unsigned* rowoff = (unsigned*)(ws + WS_ROWOFF) + (size_t)chn * CROWS; float* roww = (float*)(ws + WS_ROWW) + (size_t)chn * CROWS;
#define ROWOFF_IDX(d) ((((d) >> 8) << 8) + (((d) & 63) << 2) + (((d) >> 6) & 3))
    if (X.tid < 128) { const int tok = blk * 128 + X.tid;
        const int* ip = (const int*)(ws + WS_IDX) + (size_t)tok * 8; const float* wp = (const float*)(ws + WS_WTS) + (size_t)tok * 8; const int* rp = (const int*)(ws + WS_RK) + (size_t)tok * 8;
        int* pp = (int*)(ws + WS_POS) + (size_t)tok * 8;
#pragma unroll
        for (int k = 0; k < 8; ++k) { const int e = ip[k]; const int dest = PST[e] + BEF[e] + rp[k]; rowoff[ROWOFF_IDX(dest)] = (unsigned)tok * 4096u; roww[dest] = wp[k]; pp[k] = dest; } }
    if (jj == 0) {
        for (int e = 0; e < 64; ++e) { const int st = PST[e] + CNT[e], en = PST[e] + PAD[e]; if (st + X.tid < en) { const int d = st + X.tid; rowoff[ROWOFF_IDX(d)] = (unsigned)(chn * CT) * 4096u; roww[d] = 0.f; } }
        int* te = (int*)(ws + WS_TILEE) + chn * (RTMAX + SHT);
        if (X.tid < 64) { for (int tl = PST[X.tid] >> 8; tl < (PST[X.tid] + PAD[X.tid]) >> 8; ++tl) te[tl] = X.tid; }
        if (X.tid < SHT) te[RTMAX + X.tid] = 64;
        if (X.tid == 0) ((int*)(ws + WS_NTILE))[chn] = PST[64] >> 8;
    }
    if (X.tid < 128) { const int i = jj * 128 + X.tid, d = RTMAX * 256 + i; rowoff[ROWOFF_IDX(d)] = (unsigned)(chn * CT + i) * 4096u; roww[d] = 1.0f; }
    __syncthreads();
}

template <bool DRY = false> __device__ __forceinline__ void combine_rows(Ctx& X, const Args& A, int chn) {
    unsigned char* ws = X.ws; int l_ = X.lane; asm volatile("" : "+v"(l_)); const int l = l_; const int gw = X.vcu * 8 + X.wave, NGW = X.G * 8;
    f32x4 g2[4], b2[4];
#pragma unroll
    for (int j = 0; j < 4; ++j) { g2[j] = ((const f32x4*)A.in[31] + l)[64 * j]; b2[j] = ((const f32x4*)A.in[32] + l)[64 * j]; }
    const unsigned char* Y = ws + WS_Y;
    const int nrows = (CT - gw + NGW - 1) / NGW;
    if (nrows <= 0) return;
#define F_ROW(i_) (gw + ((i_) < nrows ? (i_) : nrows - 1) * NGW)
#define F_LOADPOS(dst, i_) do { const int* pp_ = (const int*)(ws + WS_POS) + (size_t)(chn * CT + F_ROW(i_)) * 8; _Pragma("unroll") for (int k = 0; k < 8; ++k) dst[k] = __builtin_amdgcn_readfirstlane(pp_[k]); } while (0)
#define F_LOADROW(yd, hd, pos, i_) do { const int r_ = F_ROW(i_); \
        const u32x2* hq_ = (const u32x2*)((const bf16*)X.out + (size_t)(chn * CT + r_) * 2048 + 1024) + l;     \
        _Pragma("unroll") for (int j = 0; j < 4; ++j) hd[j] = hq_[64 * j]; \
        _Pragma("unroll") for (int k = 0; k < 9; ++k) { const int row_ = k < 8 ? pos[k < 8 ? k : 0] : RTMAX * 256 + r_; const unsigned* yr_ = (const unsigned*)(Y + (size_t)row_ * 1024) + l; \
            _Pragma("unroll") for (int j = 0; j < 4; ++j) yd[k][j] = yr_[64 * j]; } } while (0)
    int pc[8], pn[8];
    unsigned yc[9][4], yn[9][4]; u32x2 hc[4], hn[4];
    F_LOADPOS(pc, 0); F_LOADROW(yc, hc, pc, 0); F_LOADPOS(pn, 1);
#pragma unroll 1
    for (int i = 0; i < nrows; ++i) {
        F_LOADROW(yn, hn, pn, i + 1);
        F_LOADPOS(pc, i + 2);
        const int m = chn * CT + gw + i * NGW;
        f32x4 v[4]; float s, mean, s2, rstd;
#pragma unroll
        for (int j = 0; j < 4; ++j) v[j] = DN_ALPHA * (f32x4){bflo(hc[j].x), bfhi(hc[j].x), bflo(hc[j].y), bfhi(hc[j].y)};
        f32x4 ys[4] = {(f32x4){0.f, 0.f, 0.f, 0.f}, (f32x4){0.f, 0.f, 0.f, 0.f}, (f32x4){0.f, 0.f, 0.f, 0.f}, (f32x4){0.f, 0.f, 0.f, 0.f}};
#pragma unroll
        for (int k = 0; k < 9; ++k)
#pragma unroll
            for (int j = 0; j < 4; ++j) { const int y = (int)yc[k][j];
                ys[j].x += __builtin_amdgcn_cvt_f32_fp8(y, 0); ys[j].y += __builtin_amdgcn_cvt_f32_fp8(y, 1); ys[j].z += __builtin_amdgcn_cvt_f32_fp8(y, 2); ys[j].w += __builtin_amdgcn_cvt_f32_fp8(y, 3); }
#pragma unroll
        for (int j = 0; j < 4; ++j) v[j] += ys[j] * (1.0f / YSCALE);
        s = 0.f;
#pragma unroll
        for (int j = 0; j < 4; ++j) s += (v[j].x + v[j].y) + (v[j].z + v[j].w);
        mean = wave_sum(s) * (1.f / D); s2 = 0.f;
#pragma unroll
        for (int j = 0; j < 4; ++j) { v[j] = v[j] - mean; s2 += (v[j].x * v[j].x + v[j].y * v[j].y) + (v[j].z * v[j].z + v[j].w * v[j].w); }
        rstd = 1.f / sqrtf(wave_sum(s2) * (1.f / D) + LN_EPS);
        f32x4* xr = (f32x4*)(X.out + (size_t)m * D) + l;
#pragma unroll
        for (int j = 0; j < 4; ++j) { f32x4* orow = DRY ? (f32x4*)(ws + WS_HB + (size_t)chn * CROWS * 512 + (size_t)(gw + i * NGW) * 4096) + l : xr; orow[64 * j] = v[j] * rstd * g2[j] + b2[j]; }
#pragma unroll
        for (int k = 0; k < 9; ++k)
#pragma unroll
            for (int j = 0; j < 4; ++j) yc[k][j] = yn[k][j];
#pragma unroll
        for (int j = 0; j < 4; ++j) hc[j] = hn[j];
#pragma unroll
        for (int k = 0; k < 8; ++k) { const int t_ = pn[k]; pn[k] = pc[k]; pc[k] = t_; }
    }
#undef F_ROW
#undef F_LOADPOS
#undef F_LOADROW
}
#if MK_DEBUG
__device__ __forceinline__ unsigned hsh(unsigned x) { x ^= x >> 16; x *= 0x7feb352dU; x ^= x >> 15; x *= 0x846ca68bU; x ^= x >> 16; return x; }
__device__ __forceinline__ void dbg_fail(unsigned char* ws, int code) { atomicMin((int*)ws, code); }
__device__ __forceinline__ bool closef(float got, float ex, float rel, float ab) { return fabsf(got - ex) <= rel * fabsf(ex) + ab; }
__device__ __forceinline__ float rbf(float x) { return bf2f(f2bf(x)); }
__device__ __forceinline__ float wave_max(float v) {
#pragma unroll
    for (int o = 1; o < 64; o <<= 1) v = fmaxf(v, __shfl_xor(v, o));
    return v;
}
#define DBG_EXP(ws) ((float*)((ws) + 65536))

__device__ __forceinline__ void chk_B(Ctx& X, const Args& A) {
    unsigned char* ws = X.ws; const int gw = X.bid * 8 + X.wave, NGW = X.G * 8, l = X.lane;
    for (int s = gw; s < 4096; s += NGW) {
        const int t = hsh(2 * s + 1) % T, c = hsh(2 * s + 2) % 8192;
        float acc = 0.f;
        for (int k = l; k < 1024; k += 64) acc += bf2f(((const bf16*)(ws + WS_H0))[(size_t)t * 1024 + k]) * rbf(A.in[4][(size_t)k * 8192 + c]);
        const float z = wave_sum(acc); const int reg = c >> 10, cc = c & 1023;
        const float ex = (reg == 0 || reg == 1 || reg == 3) ? gelu_tanh(z) : reg == 2 ? z : reg == 4 ? z * 0.0625f : 1.f / (1.f + __expf(-z));
        const bf16* buf = reg == 0 ? (const bf16*)(ws + WS_U) : reg == 1 ? (const bf16*)(ws + WS_GV) : reg == 2 ? (const bf16*)(ws + WS_LX) : reg == 3 ? (const bf16*)(ws + WS_LG) : reg == 4 ? (const bf16*)(ws + WS_Q) :
                          reg == 5 ? (const bf16*)(ws + WS_G0) : reg == 6 ? (const bf16*)X.out : (const bf16*)X.out + (size_t)T * 1024;
        const float got = bf2f(buf[(size_t)t * 1024 + cc]);
        if (!closef(got, ex, 0.02f, 0.01f)) { dbg_fail(ws, 10 + reg); }
    }
    for (int s = gw; s < 1024; s += NGW) {
        const int m = hsh(3 * s + 7) % TM, c = hsh(3 * s + 8) % 2048;
        float acc = 0.f;
        for (int k = l; k < 1024; k += 64) acc += rbf(A.in[1][(size_t)m * 1024 + k]) * rbf(A.in[16][(size_t)k * 2048 + c]);
        const float z = wave_sum(acc);
        const float got = c < 1024 ? bf2f(((const bf16*)(ws + WS_KB))[(size_t)m * 1024 + c]) : bf2f(((const bf16*)(ws + WS_VT))[(size_t)(c - 1024) * 4096 + m]);
        if (!closef(got, z, 0.02f, 0.01f)) dbg_fail(ws, c < 1024 ? 18 : 19);
    }
    for (int s = gw; s < 512; s += NGW) {
        const int t = hsh(5 * s + 3) % T; float a = 0.f, q = 0.f;
        for (int k = l; k < 1024; k += 64) { const float v = bf2f(((const bf16*)(ws + WS_GV))[(size_t)t * 1024 + k]); a += v; q += v * v; }
        a = wave_sum(a); q = wave_sum(q);
        float pa = 0.f, pq = 0.f; if (l < 16) { const f32x2 p = ((const f32x2*)(ws + WS_VSTAT))[(size_t)t * 16 + l]; pa = p.x; pq = p.y; }
        pa = wave_sum(pa); pq = wave_sum(pq);
        if (!closef(pa, a, 0.01f, 0.5f) || !closef(pq, q, 0.01f, 0.5f)) dbg_fail(ws, 9);
    }
}

__device__ __forceinline__ void chk_C_pre(Ctx& X, const Args& A) {
    unsigned char* ws = X.ws; const int gw = X.bid * 8 + X.wave, NGW = X.G * 8, l = X.lane;
    float* EX = DBG_EXP(ws);
    for (int s = gw; s < 3 * 512; s += NGW) {
        const int kind = s / 512, si = s % 512;
        if (kind == 0) {
            const int t = hsh(7 * si + 1) % T, c = hsh(7 * si + 2) % 1024, g = c >> 7, t0 = t & ~127, tl = t - t0;
            float acc = 0.f;
            for (int sr = 0; sr <= tl; ++sr) {
                float a = 0.f, q = 0.f;
                for (int k = l; k < 1024; k += 64) { const float v = bf2f(((const bf16*)(ws + WS_GV))[(size_t)(t0 + sr) * 1024 + k]); a += v; q += v * v; }
                a = wave_sum(a); q = wave_sum(q);
                const float mean = a * (1.f / 1024.f), var = q * (1.f / 1024.f) - mean * mean, rstd = 1.f / sqrtf(var + LN_EPS);
                const float vn = (bf2f(((const bf16*)(ws + WS_GV))[(size_t)(t0 + sr) * 1024 + c]) - mean) * rstd * A.in[5][c] + A.in[6][c];
                acc += A.in[7][(g * 128 + tl) * 128 + sr] * vn;
            }
            EX[s] = bf2f(((const bf16*)(ws + WS_U))[(size_t)t * 1024 + c]) * (acc + A.in[8][g * 128 + tl]);
        } else if (kind == 1) {
            if (si >= 64) { EX[s] = 0.f; continue; }
            const int b = hsh(11 * si + 1) % NB, ch = hsh(11 * si + 2) % 1024, ts = hsh(11 * si + 3) % SEQ, g = ch >> 7, o = ch & 127;
            float xh[2][3] = {{0.f, 0.f, 0.f}, {0.f, 0.f, 0.f}}; float h = 0.f;
            const float lam = A.in[15][ch], sp = log1pf(__expf(-lam)), ba = A.in[12][ch], bi = A.in[14][ch];
            float cw[2][4], cb[2], wa[2], wi[2];
#pragma unroll
            for (int q = 0; q < 2; ++q) { const int i = g * 128 + l + 64 * q; cb[q] = A.in[10][i];
#pragma unroll
                for (int k = 0; k < 4; ++k) cw[q][k] = A.in[9][k * 1024 + i];
                wa[q] = rbf(A.in[11][(size_t)g * 16384 + (l + 64 * q) * 128 + o]); wi[q] = rbf(A.in[13][(size_t)g * 16384 + (l + 64 * q) * 128 + o]); }
            for (int t = 0; t <= ts; ++t) {
                float xc[2]; float pa = 0.f, pi = 0.f;
#pragma unroll
                for (int q = 0; q < 2; ++q) { const float x0 = bf2f(((const bf16*)(ws + WS_LX))[(size_t)(b * SEQ + t) * 1024 + g * 128 + l + 64 * q]);
                    xc[q] = rbf(cb[q] + cw[q][0] * x0 + cw[q][1] * xh[q][0] + cw[q][2] * xh[q][1] + cw[q][3] * xh[q][2]);
                    xh[q][2] = xh[q][1]; xh[q][1] = xh[q][0]; xh[q][0] = x0; pa += xc[q] * wa[q]; pi += xc[q] * wi[q]; }
                pa = wave_sum(pa); pi = wave_sum(pi);
                const float xo = __shfl(o < 64 ? xc[0] : xc[1], o & 63);
                const float r = 1.f / (1.f + __expf(-(pa + ba))), ii = 1.f / (1.f + __expf(-(pi + bi)));
                const float la = -8.f * r * sp, a = __expf(la), mult = sqrtf(-expm1f(2.f * la));
                h = a * h + mult * ii * xo;
            }
            EX[s] = h * bf2f(((const bf16*)(ws + WS_LG))[(size_t)(b * SEQ + ts) * 1024 + ch]);
        } else {
            const int t = hsh(13 * si + 1) % T, c = hsh(13 * si + 2) % 1024, hh = c >> 8, b = t / SEQ;
            float sc[4];
#pragma unroll
            for (int j = 0; j < 4; ++j) { const int m = l + 64 * j; float a = 0.f;
                for (int dd = 0; dd < 256; ++dd) a += bf2f(((const bf16*)(ws + WS_Q))[(size_t)t * 1024 + hh * 256 + dd]) * bf2f(((const bf16*)(ws + WS_KB))[(size_t)(b * 256 + m) * 1024 + hh * 256 + dd]);
                sc[j] = a; }
            const float mx = wave_max(fmaxf(fmaxf(sc[0], sc[1]), fmaxf(sc[2], sc[3])));
            float sum = 0.f, ov = 0.f;
#pragma unroll
            for (int j = 0; j < 4; ++j) { const float p = __expf(sc[j] - mx); sum += p; ov += p * bf2f(((const bf16*)(ws + WS_VT))[(size_t)c * 4096 + b * 256 + l + 64 * j]); }
            sum = wave_sum(sum); ov = wave_sum(ov);
            EX[s] = ov / sum;
        }
    }
}
__device__ __forceinline__ void chk_C_post(Ctx& X, const Args& A) {
    unsigned char* ws = X.ws; const float* EX = DBG_EXP(ws);
    for (int s = X.bid * 512 + X.tid; s < 3 * 512; s += X.G * 512) {
        const int kind = s / 512, si = s % 512; float got;
        if (kind == 0) { const int t = hsh(7 * si + 1) % T, c = hsh(7 * si + 2) % 1024; got = bf2f(((const bf16*)(ws + WS_U))[(size_t)t * 1024 + c]); }
        else if (kind == 1) { if (si >= 64) continue; const int b = hsh(11 * si + 1) % NB, ch = hsh(11 * si + 2) % 1024, ts = hsh(11 * si + 3) % SEQ; got = bf2f(((const bf16*)(ws + WS_LG))[(size_t)(b * SEQ + ts) * 1024 + ch]); }
        else { const int t = hsh(13 * si + 1) % T, c = hsh(13 * si + 2) % 1024; got = bf2f(((const bf16*)(ws + WS_Q))[(size_t)t * 1024 + c]); }
        if (!closef(got, EX[s], 0.04f, kind == 2 ? 0.004f : 0.02f)) dbg_fail(ws, 20 + kind);
    }
}
__device__ __forceinline__ void chk_D1(Ctx& X, const Args& A) {
    unsigned char* ws = X.ws; const int gw = X.bid * 8 + X.wave, NGW = X.G * 8, l = X.lane;
    for (int s = gw; s < 2048; s += NGW) {
        const int t = hsh(17 * s + 1) % T, c = hsh(17 * s + 2) % 1024; float ex = 0.f;
#pragma unroll
        for (int k = 0; k < 3; ++k) {
            const bf16* Y = (const bf16*)(ws + (k == 0 ? WS_U : k == 1 ? WS_LG : WS_Q)); const bf16* Gk = k == 0 ? (const bf16*)(ws + WS_G0) : k == 1 ? (const bf16*)X.out : (const bf16*)X.out + (size_t)T * 1024;
            float acc = 0.f;
            for (int j = l; j < 1024; j += 64) acc += bf2f(Y[(size_t)t * 1024 + j]) * rbf(A.in[17 + k][(size_t)j * 1024 + c]);
            ex += bf2f(Gk[(size_t)t * 1024 + c]) * wave_sum(acc);
        }
        const float got = bf2f(((const bf16*)(ws + WS_H0))[(size_t)t * 1024 + c]);
        if (!closef(got, ex, 0.02f, 0.01f)) dbg_fail(ws, 30);
    }
}
__device__ __forceinline__ void chk_D2(Ctx& X, const Args& A) {
    unsigned char* ws = X.ws; const int gw = X.bid * 8 + X.wave, NGW = X.G * 8, l = X.lane;
    for (int s = gw; s < 2048; s += NGW) {
        const int t = hsh(19 * s + 1) % T, c = hsh(19 * s + 2) % 1024;
        float a = 0.f, q = 0.f, acc = 0.f;
        for (int j = l; j < 1024; j += 64) { const float v = A.in[0][(size_t)t * 1024 + j]; a += v; q += v * v; acc += bf2f(((const bf16*)(ws + WS_H0))[(size_t)t * 1024 + j]) * rbf(A.in[20][(size_t)j * 1024 + c]); }
        a = wave_sum(a); q = wave_sum(q); acc = wave_sum(acc);
        const float mean = a * (1.f / 1024.f), var = q * (1.f / 1024.f) - mean * mean, rstd = 1.f / sqrtf(var + LN_EPS);
        const float ex = DN_ALPHA * ((A.in[0][(size_t)t * 1024 + c] - mean) * rstd * A.in[2][c] + A.in[3][c]) + acc;
        if (!closef(X.out[(size_t)t * 1024 + c], ex, 0.01f, 0.01f)) dbg_fail(ws, 31);
    }
}
__device__ __forceinline__ void chk_R1(Ctx& X, const Args& A) {
    unsigned char* ws = X.ws; const int gw = X.bid * 8 + X.wave, NGW = X.G * 8, l = X.lane;
    LAS float* hb = (LAS float*)(X.lds + X.wave * 8192); LAS float* cs = hb + 1024; LAS float* ss = cs + 64;
    int nmis = 0;
    for (int s = gw; s < 2048; s += NGW) {
        const int t = hsh(23 * s + 1) % T;
        float a = 0.f, q = 0.f;
        for (int j = l; j < 1024; j += 64) { const float v = X.out[(size_t)t * 1024 + j]; a += v; q += v * v; }
        a = wave_sum(a); q = wave_sum(q);
        const float mean = a * (1.f / 1024.f), var = q * (1.f / 1024.f) - mean * mean, rstd = 1.f / sqrtf(var + LN_EPS);
        bool badh = false;
        for (int j = l; j < 1024; j += 64) { const float h1 = (X.out[(size_t)t * 1024 + j] - mean) * rstd * A.in[21][j] + A.in[22][j]; hb[j] = h1;
            if (!closef(bf2f(((const bf16*)(ws + WS_H1))[(size_t)t * 1024 + j]), h1, 0.01f, 0.003f)) badh = true; }
        if (__any(badh)) dbg_fail(ws, 39);
        LDS_WAIT();
        float lg = 0.f;
        for (int k = 0; k < 1024; ++k) lg += hb[k] * A.in[23][k * 64 + l];
        const float sg = 1.f / (1.f + __expf(-lg)); ss[l] = sg; cs[l] = sg + A.in[24][l];
        LDS_WAIT();
        unsigned long long sel = 0ull, ksel = 0ull; float wsum = 0.f;
        {
            float gs[8]; unsigned gmask = 0u;
            for (int g = 0; g < 8; ++g) { float m1 = -3e38f, m2 = -3e38f; for (int j = 0; j < 8; ++j) { const float v = cs[g * 8 + j]; if (v > m1) { m2 = m1; m1 = v; } else if (v > m2) m2 = v; } gs[g] = m1 + m2; }
            for (int it = 0; it < 4; ++it) { float best = -3e38f; int bi = 0; for (int g = 0; g < 8; ++g) if (!((gmask >> g) & 1u) && gs[g] > best) { best = gs[g]; bi = g; } gmask |= 1u << bi; }
            for (int k = 0; k < 8; ++k) { float best = -3e38f; int be = 0; for (int e = 0; e < 64; ++e) { const float v = cs[e]; if (((gmask >> (e >> 3)) & 1u) && !((sel >> e) & 1ull) && v > best) { best = v; be = e; } } sel |= 1ull << be; wsum += ss[be]; }
        }
        const int* ip = (const int*)(ws + WS_IDX) + (size_t)t * 8; const float* wp = (const float*)(ws + WS_WTS) + (size_t)t * 8;
        bool wbad = false;
        for (int k = 0; k < 8; ++k) { const int e = ip[k]; if (e < 0 || e > 63) { dbg_fail(ws, 42); continue; } ksel |= 1ull << e; if (!closef(wp[k], ss[e] / wsum * ROUTED_SCALE, 0.01f, 1e-4f)) wbad = true; }
        if (ksel != sel) ++nmis; else if (wbad) dbg_fail(ws, 41);
        LDS_WAIT();
    }
    if (nmis > 0 && l == 0) atomicAdd((int*)ws + 4, nmis);
}
__device__ __forceinline__ void chk_R2(Ctx& X, const Args& A) {
    unsigned char* ws = X.ws;
    if (X.bid == 0 && X.tid == 0 && ((const int*)ws)[4] > 100) dbg_fail(ws, 40);
    for (int s = X.bid * 512 + X.tid; s < 16384; s += X.G * 512) {
        const int tok = hsh(29 * s + 1) % T, k = hsh(29 * s + 2) % 8, chn = tok / CT;
        const int dest = ((const int*)(ws + WS_POS))[tok * 8 + k], e = ((const int*)(ws + WS_IDX))[tok * 8 + k];
        const int nt = ((const int*)(ws + WS_NTILE))[chn];
        if (nt < CT / 32 || nt > RTMAX || dest < 0 || dest >= nt * 256) { dbg_fail(ws, 50); continue; }
        const unsigned ro = ((const unsigned*)(ws + WS_ROWOFF))[(size_t)chn * CROWS + ROWOFF_IDX(dest)];
        if (ro != (unsigned)tok * 2048u) dbg_fail(ws, 51);
        if (((const float*)(ws + WS_ROWW))[(size_t)chn * CROWS + dest] != ((const float*)(ws + WS_WTS))[tok * 8 + k]) dbg_fail(ws, 52);
        if (((const int*)(ws + WS_TILEE))[chn * (RTMAX + SHT) + (dest >> 8)] != e) dbg_fail(ws, 53);
    }
}
__device__ __forceinline__ void chk_E(Ctx& X, const Args& A, int chn, int which) {
    unsigned char* ws = X.ws; const int gw = X.bid * 8 + X.wave, NGW = X.G * 8, l = X.lane;
    const int nt = ((const int*)(ws + WS_NTILE))[chn];
    for (int s = gw; s < 2048; s += NGW) {
        const int ti = hsh(31 * s + 1 + chn) % (nt + SHT), tile = ti < nt ? ti : RTMAX + (ti - nt), row = tile * 256 + hsh(31 * s + 2) % 256;
        const int e = ((const int*)(ws + WS_TILEE))[chn * (RTMAX + SHT) + tile];
        if (e < 0 || e > 64) { dbg_fail(ws, 59); continue; }
        if (which == 0) {
            const int col = hsh(31 * s + 3) % 256;
            const unsigned tok = ((const unsigned*)(ws + WS_ROWOFF))[(size_t)chn * CROWS + ROWOFF_IDX(row)] / 2048u;
            const float* Wg = e < 64 ? A.in[25] + (size_t)e * 262144 : A.in[28]; const float* Wu = e < 64 ? A.in[26] + (size_t)e * 262144 : A.in[29];
            float ag = 0.f, au = 0.f;
            for (int k = l; k < 1024; k += 64) { const float hv = bf2f(((const bf16*)(ws + WS_H1))[(size_t)tok * 1024 + k]); ag += hv * rbf(Wg[(size_t)k * 256 + col]); au += hv * rbf(Wu[(size_t)k * 256 + col]); }
            ag = wave_sum(ag); au = wave_sum(au);
            const float ex = ag / (1.f + __expf(-ag)) * au;
            if (!closef(bf2f(((const bf16*)(ws + WS_HB))[((size_t)chn * CROWS + row) * 256 + col]), ex * ((const float*)(ws + WS_ROWW))[(size_t)chn * CROWS + row], 0.03f, 0.003f)) dbg_fail(ws, 60 + chn);
        } else {
            const int col = hsh(31 * s + 3) % 1024;
            const float* Wd = e < 64 ? A.in[27] + (size_t)e * 262144 : A.in[30];
            float acc = 0.f;
            for (int j = l; j < 256; j += 64) acc += bf2f(((const bf16*)(ws + WS_HB))[((size_t)chn * CROWS + row) * 256 + j]) * rbf(Wd[(size_t)j * 1024 + col]);
            acc = wave_sum(acc);
            { const int yw = ((const int*)(ws + WS_Y))[((size_t)row * 1024 + col) >> 2]; const int bs = col & 3; const float yv = (bs == 0 ? __builtin_amdgcn_cvt_f32_fp8(yw, 0) : bs == 1 ? __builtin_amdgcn_cvt_f32_fp8(yw, 1) : bs == 2 ? __builtin_amdgcn_cvt_f32_fp8(yw, 2) : __builtin_amdgcn_cvt_f32_fp8(yw, 3)) * (1.f / YSCALE);
              if (!closef(yv, acc, 0.08f, 0.004f)) dbg_fail(ws, 70 + chn); }
        }
    }
}
__device__ __forceinline__ void dbg_finish(Ctx& X) {
    const int* cw = (const int*)X.ws; const int code = cw[0];
    if (code != 0x7fffffff) { const float v = sqrtf((float)code); for (size_t i = (size_t)X.bid * 512 + X.tid; i < (size_t)T * D; i += (size_t)X.G * 512) X.out[i] = v; }
}
#endif
#define XB_TMO      128
#define XB_XCNT(j)  (256  + 64 * (j))
#define XB_XSUB(j)  (1280 + 64 * (j))
#define XB_XGEN(j)  (2304 + 64 * (j))
#define XB_TOP      3328
#define XB_TOPGEN   3392
#define XCD_BAR_WORDS 3456
#define XB_SPIN_CAP (1u << 18)

__device__ __forceinline__ unsigned xb_ld(unsigned* p)              { return __hip_atomic_load(p, __ATOMIC_RELAXED, __HIP_MEMORY_SCOPE_AGENT); }
__device__ __forceinline__ unsigned xb_add(unsigned* p, unsigned v) { return __hip_atomic_fetch_add(p, v, __ATOMIC_RELAXED, __HIP_MEMORY_SCOPE_AGENT); }
__device__ __forceinline__ unsigned xb_xcc_id() { return (unsigned)__builtin_amdgcn_s_getreg((3 << 11) | 20) & 0xFu; }
#define XB_SPIN(cond, bar) do { unsigned _sp = 0; while (cond) { __builtin_amdgcn_s_sleep(1); \
    if ((++_sp & 255u) == 0u) { if (xb_ld(&(bar)[XB_TMO])) break; if (_sp > XB_SPIN_CAP) { atomicAdd(&(bar)[XB_TMO], 1u); break; } } } } while (0)

struct XcdBarrier {
    unsigned* bar; unsigned x; int wv;
    volatile LAS unsigned* st;
};

__device__ __forceinline__ XcdBarrier xcd_barrier_post(unsigned* bar, volatile LAS unsigned* st, int wv) {
    XcdBarrier b; b.bar = bar; b.x = xb_xcc_id(); b.st = st; b.wv = wv;
    if (wv == 0 && lane_id() == 0) (void)xb_add(&bar[XB_XCNT(b.x)], 1u);
    return b;
}
__device__ __forceinline__ void xcd_barrier_complete(unsigned* bar, unsigned x, unsigned& nloc, unsigned& nx) {
    const unsigned G = gridDim.x * gridDim.y * gridDim.z;
    unsigned sum, cnt, mine, sp = 0u;
    for (;;) {
        sum = 0u; cnt = 0u; mine = 0u;
#pragma unroll
        for (unsigned j = 0; j < 16; ++j) { const unsigned c = xb_ld(&bar[XB_XCNT(j)]); sum += c; cnt += (c > 0u) ? 1u : 0u; mine = (j == x) ? c : mine; }
        if (sum == G) break;
        __builtin_amdgcn_s_sleep(1);
        if ((++sp & 255u) == 0u) { if (xb_ld(&bar[XB_TMO])) break; if (sp > XB_SPIN_CAP) { atomicAdd(&bar[XB_TMO], 1u); break; } }
    }
    nloc = mine > 0u ? mine : 1u; nx = cnt > 0u ? cnt : 1u;
}

__device__ __forceinline__ void xcd_barrier(const XcdBarrier& b) {
    asm volatile("s_waitcnt vmcnt(0)" ::: "memory");
    __syncthreads();
    if (b.wv == 0 && lane_id() == 0) {
        unsigned* bar = b.bar;
        __builtin_amdgcn_s_waitcnt(0);
        unsigned nloc = b.st[0], nx = b.st[1];
        if (nloc == 0u) { xcd_barrier_complete(bar, b.x, nloc, nx); b.st[0] = nloc; b.st[1] = nx; }
        const unsigned old = xb_add(&bar[XB_XSUB(b.x)], 1u);
        const unsigned gen = old / nloc;
        if (old + 1u == (gen + 1u) * nloc) {
            __builtin_amdgcn_fence(__ATOMIC_RELEASE, "agent");
            asm volatile("s_waitcnt vmcnt(0)" ::: "memory");
            const unsigned og = xb_add(&bar[XB_TOP], 1u);
            const unsigned tg = og / nx;
            if (og + 1u == (tg + 1u) * nx) xb_add(&bar[XB_TOPGEN], 1u);
            else XB_SPIN(xb_ld(&bar[XB_TOPGEN]) == tg, bar);
            __builtin_amdgcn_fence(__ATOMIC_ACQUIRE, "agent");
            xb_add(&bar[XB_XGEN(b.x)], 1u);
            asm volatile("s_waitcnt vmcnt(0)" ::: "memory");
        } else {
            XB_SPIN(xb_ld(&bar[XB_XGEN(b.x)]) == gen, bar);
            __builtin_amdgcn_fence(__ATOMIC_ACQUIRE, "agent");
            asm volatile("s_waitcnt vmcnt(0)" ::: "memory");
        }
    }
    __syncthreads();
}


#ifndef MK_USE_CG
#define MK_USE_CG 1
#endif
#ifndef MK_SPLIT
#define MK_SPLIT 0
#endif
#ifndef MK_TIME
#define MK_TIME -1
#endif
#ifndef MK_TOFF
#define MK_TOFF 0.f
#endif
#if MK_TIME >= 0
#define TSTAMP() do { if (X.bid == 0 && X.tid == 0) ((unsigned long long*)(X.ws + 4096))[ph] = __builtin_amdgcn_s_memrealtime(); } while (0)
#define TSTAMP2(k) do { if (X.bid == 0 && X.tid == 0) ((unsigned long long*)(X.ws + 4096))[k] = __builtin_amdgcn_s_memrealtime(); } while (0)
#else
#define TSTAMP() do {} while (0)
#define TSTAMP2(k) do {} while (0)
#endif
#if MK_DEBUG
#define DBG(x) x
#else
#define DBG(x)
#endif
#ifndef MK_GT
#define MK_GT 0
#endif
#ifndef MK_GBLK
#define MK_GBLK 0
#endif
#ifndef MK_GWAVE
#define MK_GWAVE 0
#endif
#ifndef MK_GSEL
#define MK_GSEL 0
#endif
#ifndef MK_GMUL
#define MK_GMUL 10.f
#endif
#ifndef MK_GGAIN
#define MK_GGAIN 4
#endif
#if MK_GT
#define GT_SPIN(id) do { if (MK_GT == (id)) { GRID_SYNC(); if (X.bid == MK_GBLK && X.wave == MK_GWAVE) { volatile LAS unsigned* g_ = (volatile LAS unsigned*)(X.lds + 141312 + MK_GWAVE * 32); \
        unsigned v_ = (MK_GSEL == 16) ? g_[0] + g_[1] + g_[2] + g_[3] + g_[4] + g_[6] : (MK_GSEL == 17) ? g_[2] + g_[4] : g_[MK_GSEL & 7]; v_ = (unsigned)__builtin_amdgcn_readfirstlane((int)v_) * MK_GGAIN; \
        const unsigned t0_ = (unsigned)__builtin_amdgcn_s_memrealtime(); while ((unsigned)__builtin_amdgcn_s_memrealtime() - t0_ < v_) __builtin_amdgcn_s_sleep(8); } __syncthreads(); } } while (0)
#define GT_CALL(id, PT, P) do { if (MK_GT == (id)) pg8::gemm_phase<PT, true>(X.lds, P, X.tid, nullptr); else pg8::gemm_phase(X.lds, P, X.tid); } while (0)
#else
#define GT_CALL(id, PT, P) pg8::gemm_phase(X.lds, P, X.tid)
#define GT_SPIN(id) do {} while (0)
#endif
#ifndef MK_TA
#define MK_TA MK_TIME
#define MK_TB (MK_TIME + 1)
#endif
#ifdef DRY_F
constexpr int N_PHASES = 8 + 3 * NCH;
#else
constexpr int N_PHASES = 8 + 2 * NCH;
#endif

__global__ void __launch_bounds__(512, 2) mk_fwd(Args a) {
    extern __shared__ __attribute__((aligned(16))) unsigned char lds_raw[];
#if MK_USE_CG || MK_DEBUG || MK_TIME >= 0
    cg::grid_group grid = cg::this_grid();
#endif
    Ctx X;
    X.out = a.out; X.ws = a.ws; X.lds = (LAS unsigned char*)lds_raw;
#define SET_TID() do { int t_ = wave0 * 64 + lane_id(); asm volatile("" : "+v"(t_)); X.tid = t_; X.lane = t_ & 63; X.wave = __builtin_amdgcn_readfirstlane(t_ >> 6); } while (0)
    const int wave0 = __builtin_amdgcn_readfirstlane((int)threadIdx.x >> 6);
    SET_TID();
    X.G = gridDim.x; X.bid = blockIdx.x; X.vcu = (X.G % 8 == 0) ? (X.bid % 8) * (X.G / 8) + X.bid / 8 : X.bid;
    if (X.tid < 16) ((volatile LAS unsigned*)(X.lds + LDS_BYTES - 64))[X.tid] = 0u;
#if MK_USE_CG
    if (blockIdx.x == 0) for (int i = X.tid; i < XCD_BAR_WORDS; i += 512) ((unsigned*)(X.ws + WS_BAR))[i] = 0u;
    XcdBarrier xbar; xbar.bar = nullptr; xbar.x = 0; xbar.st = nullptr; xbar.wv = 0;
#else
    __syncthreads();
    XcdBarrier xbar = xcd_barrier_post((unsigned*)(X.ws + WS_BAR), (volatile LAS unsigned*)(X.lds + LDS_BYTES - 64), wave0);
#endif
    const int lo = a.ph_lo, hi = a.ph_hi;
    int ph = 0;
    constexpr int TE_LDS = pg8::STAGE_BYTES + 4096;
#define LOAD_TILE_TABLE() do { for (int i_ = X.tid; i_ < NCH * (RTMAX + SHT); i_ += 512) ((LAS int*)(X.lds + TE_LDS))[i_] = ((const int*)(X.ws + WS_TILEE))[i_]; __syncthreads(); } while (0)
#define PHASE_BEGIN() if (lo <= ph && ph < hi) { SET_TID(); TSTAMP();
#if MK_USE_CG
#define GRID_SYNC_FIRST() do { asm volatile("s_waitcnt vmcnt(0) lgkmcnt(0)" ::: "memory"); __syncthreads(); grid.sync(); xbar = xcd_barrier_post((unsigned*)(X.ws + WS_BAR), (volatile LAS unsigned*)(X.lds + LDS_BYTES - 64), wave0); } while (0)
#define GRID_SYNC() xcd_barrier(xbar)
#else
#define GRID_SYNC() xcd_barrier(xbar)
#endif
#define PHASE_END() if (ph + 1 < hi) GRID_SYNC(); } ++ph;

    PHASE_BEGIN() DBG(if (X.bid == 0 && X.tid < 64) ((int*)X.ws)[X.tid] = (X.tid == 0) ? 0x7fffffff : 0;) phase_p0(X, a); if (ph + 1 < hi) GRID_SYNC_FIRST(); } ++ph;
    PHASE_BEGIN() { ProbB P{1024, X.G, X.bid, X.ws, (bf16*)X.out}; GT_CALL(1, ProbB, P); } GT_SPIN(1); DBG(if (X.tid == 0) atomicAdd((int*)X.ws + 40, 1);) PHASE_END()
    PHASE_BEGIN()
        DBG(if (X.tid == 0 && __hip_atomic_load((int*)X.ws + 40, __ATOMIC_RELAXED, __HIP_MEMORY_SCOPE_AGENT) != X.G) dbg_fail(X.ws, 2); chk_B(X, a); chk_C_pre(X, a); GRID_SYNC();)
        conv_wbr(X, a);
        __syncthreads();
#ifdef DRY_LRU
        for (int u = X.bid; u < 256; u += X.G) lru_unit<true>(X, a, u);
#endif
#ifdef DRY_GMLP
        gmlp_units<true>(X, a);
#endif
        SET_TID(); TSTAMP2(32);
        for (int u = X.bid; u < 256; u += X.G) lru_unit(X, a, u);
        SET_TID(); TSTAMP2(33);
        for (int u = X.bid; u < 512; u += X.G) attn_unit(X, a, u);
        SET_TID(); TSTAMP2(34);
        gmlp_units(X, a); TSTAMP2(35);
    PHASE_END()
    PHASE_BEGIN() DBG(chk_C_post(X, a);) { ProbD1 P{3072, X.G, X.bid, X.ws, (bf16*)X.out}; pg8::gemm_phase(X.lds, P, X.tid); } PHASE_END()
    PHASE_BEGIN() DBG(chk_D1(X, a); GRID_SYNC();) { ProbD2 P{1024, X.G, X.bid, X.ws}; GT_CALL(4, ProbD2, P); } GT_SPIN(4); conv_experts(X, a); PHASE_END()
    PHASE_BEGIN() DBG(chk_D2(X, a); GRID_SYNC();) for (int b = X.bid; b < T / 128; b += X.G) route_block(X, a, b); PHASE_END()
    PHASE_BEGIN() DBG(chk_R1(X, a); __syncthreads();) for (int b = X.bid; b < T / 128; b += X.G) place_block(X, a, b); PHASE_END()
    PHASE_BEGIN() DBG(chk_R2(X, a);) { LOAD_TILE_TABLE(); const int* np = (const int*)(X.ws + WS_NTILE); ProbE1 P{1024, X.G, X.vcu, X.ws, np[0], np[1], (LAS const int*)(X.lds + TE_LDS), X.out}; GT_CALL(3, ProbE1, P); } GT_SPIN(3); PHASE_END()
    for (int chn = 0; chn < NCH; ++chn) {
        PHASE_BEGIN() DBG(if (chn == 0) { for (int c2 = 0; c2 < NCH; ++c2) chk_E(X, a, c2, 0); GRID_SYNC(); }) { LOAD_TILE_TABLE(); const int nt = ((const int*)(X.ws + WS_NTILE))[chn]; ProbE2 P{256, X.G, X.vcu, X.ws, chn, nt, (LAS const int*)(X.lds + TE_LDS)}; GT_CALL(2, ProbE2, P); } GT_SPIN(2); PHASE_END()
#ifdef DRY_F
        PHASE_BEGIN() combine_rows<true>(X, a, chn); PHASE_END()
#endif
        PHASE_BEGIN() DBG(chk_E(X, a, chn, 1);) combine_rows(X, a, chn); PHASE_END()
    }
    DBG(grid.sync(); dbg_finish(X);)
#if MK_TIME >= 0 && defined(MK_PG)
    GRID_SYNC(); TSTAMP();
    if (X.bid == 0 && X.tid == 0) { const unsigned long long* ts = (const unsigned long long*)(X.ws + 4096); const unsigned long long d_ = (ts[MK_TB] - ts[MK_TA]) * MK_PG;
        const unsigned long long t0_ = __builtin_amdgcn_s_memrealtime(); while (__builtin_amdgcn_s_memrealtime() - t0_ < d_) __builtin_amdgcn_s_sleep(8); }
#elif MK_TIME >= 0
    GRID_SYNC(); TSTAMP(); GRID_SYNC();
    { const unsigned long long* ts = (const unsigned long long*)(X.ws + 4096); const float us = (float)(ts[MK_TIME + 1] - ts[MK_TIME]) * 0.01f;
      const float v = sqrtf(1.f + floorf((us + MK_TOFF) * (1.f / 16.f))); for (size_t i = (size_t)X.bid * 512 + X.tid; i < (size_t)T * D; i += (size_t)X.G * 512) X.out[i] = v; }
#endif
}

extern "C" void kernel_launch(void* const* d_in, const int* in_sizes, int n_in, void* d_out, int out_size, void* d_ws, size_t ws_size, hipStream_t stream) {
    static int grid = 0;
    if (grid == 0) {
        if (n_in != 33 || out_size != T * D || ws_size < WS_END) { fprintf(stderr, "kernel_launch: unexpected shapes: n_in %d out %d ws %zu\n", n_in, out_size, ws_size); grid = -1; return; }
        int dev = 0, cus = 0, per_cu = 0;
        if (hipGetDevice(&dev) != hipSuccess || hipDeviceGetAttribute(&cus, hipDeviceAttributeMultiprocessorCount, dev) != hipSuccess) { grid = -1; return; }
        if (hipFuncSetAttribute((const void*)mk_fwd, hipFuncAttributeMaxDynamicSharedMemorySize, LDS_BYTES) != hipSuccess) { fprintf(stderr, "kernel_launch: hipFuncSetAttribute failed\n"); grid = -1; return; }
        if (hipOccupancyMaxActiveBlocksPerMultiprocessor(&per_cu, (const void*)mk_fwd, 512, LDS_BYTES) != hipSuccess || per_cu < 1) { fprintf(stderr, "kernel_launch: occupancy query says %d\n", per_cu); per_cu = 1; }
        (void)hipGetLastError();
        grid = cus;
        fprintf(stderr, "kernel_launch: cus %d per_cu %d grid %d ws %zu\n", cus, per_cu, grid, ws_size);
    }
    if (grid < 0) return;
#if !MK_USE_CG
    if (hipMemsetAsync((char*)d_ws + WS_BAR, 0, XCD_BAR_WORDS * 4, stream) != hipSuccess) { fprintf(stderr, "kernel_launch: hipMemsetAsync of the barrier words failed\n"); return; }
#endif
    Args a{};
    for (int i = 0; i < 33; ++i) a.in[i] = (const float*)d_in[i];
    a.out = (float*)d_out; a.ws = (unsigned char*)d_ws;
#if MK_SPLIT
    for (int p = 0; p < N_PHASES; ++p) { a.ph_lo = p; a.ph_hi = p + 1;
#else
    { a.ph_lo = 0; a.ph_hi = N_PHASES;
#endif
        void* args[] = {&a};
        const hipError_t e = hipLaunchCooperativeKernel((const void*)mk_fwd, dim3(grid), dim3(512), args, LDS_BYTES, stream);
        if (e != hipSuccess) fprintf(stderr, "kernel_launch: cooperative launch failed: %s (grid %d)\n", hipGetErrorString(e), grid);
    }
}
```

```cpp
#include <hip/hip_runtime.h>
#include <hip/hip_cooperative_groups.h>
#include <cstdio>
#include <cstdint>
namespace cg = cooperative_groups;
#ifndef DBG_SEL
#define DBG_SEL 0
#endif
#ifndef MK_DEBUG
#define MK_DEBUG 0
#endif
#ifndef MK_TIME
#define MK_TIME -1
#endif
#if MK_TIME >= 0
#define XSTAMP(ws_, bid_, tid_, k) do { if ((bid_) == 0 && (tid_) == 0) ((unsigned long long*)((ws_) + 4096))[k] = __builtin_amdgcn_s_memrealtime(); } while (0)
#else
#define XSTAMP(ws_, bid_, tid_, k) do {} while (0)
#endif

constexpr int T = 32768, D = 1024, NB = 16, SEQ = 2048, MEMLEN = 256, TM = NB * MEMLEN;
constexpr int INC = 8192;
constexpr int NE = 64, TOPK = 8, ED = 256;
constexpr int NCH = 2, CT = T / NCH;
constexpr int RTMAX = CT * 8 / 256 + 64, SHT = CT / 256;
constexpr int CROWS = (RTMAX + SHT) * 256;
constexpr int BPC = CT / 128;
constexpr float LN_EPS = 1e-5f;
constexpr float DN_ALPHA = 1.189207115002721f;
constexpr float ROUTED_SCALE = 2.5f;
constexpr float YSCALE = 64.0f;

constexpr size_t MiB = 1u << 20;
constexpr size_t WS_CTL = 0;
constexpr size_t WS_BAR = 256 * 1024;
constexpr size_t WS_XSTAT = 1 * MiB;
constexpr size_t WS_VSTAT = 2 * MiB;
constexpr size_t WS_IDX = 6 * MiB;
constexpr size_t WS_WTS = 7 * MiB;
constexpr size_t WS_RK = 8 * MiB;
constexpr size_t WS_POS = 9 * MiB;
constexpr size_t WS_HIST = 10 * MiB;
constexpr size_t WS_TILEE = 10 * MiB + 64 * 1024;
constexpr size_t WS_NTILE = 10 * MiB + 96 * 1024;
constexpr size_t WS_ROWW = 13 * MiB;
constexpr size_t WS_ROWOFF = 11 * MiB;
constexpr size_t WS_WA = 16 * MiB;
constexpr size_t WS_WI = WS_WA + 256 * 1024;
constexpr size_t WS_WSP = WS_WI + 256 * 1024;
constexpr size_t WS_WR = WS_WSP + 256 * 1024;
constexpr size_t WS_WIN = 17 * MiB;
constexpr size_t WS_WBR = 17 * MiB, WS_WOUT = 23 * MiB;
constexpr size_t WS_WKV = 33 * MiB;
constexpr size_t WS_MEMB = 37 * MiB, WS_KB = 45 * MiB, WS_VT = 53 * MiB;
constexpr size_t WS_H0 = 61 * MiB;
constexpr size_t WS_U = 125 * MiB, WS_LG = 189 * MiB, WS_Q = 253 * MiB, WS_GV = 317 * MiB, WS_LX = 381 * MiB;
constexpr size_t WS_P = WS_GV;
constexpr size_t WS_G0 = 445 * MiB;
constexpr size_t WS_H1 = WS_H0, WS_H1LO = 125 * MiB;
constexpr size_t WS_MO = 447 * MiB;
constexpr size_t WS_WGU = 189 * MiB;
constexpr size_t WS_WD = 254 * MiB;
constexpr size_t WS_HB = 287 * MiB;
constexpr size_t WS_Y = 61 * MiB;
constexpr size_t WS_END = 509 * MiB;
static_assert(WS_WD + (size_t)65 * 1024 * 256 * 2 <= WS_HB && WS_HB + (size_t)NCH * CROWS * 256 * 2 <= WS_END && WS_Y + (size_t)CROWS * 1024 <= WS_WD, "MoE map");
static_assert(WS_WGU + (size_t)65 * 2 * 256 * 1024 * 2 <= WS_WD, "MoE map 2");
static_assert(WS_ROWOFF + (size_t)NCH * CROWS * 4 <= WS_ROWW && WS_ROWW + (size_t)NCH * CROWS * 4 <= WS_WA, "tables");

constexpr int LDS_BYTES = 147456;
#define LAS __attribute__((address_space(3)))
typedef unsigned short bf16;
typedef short bf16x8 __attribute__((ext_vector_type(8)));
typedef float f32x4 __attribute__((ext_vector_type(4)));
typedef float f32x2 __attribute__((ext_vector_type(2)));
typedef unsigned u32x4 __attribute__((ext_vector_type(4)));
typedef unsigned u32x2 __attribute__((ext_vector_type(2)));

__device__ __forceinline__ unsigned f2bf(float f) { unsigned u = __builtin_bit_cast(unsigned, f); return (u + 0x7fffu + ((u >> 16) & 1u)) >> 16; }
__device__ __forceinline__ unsigned pk2(float lo, float hi) { return f2bf(lo) | (f2bf(hi) << 16); }
__device__ __forceinline__ float bf2f(unsigned b) { return __builtin_bit_cast(float, b << 16); }
__device__ __forceinline__ float bflo(unsigned w) { return __builtin_bit_cast(float, w << 16); }
__device__ __forceinline__ float bfhi(unsigned w) { return __builtin_bit_cast(float, w & 0xffff0000u); }
__device__ __forceinline__ float wave_sum(float v) {
    v += __builtin_bit_cast(float, __builtin_amdgcn_update_dpp(0, __builtin_bit_cast(int, v), 0xB1, 0xF, 0xF, false));
    v += __builtin_bit_cast(float, __builtin_amdgcn_update_dpp(0, __builtin_bit_cast(int, v), 0x4E, 0xF, 0xF, false));
    v += __builtin_bit_cast(float, __builtin_amdgcn_update_dpp(0, __builtin_bit_cast(int, v), 0x124, 0xF, 0xF, false));
    v += __builtin_bit_cast(float, __builtin_amdgcn_update_dpp(0, __builtin_bit_cast(int, v), 0x128, 0xF, 0xF, false));
    const int vi = __builtin_bit_cast(int, v);
    const float a = __builtin_bit_cast(float, __builtin_amdgcn_readlane(vi, 0)), b = __builtin_bit_cast(float, __builtin_amdgcn_readlane(vi, 16));
    const float c = __builtin_bit_cast(float, __builtin_amdgcn_readlane(vi, 32)), d = __builtin_bit_cast(float, __builtin_amdgcn_readlane(vi, 48));
    return (a + b) + (c + d);
}
__device__ __forceinline__ float fast_sigmoid(float x) { return __builtin_amdgcn_rcpf(1.0f + __builtin_amdgcn_exp2f(-1.4426950408889634f * x)); }
__device__ __forceinline__ float gelu_tanh(float x) { const float u = x * (1.0f + 0.044715f * x * x); return x * fast_sigmoid(1.5957691216057308f * u); }
__device__ __forceinline__ int lane_id() { int l; asm volatile("v_mbcnt_lo_u32_b32 %0, -1, 0\n\tv_mbcnt_hi_u32_b32 %0, -1, %0" : "=v"(l)); return l; }
#define LDS_WAIT() asm volatile("s_waitcnt lgkmcnt(0)" ::: "memory")
#define VM_WAIT() asm volatile("s_waitcnt vmcnt(0)" ::: "memory")
namespace pg8 {
#define PG8_LAS __attribute__((address_space(3)))
typedef unsigned short bf16_t;
typedef short bf16x8 __attribute__((ext_vector_type(8)));
typedef float f32x4 __attribute__((ext_vector_type(4)));
typedef float f32x2 __attribute__((ext_vector_type(2)));
typedef unsigned u32x4 __attribute__((ext_vector_type(4)));
typedef unsigned u32x2 __attribute__((ext_vector_type(2)));
constexpr int BM = 256, BK = 64, HALF = 128, HTB = HALF * BK * 2  , STAGE_BYTES = 8 * HTB, NXCD = 8, WGM = 4;

__host__ __device__ __forceinline__ int lds_byte(int r, int c) { const int st = (r >> 4) * 2 + (c >> 5), rr = r & 15, cc = c & 31, ob = rr * 64 + cc * 2; return st * 1024 + (ob ^ (((ob >> 9) & 1) << 5)); }
__host__ __device__ __forceinline__ void stage_rc(int b, int& R, int& C) { const int st = b / 1024, sb = b % 1024, swz = sb ^ (((sb >> 9) & 1) << 5); R = (st >> 1) * 16 + swz / 64; C = (st & 1) * 32 + (swz % 64) / 2; }
__host__ __device__ __forceinline__ int perm32(int rho) { const int n = rho >> 4, i = rho & 15; return 8 * (i >> 2) + 4 * n + (i & 3); }

struct Unit { int pm, pn, aux, ch; };

__device__ __forceinline__ void tile_order(int L, int nM, int nN, int& pm, int& pn) {
    const int nwg = nM * nN; int wgid = L;
    { const int q = nwg / NXCD, r = nwg % NXCD, xcd = wgid % NXCD, off = wgid / NXCD; wgid = (xcd < r ? xcd * (q + 1) : r * (q + 1) + (xcd - r) * q) + off; }
    const int nig = WGM * nN, gid = wgid / nig, fm = gid * WGM, gsz = (nM - fm) < WGM ? (nM - fm) : WGM;
    pm = fm + ((wgid % nig) % gsz); pn = (wgid % nig) / gsz;
}

__device__ __forceinline__ unsigned cvt_pk_bf16(float lo, float hi) { unsigned r; asm volatile("v_cvt_pk_bf16_f32 %0, %1, %2" : "=v"(r) : "v"(lo), "v"(hi)); return r; }

#ifndef MK_GT
#define MK_GT 0
#endif
#if MK_GT
#define PG8_TS(k) do { if (TM) { const unsigned n_ = (unsigned)__builtin_amdgcn_s_memrealtime(); if (lane == 0) tl_[k] += n_ - tprev; tprev = n_; } } while (0)
#else
#define PG8_TS(k) do {} while (0)
#endif
template <class P, bool TM = false>
__device__ __forceinline__ void gemm_phase(PG8_LAS unsigned char* lds, const P& S, int tid_in, unsigned* tout = nullptr) {
#if MK_GT
    unsigned tprev = 0;
#define tl_ ((volatile PG8_LAS unsigned*)(lds + 141312 + wid * 32))

#endif
    int tid_ = tid_in; asm volatile("" : "+v"(tid_));
    const int tid = tid_, wid = __builtin_amdgcn_readfirstlane(tid >> 6), lane = tid & 63, wr = wid >> 2, wc = wid & 3, fr = lane & 15, fq = lane >> 4;
    const int K = P::KSEG > 0 ? P::KSEG * BK : S.K, nt = S.K / BK;
    unsigned voffA[2], voffB[2]; int RA[2], CA[2];
#pragma unroll
    for (int i = 0; i < 2; ++i) { int R, C; stage_rc(tid * 16 + i * 8192, R, C); const int Rb = P::PERM ? ((R & ~31) + perm32(R & 31)) : R;
        RA[i] = R; CA[i] = C; voffA[i] = (unsigned)(R * K + C) * 2u; voffB[i] = (unsigned)(Rb * K + C) * 2u; }
    const size_t kstep = (size_t)(BK * 2);
    const size_t hstep = (size_t)HALF * K * 2;
    const unsigned ldsw = (unsigned)wid * 1024u;
    const int aoff = lds_byte(wr * 64 + fr, fq * 8), boff = lds_byte(wc * 32 + fr, fq * 8);
#define PG8_SA(b, h) (((b) * 2 + (h)) * HTB)
#define PG8_SB(b, h) ((4 + (b) * 2 + (h)) * HTB)
#define PG8_STAGE(bufoff, gbase, o0, o1) do { \
        __builtin_amdgcn_global_load_lds((const unsigned*)((const char*)(gbase) + (o0)), (PG8_LAS unsigned*)(lds + (bufoff) + ldsw), 16, 0, 0); \
        __builtin_amdgcn_global_load_lds((const unsigned*)((const char*)(gbase) + (o1)), (PG8_LAS unsigned*)(lds + (bufoff) + ldsw + 8192), 16, 0, 0); } while (0)
#define PG8_STAGEB(bufoff, gbase) PG8_STAGE(bufoff, gbase, voffB[0], voffB[1])
#define PG8_STAGEA(bufoff, p, v, h) do { if constexpr (P::GATHER) PG8_STAGE(bufoff, p, (v)[h][0], (v)[h][1]); else PG8_STAGE(bufoff, (p) + (h) * hstep, voffA[0], voffA[1]); } while (0)
#define PG8_LDA(dst, b, h) do { _Pragma("unroll") for (int m = 0; m < 4; ++m) _Pragma("unroll") for (int k = 0; k < 2; ++k) dst[m][k] = *(const PG8_LAS bf16x8*)(lds + PG8_SA(b, h) + aoff + m * 2048 + k * 1024); } while (0)
#define PG8_LDB(dst, b, h) do { _Pragma("unroll") for (int n = 0; n < 2; ++n) _Pragma("unroll") for (int k = 0; k < 2; ++k) dst[n][k] = *(const PG8_LAS bf16x8*)(lds + PG8_SB(b, h) + boff + n * 2048 + k * 1024); } while (0)
#define PG8_MMA(ai, bj, At, Bt) do { __builtin_amdgcn_s_setprio(3); _Pragma("unroll") for (int m = 0; m < 4; ++m) _Pragma("unroll") for (int n = 0; n < 2; ++n) _Pragma("unroll") for (int k = 0; k < 2; ++k) \
        acc[ai][bj][m][n] = __builtin_amdgcn_mfma_f32_16x16x32_bf16(Bt[n][k], At[m][k], acc[ai][bj][m][n], 0, 0, 0); __builtin_amdgcn_s_setprio(0); } while (0)
#define PG8_WAIT_V(n) asm volatile("s_waitcnt vmcnt(" #n ")" ::: "memory")
#define PG8_WAIT_V_SP2(fresh) do { if constexpr (P::EPI_OPS > 0) asm volatile("s_cmp_lg_u32 %0, 0\n\ts_cbranch_scc1 .Lwa_%=\n\ts_waitcnt vmcnt(8)\n\ts_branch .Lwb_%=\n.Lwa_%=:\n\ts_waitcnt vmcnt(%1)\n.Lwb_%=:" :: "s"(__builtin_amdgcn_readfirstlane(fresh)), "n"(8 + P::EPI_OPS + (P::PRE == 2 ? 2 : 0)) : "memory", "scc"); \
        else asm volatile("s_waitcnt vmcnt(8)" ::: "memory"); } while (0)
#define PG8_WAIT_L(n) asm volatile("s_waitcnt lgkmcnt(" #n ")" ::: "memory")
#define PG8_BAR __builtin_amdgcn_s_barrier()
#define PG8_SCHED __builtin_amdgcn_sched_barrier(0)
    Unit cur, nxt; int ui = 0;
    if (!S.next(0, cur)) return;
    f32x4 acc[2][2][4][2];
#pragma unroll
    for (int a = 0; a < 2; ++a)
#pragma unroll
        for (int b = 0; b < 2; ++b)
#pragma unroll
            for (int m = 0; m < 4; ++m)
#pragma unroll
                for (int n = 0; n < 2; ++n) acc[a][b][m][n] = (f32x4){0.f, 0.f, 0.f, 0.f};
    bf16x8 At[4][2], B0[2][2], B1[2][2];
    unsigned vA[2][2] = {{0u, 0u}, {0u, 0u}};
#define PG8_PA(u, tile) (P::KSEG > 0 ? S.abase(u, (tile) / (P::KSEG > 0 ? P::KSEG : 1)) + (size_t)((tile) % (P::KSEG > 0 ? P::KSEG : 1)) * kstep : S.abase(u, 0) + (size_t)(tile) * kstep)
#define PG8_PB(u, tile) (P::KSEG > 0 ? S.bbase(u, (tile) / (P::KSEG > 0 ? P::KSEG : 1)) + (size_t)((tile) % (P::KSEG > 0 ? P::KSEG : 1)) * kstep : S.bbase(u, 0) + (size_t)(tile) * kstep)
    const char* cA = PG8_PA(cur, 0); const char* cB = PG8_PB(cur, 0);
    if constexpr (P::GATHER) { S.gather(cur, RA[0], vA, CA[0], CA[1]); if (tid < 64) S.rows_to_lds(cur, lds + STAGE_BYTES, 0, tid, false); }
    PG8_STAGEB(PG8_SB(0, 0), cB); PG8_STAGEB(PG8_SB(0, 1), cB + hstep); PG8_STAGEA(PG8_SA(0, 0), cA, vA, 0); PG8_STAGEA(PG8_SA(0, 1), cA, vA, 1);
    if (wr == 1) PG8_BAR;
    PG8_WAIT_V(2); PG8_BAR;
    PG8_STAGEB(PG8_SB(1, 0), cB + kstep); PG8_STAGEA(PG8_SA(1, 0), cA + kstep, vA, 0); PG8_STAGEB(PG8_SB(1, 1), cB + hstep + kstep);
    PG8_WAIT_V(6); PG8_BAR;
#if MK_GT
    if (TM) { if (lane < 8) tl_[lane] = 0u; tprev = (unsigned)__builtin_amdgcn_s_memrealtime(); }
#endif
    for (;;) {
        const bool has_next = S.next(ui + 1, nxt);
        const char* nA = has_next ? PG8_PA(nxt, 0) : PG8_PA(cur, 0); const char* nB = has_next ? PG8_PB(nxt, 0) : PG8_PB(cur, 0);
        if constexpr (P::GATHER) { if (has_next && tid < 64) S.rows_to_lds(nxt, lds + STAGE_BYTES, (ui + 1) % 3, tid, true); }
        for (int t = 0; t < nt; t += 2) {
            const bool last = (t == nt - 2); const int fresh = (t == 0 && ui > 0) ? 1 : 0;
            const char* a1 = PG8_PA(cur, t + 1);
            const char* a2 = last ? nA : PG8_PA(cur, t + 2); const char* b2 = last ? nB : PG8_PB(cur, t + 2);
            if constexpr (P::KSEG > 0) { if (t > 0 && (t % (P::KSEG > 0 ? P::KSEG : 1)) == 0) S.khook(acc, cur, t / (P::KSEG > 0 ? P::KSEG : 1), wr, wc, fr, fq); }
            const char* a3 = a2 + kstep; const char* b3 = b2 + kstep;
            PG8_LDB(B0, 0, 0); PG8_LDB(B1, 0, 1); PG8_SCHED; PG8_LDA(At, 0, 0); if (P::PRE != 1 || !fresh) PG8_STAGEA(PG8_SA(1, 1), a1, vA, 1);
            PG8_WAIT_V_SP2(fresh); PG8_WAIT_L(0); PG8_BAR; PG8_MMA(0, 0, At, B0); PG8_MMA(0, 1, At, B1); PG8_BAR; PG8_SCHED;
            if constexpr (P::GATHER) { if (last && has_next) { int R_, C_; stage_rc(tid * 16, R_, C_); const u32x4 o = *(const PG8_LAS u32x4*)(lds + STAGE_BYTES + R_ * 16); const unsigned c2 = (unsigned)C_ * 2u;
                vA[0][0] = o.x + c2; vA[0][1] = o.y + c2; vA[1][0] = o.z + c2; vA[1][1] = o.w + c2; } }
            PG8_LDA(At, 0, 1); PG8_STAGEB(PG8_SB(0, 0), b2); PG8_STAGEB(PG8_SB(0, 1), b2 + hstep); PG8_STAGEA(PG8_SA(0, 0), a2, vA, 0);
            PG8_WAIT_V_SP2(fresh); PG8_WAIT_L(0); PG8_BAR; PG8_MMA(1, 0, At, B0); PG8_MMA(1, 1, At, B1); PG8_BAR; PG8_SCHED;
            PG8_LDB(B0, 1, 0); PG8_LDB(B1, 1, 1); PG8_SCHED; PG8_LDA(At, 1, 0); PG8_STAGEA(PG8_SA(0, 1), a2, vA, 1);
            if constexpr (P::PRE != 0) PG8_WAIT_V_SP2(fresh); else PG8_WAIT_V(8);
            PG8_WAIT_L(0); PG8_BAR; PG8_MMA(0, 0, At, B0); PG8_MMA(0, 1, At, B1); PG8_BAR; PG8_SCHED;
            PG8_LDA(At, 1, 1); PG8_STAGEB(PG8_SB(1, 0), b3); PG8_STAGEB(PG8_SB(1, 1), b3 + hstep); PG8_STAGEA(PG8_SA(1, 0), a3, vA, 0);
            PG8_WAIT_V(8); PG8_WAIT_L(0); PG8_BAR; PG8_MMA(1, 0, At, B0); PG8_MMA(1, 1, At, B1); PG8_BAR; PG8_SCHED;
#if MK_GT
            if (TM) { if (t == 0) { if (ui == 0) PG8_TS(0); else PG8_TS(6); } else PG8_TS(1); }
#endif
        }
        if constexpr (P::PRE != 0) PG8_STAGEA(PG8_SA(1, 1), nA + kstep, vA, 1);
        if (wr == 0) PG8_BAR;
        PG8_TS(2);
        S.epi(acc, cur, wr, wc, fr, fq, lds + STAGE_BYTES + 1024 + (ui % 3) * 1024);
        PG8_TS(3);
#if MK_GT
        if (TM && lane == 0) tl_[5] += 1;
#endif
        if (!has_next) break;
#pragma unroll
        for (int a = 0; a < 2; ++a)
#pragma unroll
            for (int b = 0; b < 2; ++b)
#pragma unroll
                for (int m = 0; m < 4; ++m)
#pragma unroll
                    for (int n = 0; n < 2; ++n) acc[a][b][m][n] = (f32x4){0.f, 0.f, 0.f, 0.f};
        cur = nxt; ++ui;
        if (wr == 1) PG8_BAR;
        PG8_TS(4);
    }
#if MK_GT
    if (TM && tout != nullptr && lane == 0) { for (int k = 0; k < 6; ++k) tout[wid * 8 + k] = tl_[k]; }
#endif
    PG8_WAIT_V(0);
    PG8_BAR;
#undef PG8_PA
#undef PG8_PB
#undef PG8_SA
#undef PG8_SB
#undef PG8_STAGE
#undef PG8_STAGEA
#undef PG8_STAGEB
#undef PG8_LDA
#undef PG8_LDB
#undef PG8_MMA
#undef PG8_WAIT_V
#undef PG8_WAIT_L
#undef PG8_BAR
#undef PG8_SCHED
}
}
using pg8::Unit;
constexpr size_t TSTEP1024 = (size_t)256 * 1024 * 2;
constexpr size_t TSTEP256 = (size_t)256 * 256 * 2;

struct ActC { float ca, cb, d1, d3, d0; };
__device__ __forceinline__ ActC act_gelu() { return ActC{1.f, 0.f, -1.4426950409f * 1.5957691216f, -1.4426950409f * 0.0713548163f, 0.f}; }
__device__ __forceinline__ ActC act_sigmoid() { return ActC{0.f, 1.f, -1.4426950409f, 0.f, 0.f}; }
__device__ __forceinline__ ActC act_linear(float s) { return ActC{s, 0.f, 0.f, 0.f, -1.4426950409f * 40.f}; }
struct LaneTr { int fr2, fq2, paddr, ipaddr; };
__device__ __forceinline__ LaneTr lane_tr_make(int fr, int fq) { LaneTr t; t.fr2 = fq * 4 + (fr >> 2); t.fq2 = fr & 3; t.paddr = ((fr & 3) * 16 + fq * 4 + (fr >> 2)) * 4; t.ipaddr = (fr * 4 + fq) * 4; return t; }
__device__ __forceinline__ u32x4 lane_tr4(const LaneTr& t, u32x4 w) {
    u32x4 r; r.x = (unsigned)__builtin_amdgcn_ds_bpermute(t.paddr, (int)w.x); r.y = (unsigned)__builtin_amdgcn_ds_bpermute(t.paddr, (int)w.y);
    r.z = (unsigned)__builtin_amdgcn_ds_bpermute(t.paddr, (int)w.z); r.w = (unsigned)__builtin_amdgcn_ds_bpermute(t.paddr, (int)w.w); return r; }
__device__ __forceinline__ u32x4 lane_tr4_inv(const LaneTr& t, u32x4 w) {
    u32x4 r; r.x = (unsigned)__builtin_amdgcn_ds_bpermute(t.ipaddr, (int)w.x); r.y = (unsigned)__builtin_amdgcn_ds_bpermute(t.ipaddr, (int)w.y);
    r.z = (unsigned)__builtin_amdgcn_ds_bpermute(t.ipaddr, (int)w.z); r.w = (unsigned)__builtin_amdgcn_ds_bpermute(t.ipaddr, (int)w.w); return r; }
__device__ __forceinline__ u32x2 lane_tr2_inv(const LaneTr& t, u32x2 w) {
    u32x2 r; r.x = (unsigned)__builtin_amdgcn_ds_bpermute(t.ipaddr, (int)w.x); r.y = (unsigned)__builtin_amdgcn_ds_bpermute(t.ipaddr, (int)w.y); return r; }
__device__ __forceinline__ u32x2 lane_tr2(const LaneTr& t, u32x2 w) {
    u32x2 r; r.x = (unsigned)__builtin_amdgcn_ds_bpermute(t.paddr, (int)w.x); r.y = (unsigned)__builtin_amdgcn_ds_bpermute(t.paddr, (int)w.y); return r; }

template <int MODE>
__device__ __forceinline__ void store_tile_uni(const f32x4 (&acc)[2][2][4][2], bf16* O, int ldc, int rowb, int colb, const ActC A, f32x2* stat, int statcol, int fr, int fq) {
    const LaneTr T = lane_tr_make(fr, fq);
#pragma unroll
    for (int ai = 0; ai < 2; ++ai)
#pragma unroll
        for (int m = 0; m < 4; ++m) {
            const int rowm = rowb + ai * 128 + m * 16;
            bf16* rowp = O + (size_t)(rowm + T.fr2) * ldc + colb + 8 * T.fq2;
            f32x2 s2 = (f32x2){0.f, 0.f}, q2 = (f32x2){0.f, 0.f};
#pragma unroll
            for (int bj = 0; bj < 2; ++bj) {
                f32x2 v[4] = {(f32x2){acc[ai][bj][m][0][0], acc[ai][bj][m][0][1]}, (f32x2){acc[ai][bj][m][0][2], acc[ai][bj][m][0][3]}, (f32x2){acc[ai][bj][m][1][0], acc[ai][bj][m][1][1]}, (f32x2){acc[ai][bj][m][1][2], acc[ai][bj][m][1][3]}};
#pragma unroll
                for (int j = 0; j < 4; ++j) {
                    const f32x2 z = v[j];
                    if (MODE == 2) v[j] = z * A.ca;
                    else {
                        const f32x2 u = z * ((z * z) * A.d3 + A.d1) + A.d0;
                        f32x2 e; e.x = __builtin_amdgcn_exp2f(u.x); e.y = __builtin_amdgcn_exp2f(u.y);
                        const f32x2 den = e + 1.0f; f32x2 r; r.x = __builtin_amdgcn_rcpf(den.x); r.y = __builtin_amdgcn_rcpf(den.y);
                        v[j] = (z * A.ca + A.cb) * r;
                        if (MODE == 1) { s2 += v[j]; q2 += v[j] * v[j]; }
                    }
                }
                u32x4 w; w.x = pg8::cvt_pk_bf16(v[0].x, v[0].y); w.y = pg8::cvt_pk_bf16(v[1].x, v[1].y); w.z = pg8::cvt_pk_bf16(v[2].x, v[2].y); w.w = pg8::cvt_pk_bf16(v[3].x, v[3].y);
                *(u32x4*)(rowp + bj * 128) = lane_tr4(T, w);
            }
            if (MODE == 1) {
                float s = s2.x + s2.y, q = q2.x + q2.y;
                s += __shfl_xor(s, 16); s += __shfl_xor(s, 32); q += __shfl_xor(q, 16); q += __shfl_xor(q, 32);
                if (fq == 0) stat[(size_t)(rowm + fr) * 16 + statcol] = (f32x2){s, q};
            }
        }
}

struct ProbB {
    static constexpr bool PERM = true, GATHER = false; static constexpr int KSEG = 0; static constexpr int EPI_OPS = 16; static constexpr int PRE = 1;
    int K, G, c; unsigned char* ws; bf16* dout;
    __device__ __forceinline__ bool next(int i, Unit& u) const {
        const long L = (long)i * G + c; if (L >= 4096 + 128) return false;
        if (L < 4096) { pg8::tile_order((int)L, 128, 32, u.pm, u.pn); u.aux = 0; }
        else if (L < 4096 + 64) { const int l = (int)L - 4096; u.pm = l >> 2; u.pn = l & 3; u.aux = 1; }
        else { const int l = (int)L - 4160; u.pm = l >> 4; u.pn = l & 15; u.aux = 2; }
        return true;
    }
    __device__ __forceinline__ const char* abase(const Unit& u, int) const {
        const size_t o = u.aux == 0 ? WS_H0 + (size_t)u.pm * TSTEP1024 : u.aux == 1 ? WS_MEMB + (size_t)u.pm * TSTEP1024 : WS_WKV + (size_t)(4 + u.pm) * TSTEP1024;
        return (const char*)ws + o; }
    __device__ __forceinline__ const char* bbase(const Unit& u, int) const {
        const size_t o = u.aux == 0 ? WS_WIN + (size_t)u.pn * TSTEP1024 : u.aux == 1 ? WS_WKV + (size_t)u.pn * TSTEP1024 : WS_MEMB + (size_t)u.pn * TSTEP1024;
        return (const char*)ws + o; }
    __device__ __forceinline__ void gather(const Unit&, int, unsigned (&)[2][2], int, int) const {}
    __device__ __forceinline__ void epi(const f32x4 (&acc)[2][2][4][2], const Unit& u, int wr, int wc, int, int, PG8_LAS const unsigned char* = nullptr) const {
        const int l_ = lane_id(); const int fr = l_ & 15, fq = l_ >> 4;
        const int row0 = u.pm * 256 + wr * 64;
        if (u.aux == 0) {
            const int reg = u.pn >> 2, col0 = (u.pn & 3) * 256 + wc * 32;
            const size_t off = reg == 0 ? WS_U : reg == 1 ? WS_GV : reg == 2 ? WS_LX : reg == 3 ? WS_LG : reg == 4 ? WS_Q : WS_G0;
            bf16* O = reg < 6 ? (bf16*)(ws + off) : reg == 6 ? dout : dout + (size_t)T * 1024;
            if (reg == 2 || reg == 4) store_tile_uni<2>(acc, O, 1024, row0, col0, act_linear(reg == 2 ? 1.f : 0.0625f), nullptr, 0, fr, fq);
            else if (reg == 1) store_tile_uni<1>(acc, O, 1024, row0, col0, act_gelu(), (f32x2*)(ws + WS_VSTAT), (u.pn & 3) * 4 + wc, fr, fq);
            else store_tile_uni<0>(acc, O, 1024, row0, col0, (reg == 0 || reg == 3) ? act_gelu() : act_sigmoid(), nullptr, 0, fr, fq);
        } else {
            bf16* O = u.aux == 1 ? (bf16*)(ws + WS_KB) : (bf16*)(ws + WS_VT);
            store_tile_uni<2>(acc, O, u.aux == 1 ? 1024 : 4096, row0, u.pn * 256 + wc * 32, act_linear(1.f), nullptr, 0, fr, fq);
        }
    }
};

struct ProbD1 {
    static constexpr bool PERM = true, GATHER = false; static constexpr int KSEG = 16; static constexpr int EPI_OPS = 32; static constexpr int PRE = 1;
    int K, G, c; unsigned char* ws; bf16* dout;
    __device__ __forceinline__ bool next(int i, Unit& u) const {
        const long L = (long)i * G + c; if (L >= 512) return false;
        pg8::tile_order((int)L, 128, 4, u.pm, u.pn); u.aux = 0; return true;
    }
    __device__ __forceinline__ const char* abase(const Unit& u, int seg) const { return (const char*)ws + (seg == 0 ? WS_U : seg == 1 ? WS_LG : WS_Q) + (size_t)u.pm * TSTEP1024; }
    __device__ __forceinline__ const char* bbase(const Unit& u, int seg) const { return (const char*)ws + WS_WBR + (size_t)seg * 2 * MiB + (size_t)u.pn * TSTEP1024; }
    __device__ __forceinline__ void gather(const Unit&, int, unsigned (&)[2][2], int, int) const {}
    __device__ __forceinline__ const bf16* gate(int k) const { return k == 0 ? (const bf16*)(ws + WS_G0) : k == 1 ? dout : dout + (size_t)T * 1024; }
    __device__ __forceinline__ void khook(f32x4 (&acc)[2][2][4][2], const Unit& u, int seg, int wr, int wc, int, int, PG8_LAS const unsigned char* = nullptr) const {
        const int l_ = lane_id(); const int fr = l_ & 15, fq = l_ >> 4;
        const LaneTr TR = lane_tr_make(fr, fq);
        const int row2 = u.pm * 256 + wr * 64 + TR.fr2, col2 = u.pn * 256 + wc * 32 + 8 * TR.fq2;
        const bf16* gp = gate(seg - 1); const bf16* gn = gate(seg);
#pragma unroll
        for (int ai = 0; ai < 2; ++ai)
#pragma unroll
            for (int m = 0; m < 4; ++m) {
                const size_t off = (size_t)(row2 + ai * 128 + m * 16) * 1024 + col2;
#pragma unroll
                for (int bj = 0; bj < 2; ++bj) {
                    const u32x4 a = lane_tr4_inv(TR, *(const u32x4*)(gp + off + bj * 128)), b = lane_tr4_inv(TR, *(const u32x4*)(gn + off + bj * 128));
                    const float pa[8] = {bflo(a.x), bfhi(a.x), bflo(a.y), bfhi(a.y), bflo(a.z), bfhi(a.z), bflo(a.w), bfhi(a.w)};
                    const float nb[8] = {bflo(b.x), bfhi(b.x), bflo(b.y), bfhi(b.y), bflo(b.z), bfhi(b.z), bflo(b.w), bfhi(b.w)};
#pragma unroll
                    for (int j = 0; j < 4; ++j) { acc[ai][bj][m][0][j] *= pa[j] * __builtin_amdgcn_rcpf(fmaxf(nb[j], 1e-30f)); acc[ai][bj][m][1][j] *= pa[4 + j] * __builtin_amdgcn_rcpf(fmaxf(nb[4 + j], 1e-30f)); }
                }
            }
    }
    __device__ __forceinline__ void epi(const f32x4 (&acc)[2][2][4][2], const Unit& u, int wr, int wc, int, int, PG8_LAS const unsigned char* = nullptr) const {
        const int l_ = lane_id(); const int fr = l_ & 15, fq = l_ >> 4;
        const int row0 = u.pm * 256 + wr * 64 + fr, col0 = u.pn * 256 + wc * 32 + 8 * fq;
        const bf16* g2 = gate(2); bf16* M = (bf16*)(ws + WS_H0); const LaneTr TR = lane_tr_make(fr, fq);
#pragma unroll
        for (int ai = 0; ai < 2; ++ai)
#pragma unroll
            for (int m = 0; m < 4; ++m) {
                const size_t off = (size_t)(row0 + ai * 128 + m * 16) * 1024 + col0;
                const size_t off2 = (size_t)(row0 - fr + TR.fr2 + ai * 128 + m * 16) * 1024 + (col0 - 8 * fq + 8 * TR.fq2);
#pragma unroll
                for (int bj = 0; bj < 2; ++bj) {
                    const u32x4 b = lane_tr4_inv(TR, *(const u32x4*)(g2 + off2 + bj * 128));
                    const float nb[8] = {bflo(b.x), bfhi(b.x), bflo(b.y), bfhi(b.y), bflo(b.z), bfhi(b.z), bflo(b.w), bfhi(b.w)};
                    float v[8];
#pragma unroll
                    for (int j = 0; j < 4; ++j) { v[j] = acc[ai][bj][m][0][j] * fmaxf(nb[j], 1e-30f); v[4 + j] = acc[ai][bj][m][1][j] * fmaxf(nb[4 + j], 1e-30f); }
                    u32x4 w; w.x = pg8::cvt_pk_bf16(v[0], v[1]); w.y = pg8::cvt_pk_bf16(v[2], v[3]); w.z = pg8::cvt_pk_bf16(v[4], v[5]); w.w = pg8::cvt_pk_bf16(v[6], v[7]);
                    *(u32x4*)(M + off2 + bj * 128) = lane_tr4(TR, w);
                }
            }
    }
};

struct ProbD2 {
    static constexpr bool PERM = true, GATHER = false; static constexpr int KSEG = 0; static constexpr int EPI_OPS = 16; static constexpr int PRE = 1;
    int K, G, c; unsigned char* ws;
    __device__ __forceinline__ bool next(int i, Unit& u) const {
        const long L = (long)i * G + c; if (L >= 512) return false;
        pg8::tile_order((int)L, 128, 4, u.pm, u.pn); u.aux = 0; return true;
    }
    __device__ __forceinline__ const char* abase(const Unit& u, int) const { return (const char*)ws + WS_H0 + (size_t)u.pm * TSTEP1024; }
    __device__ __forceinline__ const char* bbase(const Unit& u, int) const { return (const char*)ws + WS_WOUT + (size_t)u.pn * TSTEP1024; }
    __device__ __forceinline__ void gather(const Unit&, int, unsigned (&)[2][2], int, int) const {}
    __device__ __forceinline__ void epi(const f32x4 (&acc)[2][2][4][2], const Unit& u, int wr, int wc, int, int, PG8_LAS const unsigned char* = nullptr) const {
        const int l_ = lane_id(); const int fr = l_ & 15, fq = l_ >> 4;
        store_tile_uni<2>(acc, (bf16*)(ws + WS_MO), 1024, u.pm * 256 + wr * 64, u.pn * 256 + wc * 32, act_linear(1.f), nullptr, 0, fr, fq);
    }
};

struct ProbE1 {
    static constexpr bool PERM = true, GATHER = true; static constexpr int KSEG = 0; static constexpr int EPI_OPS = 8; static constexpr int PRE = 1;
    int K, G, c; unsigned char* ws; int n0, n1; PG8_LAS const int* te; const float* dout;
    __device__ __forceinline__ bool next(int i, Unit& u) const {
        static_assert(NCH == 2, "ProbE1::next is written for two chunks");
        long L = (long)i * G + c; const int u0 = 2 * (n0 + SHT), u1 = 2 * (n1 + SHT);
        if (L >= (long)u0 + u1) return false;
        int ch = 0, nt = n0;
        if (L >= u0) { L -= u0; ch = 1; nt = n1; }
        const int l2 = (int)L >> 1; u.pm = l2 < nt ? l2 : RTMAX + (l2 - nt); u.pn = (int)L & 1; u.ch = ch;
        u.aux = te[ch * (RTMAX + SHT) + u.pm]; return true;
    }
    __device__ __forceinline__ const char* abase(const Unit&, int) const { return (const char*)dout + 2048; }
    __device__ __forceinline__ const char* bbase(const Unit& u, int) const { return (const char*)ws + WS_WGU + (size_t)(u.aux * 2 + u.pn) * TSTEP1024; }
    __device__ __forceinline__ void gather(const Unit& u, int R0, unsigned (&v)[2][2], int C0, int) const {
        const u32x4 o = *(const u32x4*)((const unsigned*)(ws + WS_ROWOFF) + (size_t)u.ch * CROWS + u.pm * 256 + R0 * 4);
        const unsigned c2 = (unsigned)C0 * 2u;
        v[0][0] = o.x + c2; v[0][1] = o.y + c2; v[1][0] = o.z + c2; v[1][1] = o.w + c2;
    }
    __device__ __forceinline__ void rows_to_lds(const Unit& u, PG8_LAS unsigned char* dst, int slot, int, bool with_off) const {
        const int t64 = lane_id();
        const size_t r0 = (size_t)u.ch * CROWS + u.pm * 256;
        if (with_off) *(PG8_LAS u32x4*)(dst + t64 * 16) = *(const u32x4*)((const unsigned*)(ws + WS_ROWOFF) + r0 + t64 * 4);
        *(PG8_LAS u32x4*)(dst + 1024 + slot * 1024 + t64 * 16) = *(const u32x4*)((const unsigned*)(ws + WS_ROWW) + r0 + t64 * 4);
    }
    __device__ __forceinline__ void epi(const f32x4 (&acc)[2][2][4][2], const Unit& u, int wr, int wc, int, int, PG8_LAS const unsigned char* lrw) const {
        const int l_ = lane_id(); const int fr = l_ & 15, fq = l_ >> 4;
        const LaneTr TR = lane_tr_make(fr, fq);
        const int rl = wr * 64 + fr, rl2 = wr * 64 + TR.fr2, col2 = u.pn * 128 + wc * 32 + 8 * TR.fq2;
        bf16* H = (bf16*)(ws + WS_HB) + ((size_t)u.ch * CROWS + u.pm * 256) * 256;
#pragma unroll
        for (int ai = 0; ai < 2; ++ai)
#pragma unroll
            for (int m = 0; m < 4; ++m) {
                const int r = rl + ai * 128 + m * 16; const float rw = *(PG8_LAS const float*)(lrw + r * 4);
                float v[8];
#pragma unroll
                for (int j = 0; j < 4; ++j) {
                    const float g0 = acc[ai][0][m][0][j], u0 = acc[ai][1][m][0][j], g1 = acc[ai][0][m][1][j], u1 = acc[ai][1][m][1][j];
                    v[j] = g0 * fast_sigmoid(g0) * (u0 * rw); v[4 + j] = g1 * fast_sigmoid(g1) * (u1 * rw);
                }
                u32x4 w; w.x = pg8::cvt_pk_bf16(v[0], v[1]); w.y = pg8::cvt_pk_bf16(v[2], v[3]); w.z = pg8::cvt_pk_bf16(v[4], v[5]); w.w = pg8::cvt_pk_bf16(v[6], v[7]);
                *(u32x4*)(H + (size_t)(rl2 + ai * 128 + m * 16) * 256 + col2) = lane_tr4(TR, w);
            }
    }
};

struct ProbE2 {
    static constexpr bool PERM = true, GATHER = false; static constexpr int KSEG = 0; static constexpr int EPI_OPS = 8; static constexpr int PRE = 1;
    int K, G, c; unsigned char* ws; int chunk, ntile; PG8_LAS const int* te;
    __device__ __forceinline__ bool next(int i, Unit& u) const {
        const long L = (long)i * G + c; if (L >= 4 * (ntile + SHT)) return false;
        const int l4 = (int)L >> 2; u.pm = l4 < ntile ? l4 : RTMAX + (l4 - ntile); u.pn = (int)L & 3;
        u.aux = te[chunk * (RTMAX + SHT) + u.pm]; return true;
    }
    __device__ __forceinline__ const char* abase(const Unit& u, int) const { return (const char*)ws + WS_HB + ((size_t)chunk * CROWS + (size_t)u.pm * 256) * 512; }
    __device__ __forceinline__ const char* bbase(const Unit& u, int) const { return (const char*)ws + WS_WD + (size_t)(u.aux * 4 + u.pn) * TSTEP256; }
    __device__ __forceinline__ void gather(const Unit&, int, unsigned (&)[2][2], int, int) const {}
    __device__ __forceinline__ void epi(const f32x4 (&acc)[2][2][4][2], const Unit& u, int wr, int wc, int fr, int fq, PG8_LAS const unsigned char* = nullptr) const {
        const int l_ = lane_id(); const int fr_ = l_ & 15, fq_ = l_ >> 4;
        const LaneTr TR = lane_tr_make(fr_, fq_);
        const int row0 = u.pm * 256 + wr * 64 + TR.fr2, col0 = u.pn * 256 + wc * 64 + 16 * TR.fq2;
        unsigned char* Y = ws + WS_Y;
#pragma unroll
        for (int ai = 0; ai < 2; ++ai)
#pragma unroll
            for (int m = 0; m < 4; ++m) {
                const int row = row0 + ai * 128 + m * 16;
                u32x4 w;
#pragma unroll
                for (int bj = 0; bj < 2; ++bj) {
                    f32x4 a = acc[ai][bj][m][0] * YSCALE, b = acc[ai][bj][m][1] * YSCALE;
#pragma unroll
                    for (int j = 0; j < 4; ++j) { a[j] = fminf(fmaxf(a[j], -440.f), 440.f); b[j] = fminf(fmaxf(b[j], -440.f), 440.f); }
                    int w0 = __builtin_amdgcn_cvt_pk_fp8_f32(a[0], a[1], 0, false); w0 = __builtin_amdgcn_cvt_pk_fp8_f32(a[2], a[3], w0, true);
                    int w1 = __builtin_amdgcn_cvt_pk_fp8_f32(b[0], b[1], 0, false); w1 = __builtin_amdgcn_cvt_pk_fp8_f32(b[2], b[3], w1, true);
                    if (bj == 0) { w.x = (unsigned)w0; w.y = (unsigned)w1; } else { w.z = (unsigned)w0; w.w = (unsigned)w1; }
                }
                *(u32x4*)(Y + (size_t)row * 1024 + col0) = lane_tr4(TR, w);
            }
    }
};
struct Args { const float* in[33]; float* out; unsigned char* ws; int ph_lo, ph_hi; };
static_assert(sizeof(Args) == 33 * 8 + 8 + 8 + 8, "Args has no padding");
struct Ctx {
    float* out; unsigned char* ws; LAS unsigned char* lds;
    int tid, lane, wave, G, bid, vcu;
};

__device__ __forceinline__ void transpose_item(const float* W, int ldw, bf16* WTn0, int ldt, LAS float* scr, int k0, int n0, int lane, bf16* WTlo  ) {
#pragma unroll 8
    for (int i = 0; i < 32; ++i) { const int kk = 2 * i + (lane >> 5); scr[kk * 33 + (lane & 31)] = W[(size_t)(k0 + kk) * ldw + n0 + (lane & 31)]; }
    LDS_WAIT(); asm volatile("" ::: "memory");
    const int c = lane & 7;
#pragma unroll
    for (int j = 0; j < 4; ++j) { const int n = (lane >> 3) + 8 * j; const LAS float* s = scr + (8 * c) * 33 + n;
        float f[8];
#pragma unroll
        for (int q = 0; q < 8; ++q) f[q] = s[q * 33];
        u32x4 o; o.x = pk2(f[0], f[1]); o.y = pk2(f[2], f[3]); o.z = pk2(f[4], f[5]); o.w = pk2(f[6], f[7]);
        *(u32x4*)(WTn0 + (size_t)n * ldt + k0 + 8 * c) = o;
        if (WTlo) {
#pragma unroll
            for (int q = 0; q < 8; ++q) f[q] -= bf2f(f2bf(f[q]));
            u32x4 p; p.x = pk2(f[0], f[1]); p.y = pk2(f[2], f[3]); p.z = pk2(f[4], f[5]); p.w = pk2(f[6], f[7]);
            *(u32x4*)(WTlo + (size_t)n * ldt + k0 + 8 * c) = p;
        } }
    LDS_WAIT(); asm volatile("" ::: "memory");
}

struct TItem { const float* src; bf16* dst; bf16* dstlo; int ldw, ldt; int rperm = 0; };
__device__ __forceinline__ void titem_load(const TItem& it, f32x4 (&r)[8], int lane) {
#pragma unroll
    for (int i = 0; i < 8; ++i) { const int idx = 64 * i + lane; r[i] = *(const f32x4*)(it.src + (size_t)(idx >> 3) * it.ldw + 4 * (idx & 7)); }
}
__device__ __forceinline__ void titem_store(const TItem& it, const f32x4 (&r)[8], LAS float* scr, int lane) {
#pragma unroll
    for (int i = 0; i < 8; ++i) { const int idx = 64 * i + lane; LAS float* s = scr + (idx >> 3) * 33 + 4 * (idx & 7); s[0] = r[i].x; s[1] = r[i].y; s[2] = r[i].z; s[3] = r[i].w; }
    LDS_WAIT(); asm volatile("" ::: "memory");
    const int c = lane & 7;
#pragma unroll
    for (int j = 0; j < 4; ++j) { const int n = (lane >> 3) + 8 * j; const LAS float* s = scr + (8 * c) * 33 + n;
        float f[8];
#pragma unroll
        for (int q = 0; q < 8; ++q) f[q] = s[q * 33];
        u32x4 o; o.x = pk2(f[0], f[1]); o.y = pk2(f[2], f[3]); o.z = pk2(f[4], f[5]); o.w = pk2(f[6], f[7]);
        const int nr = it.rperm ? (((n >> 3) & 1) * 128 + (n >> 4) * 8 + (n & 7)) : n;
        *(u32x4*)(it.dst + (size_t)nr * it.ldt + 8 * c) = o;
        if (it.dstlo) {
#pragma unroll
            for (int q = 0; q < 8; ++q) f[q] -= bf2f(f2bf(f[q]));
            u32x4 p; p.x = pk2(f[0], f[1]); p.y = pk2(f[2], f[3]); p.z = pk2(f[4], f[5]); p.w = pk2(f[6], f[7]);
            *(u32x4*)(it.dstlo + (size_t)n * it.ldt + 8 * c) = p;
        } }
    LDS_WAIT(); asm volatile("" ::: "memory");
}
#define TITEM_LOOP(get, it0, step, nitems, scr, lane) do { int _i = (it0); if (_i < (nitems)) { TItem _c = get(_i); f32x4 _r[8]; titem_load(_c, _r, lane); \
    for (;;) { const int _n = _i + (step); const bool _hn = _n < (nitems); TItem _x = _c; f32x4 _q[8]; if (_hn) { _x = get(_n); titem_load(_x, _q, lane); } \
        titem_store(_c, _r, scr, lane); if (!_hn) break; _c = _x; _i = _n; _Pragma("unroll") for (int _k = 0; _k < 8; ++_k) _r[_k] = _q[_k]; } } } while (0)

__device__ __forceinline__ void phase_p0(Ctx& X, const Args& A) {
    LAS float* scr = (LAS float*)(X.lds + X.wave * 16384);
    const int gw = X.vcu * 8 + X.wave, NGW = X.G * 8;
    unsigned char* ws = X.ws;
    constexpr int I_IN = 16 * 256, I_KV = 16 * 64, I_LR = 64, I_RT = 32;
    constexpr int NIT = I_IN + I_KV + 2 * I_LR + I_RT;
    auto get0 = [&](int it) -> TItem {
        int r = it;
        if (r < I_IN) { const int kb = r >> 8, nb = r & 255; return TItem{A.in[4] + (size_t)(64 * kb) * INC + 32 * nb, (bf16*)(ws + WS_WIN) + (size_t)(32 * nb) * 1024 + 64 * kb, nullptr, INC, 1024}; } r -= I_IN;
        if (r < I_KV) { const int kb = r >> 6, nb = r & 63; return TItem{A.in[16] + (size_t)(64 * kb) * 2048 + 32 * nb, (bf16*)(ws + WS_WKV) + (size_t)(32 * nb) * 1024 + 64 * kb, nullptr, 2048, 1024}; } r -= I_KV;
        if (r < 2 * I_LR) { const int which = r >= I_LR; if (which) r -= I_LR; const int g = r >> 3, kb = (r >> 2) & 1, nb = r & 3;
            return TItem{A.in[which ? 13 : 11] + g * 16384 + (64 * kb) * 128 + 32 * nb, (bf16*)(ws + (which ? WS_WI : WS_WA)) + g * 16384 + (32 * nb) * 128 + 64 * kb, nullptr, 128, 128}; } r -= 2 * I_LR;
        const int kb = r >> 1, nb = r & 1;
        return TItem{A.in[23] + (size_t)(64 * kb) * 64 + 32 * nb, (bf16*)(ws + WS_WR) + (size_t)(32 * nb) * 1024 + 64 * kb, (bf16*)(ws + WS_WR) + 65536 + (size_t)(32 * nb) * 1024 + 64 * kb, 64, 1024};
    };
    TITEM_LOOP(get0, gw, NGW, NIT, scr, X.lane);
    for (int i = X.bid * 512 + X.tid; i < 8 * 128 * 128; i += X.G * 512) { const int t = (i >> 7) & 127, s = i & 127; ((bf16*)(ws + WS_WSP))[i] = (bf16)(s <= t ? f2bf(A.in[7][i]) : 0u); }
    {
        const f32x4* gp = (const f32x4*)A.in[2] + X.lane; const f32x4* bp = (const f32x4*)A.in[3] + X.lane;
        f32x4 gg[4], bb[4];
#pragma unroll
        for (int j = 0; j < 4; ++j) { gg[j] = gp[64 * j]; bb[j] = bp[64 * j]; }
        f32x4 vn[4];
        { const f32x4* xr = (const f32x4*)(A.in[0] + (size_t)(gw < T ? gw : 0) * D) + X.lane;
#pragma unroll
          for (int j = 0; j < 4; ++j) vn[j] = xr[64 * j]; }
#pragma unroll 1
        for (int m = gw; m < T; m += NGW) {
            f32x4 v[4]; float s = 0.f;
#pragma unroll
            for (int j = 0; j < 4; ++j) v[j] = vn[j];
            { const int mn = m + NGW < T ? m + NGW : m; const f32x4* xr = (const f32x4*)(A.in[0] + (size_t)mn * D) + X.lane;
#pragma unroll
              for (int j = 0; j < 4; ++j) vn[j] = xr[64 * j]; }
#pragma unroll
            for (int j = 0; j < 4; ++j) s += (v[j].x + v[j].y) + (v[j].z + v[j].w);
            const float mean = wave_sum(s) * (1.f / D); float s2 = 0.f;
#pragma unroll
            for (int j = 0; j < 4; ++j) { v[j] = v[j] - mean; s2 += (v[j].x * v[j].x + v[j].y * v[j].y) + (v[j].z * v[j].z + v[j].w * v[j].w); }
            const float rstd = 1.f / sqrtf(wave_sum(s2) * (1.f / D) + LN_EPS);
            if (X.lane == 0) ((f32x2*)(ws + WS_XSTAT))[m] = (f32x2){mean, rstd};
            u32x2* o8 = (u32x2*)((bf16*)(ws + WS_H0) + (size_t)m * D) + X.lane;
#pragma unroll
            for (int j = 0; j < 4; ++j) { const f32x4 h = v[j] * rstd * gg[j] + bb[j]; o8[64 * j] = (u32x2){pk2(h.x, h.y), pk2(h.z, h.w)}; }
        }
    }
    for (int m = gw; m < TM; m += 2 * NGW) {
        const int m2 = m + NGW < TM ? m + NGW : m;
        const f32x4* xr = (const f32x4*)(A.in[1] + (size_t)m * D) + X.lane; u32x2* o8 = (u32x2*)((bf16*)(ws + WS_MEMB) + (size_t)m * D) + X.lane;
        const f32x4* xr2 = (const f32x4*)(A.in[1] + (size_t)m2 * D) + X.lane; u32x2* o82 = (u32x2*)((bf16*)(ws + WS_MEMB) + (size_t)m2 * D) + X.lane;
        f32x4 h[4], h2[4];
#pragma unroll
        for (int j = 0; j < 4; ++j) { h[j] = xr[64 * j]; h2[j] = xr2[64 * j]; }
#pragma unroll
        for (int j = 0; j < 4; ++j) { o8[64 * j] = (u32x2){pk2(h[j].x, h[j].y), pk2(h[j].z, h[j].w)}; o82[64 * j] = (u32x2){pk2(h2[j].x, h2[j].y), pk2(h2[j].z, h2[j].w)}; }
    }
}

__device__ __forceinline__ void conv_wbr(Ctx& X, const Args& A) {
    LAS float* scr = (LAS float*)(X.lds + X.wave * 16384);
    const int gw = X.vcu * 8 + X.wave, NGW = X.G * 8;
    auto getw = [&](int it) -> TItem { const int which = it >> 9, r = it & 511, kb = r >> 5, nb = r & 31;
        return TItem{A.in[17 + which] + (size_t)(64 * kb) * 1024 + 32 * nb, (bf16*)(X.ws + WS_WBR) + (size_t)which * 1048576 + (size_t)(32 * nb) * 1024 + 64 * kb, nullptr, 1024, 1024}; };
    TITEM_LOOP(getw, gw, NGW, 4 * 512, scr, X.lane);
}
__device__ __forceinline__ void conv_experts(Ctx& X, const Args& A) {
    LAS float* scr = (LAS float*)(X.lds + X.wave * 16384);
    const int gw = X.vcu * 8 + X.wave, NGW = X.G * 8;
    auto gete = [&](int it) -> TItem {
        const int e = it / 384, r = it % 384, which = r >> 7, q = r & 127;
        if (which < 2) { const int kb = q >> 3, nb = q & 7, n0 = 32 * nb;
            const float* W = e < 64 ? A.in[25 + which] + (size_t)e * 1024 * 256 : A.in[28 + which];
            return TItem{W + (size_t)(64 * kb) * 256 + n0, (bf16*)(X.ws + WS_WGU) + ((size_t)(e * 2 + (n0 >> 7)) * 256 + which * 128 + (n0 & 127)) * 1024 + 64 * kb, nullptr, 256, 1024}; }
        const int kb = q >> 5, nb = q & 31;
        const float* W = e < 64 ? A.in[27] + (size_t)e * 256 * 1024 : A.in[30];
        const int tl = nb >> 3, nbl = nb & 7;
        return TItem{W + (size_t)(64 * kb) * 1024 + 32 * nb, (bf16*)(X.ws + WS_WD) + ((size_t)e * 1024 + tl * 256 + (nbl >> 1) * 32 + 16 * (nbl & 1)) * 256 + 64 * kb, nullptr, 1024, 256, 1}; };
    TITEM_LOOP(gete, gw, NGW, 65 * 384, scr, X.lane);
}

__device__ __forceinline__ int swz(int r, int ch, int rowbytes) { return r * rowbytes + (((ch & ~15) | ((ch ^ r) & 15)) << 4); }

#define GSWZ(r, ch) ((r) * 256 + ((((ch) ^ ((r) & 15) ^ (((r) >> 4) & 7)) & 15) << 4))
template <bool DRY = false> __device__ __forceinline__ void gmlp_units(Ctx& X, const Args& A) {
    unsigned char* ws = X.ws; LAS unsigned char* lds = X.lds;
    LAS f32x2* st = (LAS f32x2*)(lds + 32768);
    const int w = X.wave, l = X.lane, fr = l & 15, fq = l >> 4;
    int unit = X.bid; if (unit >= 2048) return;
    const int g = unit & 7, c0 = g * 128;
    const int ch = X.tid & 15, s0 = 4 * (X.tid >> 4);
    const int srow = X.tid >> 2, spart = X.tid & 3;
    bf16x8 wfr[4]; float gg[8], bb[8];
    { const bf16* Wg = (const bf16*)(ws + WS_WSP) + g * 16384 + (16 * w + fr) * 128 + 8 * fq;
#pragma unroll
      for (int kk = 0; kk < 4; ++kk) wfr[kk] = *(const bf16x8*)(Wg + 32 * kk);
#pragma unroll
      for (int j = 0; j < 8; ++j) { gg[j] = A.in[5][c0 + ch * 8 + j]; bb[j] = A.in[6][c0 + ch * 8 + j]; } }
    const float bs = A.in[8][g * 128 + 16 * w + fr];
    const LaneTr TR = lane_tr_make(fr, fq);
    f32x2 sp[4]; u32x4 gvq[4]; u32x2 uq[8], un[8];
#define GM_PREFETCH(unit_, udst) do { const int t0_ = ((unit_) >> 3) * 128; \
        _Pragma("unroll") for (int i = 0; i < 4; ++i) sp[i] = ((const f32x2*)(ws + WS_VSTAT))[(size_t)(t0_ + srow) * 16 + i * 4 + spart]; \
        _Pragma("unroll") for (int i = 0; i < 4; ++i) gvq[i] = *(const u32x4*)((const bf16*)(ws + WS_GV) + (size_t)(t0_ + s0 + i) * 1024 + c0 + ch * 8); \
        const bf16* up_ = (const bf16*)(ws + WS_U) + (size_t)(t0_ + 16 * w + TR.fr2) * 1024 + c0 + 4 * TR.fq2; \
        _Pragma("unroll") for (int cb = 0; cb < 8; ++cb) udst[cb] = *(const u32x2*)(up_ + 16 * cb); } while (0)
    GM_PREFETCH(unit, uq);
    for (; unit < 2048; unit += X.G) {
        const int t0 = (unit >> 3) * 128;
        { float s = (sp[0].x + sp[1].x) + (sp[2].x + sp[3].x), q = (sp[0].y + sp[1].y) + (sp[2].y + sp[3].y);
          s += __shfl_xor(s, 1); s += __shfl_xor(s, 2); q += __shfl_xor(q, 1); q += __shfl_xor(q, 2);
          const float mean = s * (1.f / 1024.f), var = q * (1.f / 1024.f) - mean * mean;
          if (spart == 0) st[srow] = (f32x2){mean, 1.f / sqrtf(var + LN_EPS)}; }
        __syncthreads();
        { float y[4][8];
#pragma unroll
          for (int i = 0; i < 4; ++i) { const f32x2 ms = st[s0 + i]; const u32x4 wv = gvq[i];
              const float v[8] = {bflo(wv.x), bfhi(wv.x), bflo(wv.y), bfhi(wv.y), bflo(wv.z), bfhi(wv.z), bflo(wv.w), bfhi(wv.w)};
#pragma unroll
              for (int j = 0; j < 8; ++j) y[i][j] = (v[j] - ms.x) * ms.y * gg[j] + bb[j]; }
#pragma unroll
          for (int j = 0; j < 8; ++j) { const int c = ch * 8 + j;
              *(LAS u32x2*)(lds + GSWZ(c, s0 >> 3) + (s0 & 7) * 2) = (u32x2){pk2(y[0][j], y[1][j]), pk2(y[2][j], y[3][j])}; } }
        const bool has_next = unit + X.G < 2048;
        if (has_next) GM_PREFETCH(unit + X.G, un);
        __syncthreads();
        f32x4 acc[8];
#pragma unroll
        for (int cb = 0; cb < 8; ++cb) acc[cb] = (f32x4){0.f, 0.f, 0.f, 0.f};
        const int kmax = w >> 1;
#pragma unroll
        for (int kk = 0; kk < 4; ++kk) {
            if (kk <= kmax) {
#pragma unroll
                for (int cb = 0; cb < 8; ++cb) {
                    const bf16x8 afr = *(const LAS bf16x8*)(lds + GSWZ(16 * cb + fr, 4 * kk + fq));
                    acc[cb] = __builtin_amdgcn_mfma_f32_16x16x32_bf16(afr, wfr[kk], acc[cb], 0, 0, 0);
                }
            }
        }
        const int t = 16 * w + TR.fr2;
        bf16* up = (bf16*)(ws + WS_U) + (size_t)(t0 + t) * 1024 + c0 + 4 * TR.fq2;
#pragma unroll
        for (int cb = 0; cb < 8; ++cb) {
            const u32x2 uw = lane_tr2_inv(TR, uq[cb]);
            const float y0 = bflo(uw.x) * (acc[cb][0] + bs), y1 = bfhi(uw.x) * (acc[cb][1] + bs), y2 = bflo(uw.y) * (acc[cb][2] + bs), y3 = bfhi(uw.y) * (acc[cb][3] + bs);
            bf16* op = DRY ? (bf16*)(ws + WS_MEMB) + (size_t)((t0 + t) & 4095) * 1024 + c0 + 4 * TR.fq2 : up;
            *(u32x2*)(op + 16 * cb) = lane_tr2(TR, (u32x2){pk2(y0, y1), pk2(y2, y3)});
        }
        if (has_next) {
#pragma unroll
            for (int cb = 0; cb < 8; ++cb) uq[cb] = un[cb]; }
        __syncthreads();
    }
#undef GM_PREFETCH
}

template <bool DRY = false> __device__ __forceinline__ void lru_unit(Ctx& X, const Args& A, int unit) {
    const int b = unit >> 4, g = (unit >> 1) & 7, half = unit & 1, c0 = g * 128, oc0 = c0 + half * 64;
    unsigned char* ws = X.ws; LAS unsigned char* lds = X.lds;
    constexpr int O_XC = 0, O_A = 32768, O_B = 65536, O_RAW = 98304, O_SA = 132096, O_SB = 134144, O_CY = 136192, O_CW = 136448;
    LAS float* La = (LAS float*)(lds + O_A); LAS float* Lb = (LAS float*)(lds + O_B);
    LAS float* SA = (LAS float*)(lds + O_SA); LAS float* SB = (LAS float*)(lds + O_SB); LAS float* CY = (LAS float*)(lds + O_CY); LAS float* CW = (LAS float*)(lds + O_CW);
    const int w = X.wave, l = X.lane, fr = l & 15, fq = l >> 4, ob = w & 3, th = w >> 2;
    const int cch = X.tid & 15;
    const bf16* wpa = (const bf16*)(ws + WS_WA) + g * 16384 + (half * 64 + 16 * ob + fr) * 128 + 8 * fq; const bf16* wpi = (const bf16*)(ws + WS_WI) + g * 16384 + (half * 64 + 16 * ob + fr) * 128 + 8 * fq;
    const int och = oc0 + 16 * ob + fr;
    const float ba = A.in[12][och], bi = A.in[14][och];
    const float lam = A.in[15][och];
    const float sp8 = 8.0f * (lam > 15.f ? __expf(-lam) : log1pf(__expf(-lam)));
    if (X.tid < 64) CY[X.tid] = 0.f;
    for (int i = X.tid; i < 640; i += 512) CW[i] = i < 512 ? A.in[9][(i >> 7) * 1024 + c0 + (i & 127)] : A.in[10][c0 + (i - 512)];
    u32x4 rawq[5];
#define LRU_RAWLOAD(n_) do { const int t0_ = b * SEQ + (n_) * 128; _Pragma("unroll") for (int i = 0; i < 5; ++i) { const int q = X.tid + 512 * i; const int row = q >> 4, ch = q & 15; \
        rawq[i] = (u32x4){0u, 0u, 0u, 0u}; if (q < 131 * 16 && ((n_) > 0 || row >= 3)) rawq[i] = *(const u32x4*)((const bf16*)(ws + WS_LX) + (size_t)(t0_ - 3 + row) * 1024 + c0 + ch * 8); } } while (0)
    LRU_RAWLOAD(0);
    bf16x8 wa[4], wi[4];
#pragma unroll
    for (int kk = 0; kk < 4; ++kk) { wa[kk] = *(const bf16x8*)(wpa + 32 * kk); wi[kk] = *(const bf16x8*)(wpi + 32 * kk); }
    const int o = X.tid & 63, sg = X.tid >> 6;
#pragma unroll 1
    for (int n = 0; n < 16; ++n) {
        const int t0 = b * SEQ + n * 128;
        u32x4 gq[2];
#pragma unroll
        for (int i = 0; i < 2; ++i) { const int q = X.tid + 512 * i; gq[i] = *(const u32x4*)((const bf16*)(ws + WS_LG) + (size_t)(t0 + (q >> 3)) * 1024 + oc0 + (q & 7) * 8); }
#pragma unroll
        for (int i = 0; i < 5; ++i) { const int q = X.tid + 512 * i; if (q < 131 * 16) *(LAS u32x4*)(lds + O_RAW + (q >> 4) * 256 + (q & 15) * 16) = rawq[i]; }
        __syncthreads();
        if (n + 1 < 16) LRU_RAWLOAD(n + 1);
#pragma unroll 1
        for (int ih = 0; ih < 4; ih += 2) {
            float a[2][8];
            { const f32x4 b0 = *(const LAS f32x4*)(CW + 512 + cch * 8), b1 = *(const LAS f32x4*)(CW + 512 + cch * 8 + 4);
#pragma unroll
              for (int i = 0; i < 2; ++i) { a[i][0] = b0.x; a[i][1] = b0.y; a[i][2] = b0.z; a[i][3] = b0.w; a[i][4] = b1.x; a[i][5] = b1.y; a[i][6] = b1.z; a[i][7] = b1.w; } }
#pragma unroll
            for (int k = 0; k < 4; ++k) { const f32x4 w0 = *(const LAS f32x4*)(CW + k * 128 + cch * 8), w1 = *(const LAS f32x4*)(CW + k * 128 + cch * 8 + 4);
                const float cw[8] = {w0.x, w0.y, w0.z, w0.w, w1.x, w1.y, w1.z, w1.w};
#pragma unroll
                for (int i = 0; i < 2; ++i) { const int t = (X.tid + 512 * (ih + i)) >> 4;
                    const u32x4 v = *(const LAS u32x4*)(lds + O_RAW + (t + 3 - k) * 256 + cch * 16);
                    const float xv[8] = {bflo(v.x), bfhi(v.x), bflo(v.y), bfhi(v.y), bflo(v.z), bfhi(v.z), bflo(v.w), bfhi(v.w)};
#pragma unroll
                    for (int j = 0; j < 8; ++j) a[i][j] += cw[j] * xv[j]; } }
#pragma unroll
            for (int i = 0; i < 2; ++i) { const int t = (X.tid + 512 * (ih + i)) >> 4;
                *(LAS u32x4*)(lds + O_XC + swz(t, cch, 256)) = (u32x4){pk2(a[i][0], a[i][1]), pk2(a[i][2], a[i][3]), pk2(a[i][4], a[i][5]), pk2(a[i][6], a[i][7])}; }
        }
        __syncthreads();
#pragma unroll
        for (int i = 0; i < 2; ++i) { const int q = X.tid + 512 * i; *(LAS u32x4*)(lds + O_RAW + (q >> 3) * 128 + (q & 7) * 16) = gq[i]; }
        {
            const int cx = half * 64 + 16 * ob + fr;
#pragma unroll 2
            for (int tb = 0; tb < 4; ++tb) {
                f32x4 pa = (f32x4){0.f, 0.f, 0.f, 0.f}, pi = (f32x4){0.f, 0.f, 0.f, 0.f};
#pragma unroll
                for (int kk = 0; kk < 4; ++kk) { const bf16x8 xa = *(const LAS bf16x8*)(lds + O_XC + swz(64 * th + 16 * tb + fr, 4 * kk + fq, 256));
                    pa = __builtin_amdgcn_mfma_f32_16x16x32_bf16(xa, wa[kk], pa, 0, 0, 0); pi = __builtin_amdgcn_mfma_f32_16x16x32_bf16(xa, wi[kk], pi, 0, 0, 0); }
#pragma unroll
                for (int r = 0; r < 4; ++r) { const int t = 64 * th + 16 * tb + 4 * fq + r;
                    const float ra = fast_sigmoid(pa[r] + ba), ri = fast_sigmoid(pi[r] + bi);
                    const float x2 = -2.f * ra * sp8;
                    const float a = __builtin_amdgcn_exp2f(0.72134752f * x2);
                    const float em = x2 > -0.25f ? -x2 * (1.f + x2 * (0.5f + x2 * (0.16666667f + x2 * 0.041666668f))) : 1.f - a * a;
                    const float mult = __builtin_amdgcn_sqrtf(em);
                    const float xc = bf2f(*(const LAS bf16*)(lds + O_XC + swz(t, cx >> 3, 256) + (cx & 7) * 2));
                    La[t * 64 + 16 * ob + fr] = a; Lb[t * 64 + 16 * ob + fr] = mult * ri * xc; }
            }
        }
        __syncthreads();
        float ac[16], pl[16];
        { float Ag = 1.f, Bc = 0.f;
#pragma unroll
            for (int j = 0; j < 16; ++j) { const float a = La[(16 * sg + j) * 64 + o], bt = Lb[(16 * sg + j) * 64 + o]; Ag *= a; Bc = a * Bc + bt; ac[j] = Ag; pl[j] = Bc; }
            SA[sg * 64 + o] = Ag; SB[sg * 64 + o] = Bc; }
        __syncthreads();
        float h = CY[o];
        for (int s2 = 0; s2 < sg; ++s2) h = SA[s2 * 64 + o] * h + SB[s2 * 64 + o];
        { LAS bf16* yt = (LAS bf16*)(lds + O_RAW) + (16 * sg) * 64 + o; const float hin = h;
#pragma unroll
            for (int j = 0; j < 16; ++j) { h = pl[j] + ac[j] * hin; yt[j * 64] = (bf16)f2bf(h * bf2f(yt[j * 64])); } }
        __syncthreads();
        if (sg == 7) CY[o] = h;
#pragma unroll
        for (int i = 0; i < 2; ++i) { const int q = X.tid + 512 * i; bf16* ob_ = DRY ? (bf16*)(ws + WS_MEMB) + (size_t)((t0 + (q >> 3)) & 4095) * 1024 : (bf16*)(ws + WS_LG) + (size_t)(t0 + (q >> 3)) * 1024;
            *(u32x4*)(ob_ + oc0 + (q & 7) * 8) = *(const LAS u32x4*)(lds + O_RAW + (q >> 3) * 128 + (q & 7) * 16); }
        __syncthreads();
    }
#undef LRU_RAWLOAD
    __syncthreads();
}

__device__ __forceinline__ void attn_unit(Ctx& X, const Args& A, int unit) {
    const int b = unit >> 5, h = (unit >> 3) & 3, qt = unit & 7, t0 = b * SEQ + qt * 256;
    unsigned char* ws = X.ws; LAS unsigned char* lds = X.lds;
    const int w = X.wave, l = X.lane, fr = l & 15, fq = l >> 4;
    int fb[4];
#pragma unroll
    for (int k = 0; k < 4; ++k) fb[k] = fr * 512 + ((((4 * k + fq) ^ fr) & 15) << 4);
    const int wb = (X.tid >> 5) * 512 + (((X.tid & 31) & 16) << 4) + ((((X.tid & 31) ^ (X.tid >> 5)) & 15) << 4);
    const LaneTr TR = lane_tr_make(fr, fq);
    u32x4 qraw[2][8];
#pragma unroll
    for (int rb = 0; rb < 2; ++rb) { const bf16* qrow = (const bf16*)(ws + WS_Q) + (size_t)(t0 + 32 * w + 16 * rb + TR.fr2) * 1024 + h * 256 + 8 * TR.fq2;
#pragma unroll
        for (int kk = 0; kk < 8; ++kk) qraw[rb][kk] = *(const u32x4*)(qrow + 32 * kk); }
#pragma unroll 1
    for (int i0 = 0; i0 < 16; i0 += 8) {
#pragma unroll
        for (int i = 0; i < 8; ++i) { const int q = X.tid + 512 * (i0 + i), rho = q >> 5, ch = q & 31;
            const int key = 32 * (rho >> 5) + 8 * ((rho >> 2) & 3) + 4 * ((rho >> 4) & 1) + (rho & 3);
            *(LAS u32x4*)(lds + wb + (i0 + i) * 8192) = *(const u32x4*)((const bf16*)(ws + WS_KB) + (size_t)(b * 256 + key) * 1024 + h * 256 + ch * 8); }
    }
    __syncthreads();
    bf16x8 pf[2][8]; float inv[2];
    {
        bf16x8 qf[2][8];
#pragma unroll
        for (int rb = 0; rb < 2; ++rb)
#pragma unroll
            for (int kk = 0; kk < 8; ++kk) qf[rb][kk] = __builtin_bit_cast(bf16x8, lane_tr4_inv(TR, qraw[rb][kk]));
        f32x4 s[2][16];
#pragma unroll
        for (int blk = 0; blk < 16; ++blk) { s[0][blk] = (f32x4){0.f, 0.f, 0.f, 0.f}; s[1][blk] = (f32x4){0.f, 0.f, 0.f, 0.f};
#pragma unroll
            for (int kk = 0; kk < 8; ++kk) { const bf16x8 kf = *(const LAS bf16x8*)(lds + fb[kk & 3] + blk * 8192 + (kk >> 2) * 256);
                s[0][blk] = __builtin_amdgcn_mfma_f32_16x16x32_bf16(kf, qf[0][kk], s[0][blk], 0, 0, 0);
                s[1][blk] = __builtin_amdgcn_mfma_f32_16x16x32_bf16(kf, qf[1][kk], s[1][blk], 0, 0, 0); } }
#pragma unroll
        for (int rb = 0; rb < 2; ++rb) {
            float mx = -3.0e38f;
#pragma unroll
            for (int blk = 0; blk < 16; ++blk) mx = fmaxf(fmaxf(fmaxf(s[rb][blk][0], s[rb][blk][1]), fmaxf(s[rb][blk][2], s[rb][blk][3])), mx);
            mx = fmaxf(mx, __shfl_xor(mx, 16)); mx = fmaxf(mx, __shfl_xor(mx, 32));
            float sum = 0.f;
#pragma unroll
            for (int kk = 0; kk < 8; ++kk) { float pe[8];
#pragma unroll
                for (int r = 0; r < 4; ++r) { pe[r] = __builtin_amdgcn_exp2f((s[rb][2 * kk][r] - mx) * 1.4426950408889634f); pe[4 + r] = __builtin_amdgcn_exp2f((s[rb][2 * kk + 1][r] - mx) * 1.4426950408889634f); }
                sum += ((pe[0] + pe[1]) + (pe[2] + pe[3])) + ((pe[4] + pe[5]) + (pe[6] + pe[7]));
                u32x4 pw; pw.x = pk2(pe[0], pe[1]); pw.y = pk2(pe[2], pe[3]); pw.z = pk2(pe[4], pe[5]); pw.w = pk2(pe[6], pe[7]);
                pf[rb][kk] = __builtin_bit_cast(bf16x8, pw); }
            sum += __shfl_xor(sum, 16); sum += __shfl_xor(sum, 32);
            inv[rb] = 1.0f / sum;
            asm volatile("" ::: "memory");
        }
    }
    __syncthreads();
#pragma unroll 1
    for (int i0 = 0; i0 < 16; i0 += 8) {
#pragma unroll
        for (int i = 0; i < 8; ++i) { const int q = X.tid + 512 * (i0 + i), d = q >> 5, ch = q & 31;
            *(LAS u32x4*)(lds + wb + (i0 + i) * 8192) = *(const u32x4*)((const bf16*)(ws + WS_VT) + (size_t)(h * 256 + d) * 4096 + b * 256 + ch * 8); }
    }
    __syncthreads();
#pragma unroll
    for (int db = 0; db < 16; ++db) { f32x4 o0 = (f32x4){0.f, 0.f, 0.f, 0.f}, o1 = (f32x4){0.f, 0.f, 0.f, 0.f};
#pragma unroll
        for (int kk = 0; kk < 8; ++kk) { const bf16x8 vf = *(const LAS bf16x8*)(lds + fb[kk & 3] + db * 8192 + (kk >> 2) * 256);
            o0 = __builtin_amdgcn_mfma_f32_16x16x32_bf16(vf, pf[0][kk], o0, 0, 0, 0); o1 = __builtin_amdgcn_mfma_f32_16x16x32_bf16(vf, pf[1][kk], o1, 0, 0, 0); }
        bf16* orow = (bf16*)(ws + WS_Q) + (size_t)(t0 + 32 * w + TR.fr2) * 1024 + h * 256 + 16 * db + 4 * TR.fq2;
        *(u32x2*)(orow) = lane_tr2(TR, (u32x2){pk2(o0[0] * inv[0], o0[1] * inv[0]), pk2(o0[2] * inv[0], o0[3] * inv[0])});
        *(u32x2*)(orow + 16 * 1024) = lane_tr2(TR, (u32x2){pk2(o1[0] * inv[1], o1[1] * inv[1]), pk2(o1[2] * inv[1], o1[3] * inv[1])}); }
    __syncthreads();
}

__device__ __forceinline__ void route_block(Ctx& X, const Args& A, int blk) {
    unsigned char* ws = X.ws; LAS unsigned char* lds = X.lds;
    LAS float* GB = (LAS float*)(lds + 65536);
    LAS f32x4* ST = (LAS f32x4*)(lds + 81920);
    LAS float* LG = (LAS float*)(lds + 83968);
    LAS int* HI = (LAS int*)(lds + 117248);
    LAS float* RB = (LAS float*)(lds + 117504);
    LAS unsigned long long* KEY = (LAS unsigned long long*)lds;
    const int w = X.wave, l = X.lane, fr = l & 15, fq = l >> 4;
    if (X.tid < 64) { RB[X.tid] = A.in[24][X.tid]; HI[X.tid] = 0; }
    for (int i = X.tid; i < 4096; i += 512) GB[i] = i < 1024 ? A.in[21][i] : i < 2048 ? A.in[22][i - 1024] : i < 3072 ? A.in[2][i - 2048] : A.in[3][i - 3072];
    {
        f32x4 gi[4], bi[4];
#pragma unroll
        for (int j = 0; j < 4; ++j) { gi[j] = ((const f32x4*)A.in[2] + l)[64 * j]; bi[j] = ((const f32x4*)A.in[3] + l)[64 * j]; }
        f32x4 va[4], vb[4]; u32x2 ma[4], mb[4]; f32x2 xa, xb;
#define R1_SLOAD(vd, md, xd, r_) do { const int m = blk * 128 + 16 * w + ((r_) < 16 ? (r_) : 15); const f32x4* xr = (const f32x4*)(A.in[0] + (size_t)m * D) + l; \
            const u32x2* mr = (const u32x2*)((const bf16*)(ws + WS_MO) + (size_t)m * D) + l; xd = ((const f32x2*)(ws + WS_XSTAT))[m]; \
            _Pragma("unroll") for (int j = 0; j < 4; ++j) { vd[j] = xr[64 * j]; md[j] = mr[64 * j]; } } while (0)
        R1_SLOAD(va, ma, xa, 0); R1_SLOAD(vb, mb, xb, 1);
#pragma unroll 1
        for (int r = 0; r < 16; ++r) {
            f32x4 v[4]; u32x2 mq[4]; const f32x2 xs = xa;
#pragma unroll
            for (int j = 0; j < 4; ++j) { v[j] = va[j]; mq[j] = ma[j]; va[j] = vb[j]; ma[j] = mb[j]; }
            xa = xb;
            R1_SLOAD(vb, mb, xb, r + 2);
            float s = 0.f;
#pragma unroll
            for (int j = 0; j < 4; ++j) { const f32x4 mo = (f32x4){bflo(mq[j].x), bfhi(mq[j].x), bflo(mq[j].y), bfhi(mq[j].y)};
                v[j] = DN_ALPHA * ((v[j] - xs.x) * xs.y * gi[j] + bi[j]) + mo; s += (v[j].x + v[j].y) + (v[j].z + v[j].w); }
            const float mean = wave_sum(s) * (1.f / D); float s2 = 0.f;
#pragma unroll
            for (int j = 0; j < 4; ++j) { const f32x4 d = v[j] - mean; s2 += (d.x * d.x + d.y * d.y) + (d.z * d.z + d.w * d.w); }
            const float rstd = 1.f / sqrtf(wave_sum(s2) * (1.f / D) + LN_EPS);
            if (l == 0) ST[16 * w + r] = (f32x4){xs.x, xs.y, mean, rstd};
        }
#undef R1_SLOAD
    }
    __syncthreads();
    {
        f32x4 acc[4];
#pragma unroll
        for (int n = 0; n < 4; ++n) acc[n] = (f32x4){0.f, 0.f, 0.f, 0.f};
        const int row = blk * 128 + 16 * w + fr; const f32x4 st = ST[16 * w + fr];
        const float* tr = A.in[0] + (size_t)row * D + 8 * fq; const bf16* mr = (const bf16*)(ws + WS_MO) + (size_t)row * D + 8 * fq; bf16* hr = (bf16*)X.out + (size_t)row * 2048 + 1024 + 8 * fq;
        u32x4 wq[4]; f32x4 t0, t1, n0, n1; u32x4 m0, mn;
#define R1_WLOAD(c) do { _Pragma("unroll") for (int i = 0; i < 4; ++i) { const int p_ = X.tid + 512 * i; \
            wq[i] = *(const u32x4*)((const bf16*)(ws + WS_WR) + (size_t)(p_ >> 10) * 65536 + (size_t)((p_ >> 4) & 63) * 1024 + (c) * 128 + (p_ & 15) * 8); } } while (0)
#define R1_WSTORE(c) do { _Pragma("unroll") for (int i = 0; i < 4; ++i) { const int p_ = X.tid + 512 * i; \
            *(LAS u32x4*)(lds + ((c) & 1) * 32768 + (p_ >> 10) * 16384 + swz((p_ >> 4) & 63, p_ & 15, 256)) = wq[i]; } } while (0)
        R1_WLOAD(0); t0 = *(const f32x4*)(tr); t1 = *(const f32x4*)(tr + 4); m0 = *(const u32x4*)(mr); R1_WSTORE(0);
        __syncthreads();
#pragma unroll 1
        for (int c = 0; c < 8; ++c) {
            if (c + 1 < 8) R1_WLOAD(c + 1);
            const LAS unsigned char* wb = lds + (c & 1) * 32768;
#pragma unroll
            for (int k = 0; k < 4; ++k) {
                const int kb = c * 128 + 32 * k + 8 * fq;
                { const int kn = (c * 4 + k + 1 < 32) ? (c * 128 + 32 * k + 32) : 0; n0 = *(const f32x4*)(tr + kn); n1 = *(const f32x4*)(tr + kn + 4); mn = *(const u32x4*)(mr + kn); }
                const f32x4 g0 = *(const LAS f32x4*)(GB + kb), g1 = *(const LAS f32x4*)(GB + kb + 4), b0 = *(const LAS f32x4*)(GB + 1024 + kb), b1 = *(const LAS f32x4*)(GB + 1024 + kb + 4);
                const f32x4 i0 = *(const LAS f32x4*)(GB + 2048 + kb), i1 = *(const LAS f32x4*)(GB + 2048 + kb + 4), j0 = *(const LAS f32x4*)(GB + 3072 + kb), j1 = *(const LAS f32x4*)(GB + 3072 + kb + 4);
                const f32x4 ma = (f32x4){bflo(m0.x), bfhi(m0.x), bflo(m0.y), bfhi(m0.y)}, mb = (f32x4){bflo(m0.z), bfhi(m0.z), bflo(m0.w), bfhi(m0.w)};
                const f32x4 ta = DN_ALPHA * ((t0 - st.x) * st.y * i0 + j0) + ma, tb = DN_ALPHA * ((t1 - st.x) * st.y * i1 + j1) + mb;
                const f32x4 h0 = (ta - st.z) * st.w * g0 + b0, h1 = (tb - st.z) * st.w * g1 + b1;
                const unsigned q0 = f2bf(h0.x), q1 = f2bf(h0.y), q2 = f2bf(h0.z), q3 = f2bf(h0.w), q4 = f2bf(h1.x), q5 = f2bf(h1.y), q6 = f2bf(h1.z), q7 = f2bf(h1.w);
                const u32x4 hw = (u32x4){q0 | (q1 << 16), q2 | (q3 << 16), q4 | (q5 << 16), q6 | (q7 << 16)};
                const u32x4 lw = (u32x4){pk2(h0.x - bf2f(q0), h0.y - bf2f(q1)), pk2(h0.z - bf2f(q2), h0.w - bf2f(q3)), pk2(h1.x - bf2f(q4), h1.y - bf2f(q5)), pk2(h1.z - bf2f(q6), h1.w - bf2f(q7))};
                *(u32x4*)(hr + c * 128 + 32 * k) = hw;
                const bf16x8 xh = __builtin_bit_cast(bf16x8, hw), xl = __builtin_bit_cast(bf16x8, lw);
#pragma unroll
                for (int n = 0; n < 4; ++n) { const bf16x8 wh = *(const LAS bf16x8*)(wb + swz(16 * n + fr, 4 * k + fq, 256)), wl = *(const LAS bf16x8*)(wb + 16384 + swz(16 * n + fr, 4 * k + fq, 256));
                    acc[n] = __builtin_amdgcn_mfma_f32_16x16x32_bf16(xh, wh, acc[n], 0, 0, 0);
                    acc[n] = __builtin_amdgcn_mfma_f32_16x16x32_bf16(xh, wl, acc[n], 0, 0, 0);
                    acc[n] = __builtin_amdgcn_mfma_f32_16x16x32_bf16(xl, wh, acc[n], 0, 0, 0); }
                t0 = n0; t1 = n1; m0 = mn;
            }
            if (c + 1 < 8) R1_WSTORE(c + 1);
            __syncthreads();
        }
#undef R1_WLOAD
#undef R1_WSTORE
#pragma unroll
        for (int n = 0; n < 4; ++n)
#pragma unroll
            for (int r = 0; r < 4; ++r) { const int e = 16 * n + fr; const float sg = 1.0f / (1.0f + __expf(-acc[n][r])); const float ch = sg + RB[e];
                const unsigned cb = __builtin_bit_cast(unsigned, ch); const unsigned ob = cb ^ ((cb >> 31) ? 0xffffffffu : 0x80000000u);
                LG[(16 * w + 4 * fq + r) * 65 + e] = ch;
                KEY[(16 * w + 4 * fq + r) * 65 + e] = ((unsigned long long)ob << 32) | (unsigned)(63 - e); }
    }
    __syncthreads();
    {
        const int tq = X.tid >> 2, part = X.tid & 3, tok = blk * 128 + tq;
        const LAS float* ch = LG + tq * 65; const LAS unsigned long long* ky = KEY + tq * 65;
        float g2[2];
#pragma unroll
        for (int i = 0; i < 2; ++i) { float m1 = -3.0e38f, m2 = -3.0e38f;
#pragma unroll
            for (int j = 0; j < 8; ++j) { const float v = ch[(2 * part + i) * 8 + j]; if (v > m1) { m2 = m1; m1 = v; } else if (v > m2) m2 = v; }
            g2[i] = m1 + m2; }
        float gs[8];
#pragma unroll
        for (int q = 0; q < 4; ++q) { gs[2 * q] = __shfl(g2[0], (X.lane & ~3) | q); gs[2 * q + 1] = __shfl(g2[1], (X.lane & ~3) | q); }
        unsigned gmask = 0u; int mygrp = 0;
#pragma unroll
        for (int it = 0; it < 4; ++it) { float best = -3.0e38f; int bi = 0;
#pragma unroll
            for (int g = 0; g < 8; ++g) { const bool ok = !((gmask >> g) & 1u) && gs[g] > best; best = ok ? gs[g] : best; bi = ok ? g : bi; }
            gmask |= 1u << bi; mygrp = (it == part) ? bi : mygrp; }
        unsigned long long kk[8];
#pragma unroll
        for (int j = 0; j < 8; ++j) kk[j] = ky[mygrp * 8 + j];
        int idx[8]; float wt[8]; float wsum = 0.f;
#pragma unroll
        for (int k = 0; k < 8; ++k) { unsigned long long best = 0ull;
#pragma unroll
            for (int j = 0; j < 8; ++j) best = kk[j] > best ? kk[j] : best;
            { unsigned lo = (unsigned)best, hi = (unsigned)(best >> 32);
              unsigned long long o = ((unsigned long long)(unsigned)__shfl_xor((int)hi, 1) << 32) | (unsigned)__shfl_xor((int)lo, 1); best = o > best ? o : best;
              lo = (unsigned)best; hi = (unsigned)(best >> 32);
              o = ((unsigned long long)(unsigned)__shfl_xor((int)hi, 2) << 32) | (unsigned)__shfl_xor((int)lo, 2); best = o > best ? o : best; }
            const int be = 63 - (int)(best & 63ull);
#pragma unroll
            for (int j = 0; j < 8; ++j) kk[j] = (kk[j] == best) ? 0ull : kk[j];
            idx[k] = be; wt[k] = ch[be] - RB[be]; wsum += wt[k]; }
        const float sc2 = ROUTED_SCALE / wsum;
        int* ip = (int*)(ws + WS_IDX) + (size_t)tok * 8; float* wp = (float*)(ws + WS_WTS) + (size_t)tok * 8; int* rp = (int*)(ws + WS_RK) + (size_t)tok * 8;
#pragma unroll
        for (int i = 0; i < 2; ++i) { const int k = 2 * part + i;
            int ik = idx[0]; float wk = wt[0];
#pragma unroll
            for (int q = 1; q < 8; ++q) { ik = (k == q) ? idx[q] : ik; wk = (k == q) ? wt[q] : wk; }
            ip[k] = ik; wp[k] = wk * sc2; rp[k] = atomicAdd((int*)(HI + ik), 1); }
    }
    __syncthreads();
    if (X.tid < 64) ((int*)(ws + WS_HIST))[blk * 64 + X.tid] = HI[X.tid];
    __syncthreads();
}

__device__ __forceinline__ void place_block(Ctx& X, const Args& A, int blk) {
    unsigned char* ws = X.ws; LAS unsigned char* lds = X.lds;
    LAS int* CNT = (LAS int*)lds; LAS int* PAD = CNT + 64; LAS int* BEF = CNT + 128; LAS int* PST = CNT + 192;
    const int chn = blk / BPC, jj = blk % BPC;
    if (X.tid < 64) { const int* hp = (const int*)(ws + WS_HIST) + (size_t)(chn * BPC) * 64 + X.tid; int cnt = 0, bef = 0;
        for (int j = 0; j < BPC; ++j) { const int v = hp[j * 64]; cnt += v; bef += (j < jj) ? v : 0; }
        CNT[X.tid] = cnt; PAD[X.tid] = (cnt + 255) & ~255; BEF[X.tid] = bef; }
    __syncthreads();
    if (X.tid == 0) { int ps = 0; for (int e = 0; e < 64; ++e) { PST[e] = ps; ps += PAD[e]; } PST[64] = ps; }
    __syncthreads();
    unsigned* rowoff = (unsigned*)(ws + WS_ROWOFF) + (size_t)chn * CROWS; float* roww = (float*)(ws + WS_ROWW) + (size_t)chn * CROWS;
#define ROWOFF_IDX(d) ((((d) >> 8) << 8) + (((d) & 63) << 2) + (((d) >> 6) & 3))
    if (X.tid < 128) { const int tok = blk * 128 + X.tid;
        const int* ip = (const int*)(ws + WS_IDX) + (size_t)tok * 8; const float* wp = (const float*)(ws + WS_WTS) + (size_t)tok * 8; const int* rp = (const int*)(ws + WS_RK) + (size_t)tok * 8;
        int* pp = (int*)(ws + WS_POS) + (size_t)tok * 8;
#pragma unroll
        for (int k = 0; k < 8; ++k) { const int e = ip[k]; const int dest = PST[e] + BEF[e] + rp[k]; rowoff[ROWOFF_IDX(dest)] = (unsigned)tok * 4096u; roww[dest] = wp[k]; pp[k] = dest; } }
    if (jj == 0) {
        for (int e = 0; e < 64; ++e) { const int st = PST[e] + CNT[e], en = PST[e] + PAD[e]; if (st + X.tid < en) { const int d = st + X.tid; rowoff[ROWOFF_IDX(d)] = (unsigned)(chn * CT) * 4096u; roww[d] = 0.f; } }
        int* te = (int*)(ws + WS_TILEE) + chn * (RTMAX + SHT);
        if (X.tid < 64) { for (int tl = PST[X.tid] >> 8; tl < (PST[X.tid] + PAD[X.tid]) >> 8; ++tl) te[tl] = X.tid; }
        if (X.tid < SHT) te[RTMAX + X.tid] = 64;
        if (X.tid == 0) ((int*)(ws + WS_NTILE))[chn] = PST[64] >> 8;
    }
    if (X.tid < 128) { const int i = jj * 128 + X.tid, d = RTMAX * 256 + i; rowoff[ROWOFF_IDX(d)] = (unsigned)(chn * CT + i) * 4096u; roww[d] = 1.0f; }
    __syncthreads();
}

template <bool DRY = false> __device__ __forceinline__ void combine_rows(Ctx& X, const Args& A, int chn) {
    unsigned char* ws = X.ws; int l_ = X.lane; asm volatile("" : "+v"(l_)); const int l = l_; const int gw = X.vcu * 8 + X.wave, NGW = X.G * 8;
    f32x4 g2[4], b2[4];
#pragma unroll
    for (int j = 0; j < 4; ++j) { g2[j] = ((const f32x4*)A.in[31] + l)[64 * j]; b2[j] = ((const f32x4*)A.in[32] + l)[64 * j]; }
    const unsigned char* Y = ws + WS_Y;
    const int nrows = (CT - gw + NGW - 1) / NGW;
    if (nrows <= 0) return;
#define F_ROW(i_) (gw + ((i_) < nrows ? (i_) : nrows - 1) * NGW)
#define F_LOADPOS(dst, i_) do { const int* pp_ = (const int*)(ws + WS_POS) + (size_t)(chn * CT + F_ROW(i_)) * 8; _Pragma("unroll") for (int k = 0; k < 8; ++k) dst[k] = __builtin_amdgcn_readfirstlane(pp_[k]); } while (0)
#define F_LOADROW(yd, hd, pos, i_) do { const int r_ = F_ROW(i_); \
        const u32x2* hq_ = (const u32x2*)((const bf16*)X.out + (size_t)(chn * CT + r_) * 2048 + 1024) + l;     \
        _Pragma("unroll") for (int j = 0; j < 4; ++j) hd[j] = hq_[64 * j]; \
        _Pragma("unroll") for (int k = 0; k < 9; ++k) { const int row_ = k < 8 ? pos[k < 8 ? k : 0] : RTMAX * 256 + r_; const unsigned* yr_ = (const unsigned*)(Y + (size_t)row_ * 1024) + l; \
            _Pragma("unroll") for (int j = 0; j < 4; ++j) yd[k][j] = yr_[64 * j]; } } while (0)
    int pc[8], pn[8];
    unsigned yc[9][4], yn[9][4]; u32x2 hc[4], hn[4];
    F_LOADPOS(pc, 0); F_LOADROW(yc, hc, pc, 0); F_LOADPOS(pn, 1);
#pragma unroll 1
    for (int i = 0; i < nrows; ++i) {
        F_LOADROW(yn, hn, pn, i + 1);
        F_LOADPOS(pc, i + 2);
        const int m = chn * CT + gw + i * NGW;
        f32x4 v[4]; float s, mean, s2, rstd;
#pragma unroll
        for (int j = 0; j < 4; ++j) v[j] = DN_ALPHA * (f32x4){bflo(hc[j].x), bfhi(hc[j].x), bflo(hc[j].y), bfhi(hc[j].y)};
        f32x4 ys[4] = {(f32x4){0.f, 0.f, 0.f, 0.f}, (f32x4){0.f, 0.f, 0.f, 0.f}, (f32x4){0.f, 0.f, 0.f, 0.f}, (f32x4){0.f, 0.f, 0.f, 0.f}};
#pragma unroll
        for (int k = 0; k < 9; ++k)
#pragma unroll
            for (int j = 0; j < 4; ++j) { const int y = (int)yc[k][j];
                ys[j].x += __builtin_amdgcn_cvt_f32_fp8(y, 0); ys[j].y += __builtin_amdgcn_cvt_f32_fp8(y, 1); ys[j].z += __builtin_amdgcn_cvt_f32_fp8(y, 2); ys[j].w += __builtin_amdgcn_cvt_f32_fp8(y, 3); }
#pragma unroll
        for (int j = 0; j < 4; ++j) v[j] += ys[j] * (1.0f / YSCALE);
        s = 0.f;
#pragma unroll
        for (int j = 0; j < 4; ++j) s += (v[j].x + v[j].y) + (v[j].z + v[j].w);
        mean = wave_sum(s) * (1.f / D); s2 = 0.f;
#pragma unroll
        for (int j = 0; j < 4; ++j) { v[j] = v[j] - mean; s2 += (v[j].x * v[j].x + v[j].y * v[j].y) + (v[j].z * v[j].z + v[j].w * v[j].w); }
        rstd = 1.f / sqrtf(wave_sum(s2) * (1.f / D) + LN_EPS);
        f32x4* xr = (f32x4*)(X.out + (size_t)m * D) + l;
#pragma unroll
        for (int j = 0; j < 4; ++j) { f32x4* orow = DRY ? (f32x4*)(ws + WS_HB + (size_t)chn * CROWS * 512 + (size_t)(gw + i * NGW) * 4096) + l : xr; orow[64 * j] = v[j] * rstd * g2[j] + b2[j]; }
#pragma unroll
        for (int k = 0; k < 9; ++k)
#pragma unroll
            for (int j = 0; j < 4; ++j) yc[k][j] = yn[k][j];
#pragma unroll
        for (int j = 0; j < 4; ++j) hc[j] = hn[j];
#pragma unroll
        for (int k = 0; k < 8; ++k) { const int t_ = pn[k]; pn[k] = pc[k]; pc[k] = t_; }
    }
#undef F_ROW
#undef F_LOADPOS
#undef F_LOADROW
}
#if MK_DEBUG
__device__ __forceinline__ unsigned hsh(unsigned x) { x ^= x >> 16; x *= 0x7feb352dU; x ^= x >> 15; x *= 0x846ca68bU; x ^= x >> 16; return x; }
__device__ __forceinline__ void dbg_fail(unsigned char* ws, int code) { atomicMin((int*)ws, code); }
__device__ __forceinline__ bool closef(float got, float ex, float rel, float ab) { return fabsf(got - ex) <= rel * fabsf(ex) + ab; }
__device__ __forceinline__ float rbf(float x) { return bf2f(f2bf(x)); }
__device__ __forceinline__ float wave_max(float v) {
#pragma unroll
    for (int o = 1; o < 64; o <<= 1) v = fmaxf(v, __shfl_xor(v, o));
    return v;
}
#define DBG_EXP(ws) ((float*)((ws) + 65536))

__device__ __forceinline__ void chk_B(Ctx& X, const Args& A) {
    unsigned char* ws = X.ws; const int gw = X.bid * 8 + X.wave, NGW = X.G * 8, l = X.lane;
    for (int s = gw; s < 4096; s += NGW) {
        const int t = hsh(2 * s + 1) % T, c = hsh(2 * s + 2) % 8192;
        float acc = 0.f;
        for (int k = l; k < 1024; k += 64) acc += bf2f(((const bf16*)(ws + WS_H0))[(size_t)t * 1024 + k]) * rbf(A.in[4][(size_t)k * 8192 + c]);
        const float z = wave_sum(acc); const int reg = c >> 10, cc = c & 1023;
        const float ex = (reg == 0 || reg == 1 || reg == 3) ? gelu_tanh(z) : reg == 2 ? z : reg == 4 ? z * 0.0625f : 1.f / (1.f + __expf(-z));
        const bf16* buf = reg == 0 ? (const bf16*)(ws + WS_U) : reg == 1 ? (const bf16*)(ws + WS_GV) : reg == 2 ? (const bf16*)(ws + WS_LX) : reg == 3 ? (const bf16*)(ws + WS_LG) : reg == 4 ? (const bf16*)(ws + WS_Q) :
                          reg == 5 ? (const bf16*)(ws + WS_G0) : reg == 6 ? (const bf16*)X.out : (const bf16*)X.out + (size_t)T * 1024;
        const float got = bf2f(buf[(size_t)t * 1024 + cc]);
        if (!closef(got, ex, 0.02f, 0.01f)) { dbg_fail(ws, 10 + reg); }
    }
    for (int s = gw; s < 1024; s += NGW) {
        const int m = hsh(3 * s + 7) % TM, c = hsh(3 * s + 8) % 2048;
        float acc = 0.f;
        for (int k = l; k < 1024; k += 64) acc += rbf(A.in[1][(size_t)m * 1024 + k]) * rbf(A.in[16][(size_t)k * 2048 + c]);
        const float z = wave_sum(acc);
        const float got = c < 1024 ? bf2f(((const bf16*)(ws + WS_KB))[(size_t)m * 1024 + c]) : bf2f(((const bf16*)(ws + WS_VT))[(size_t)(c - 1024) * 4096 + m]);
        if (!closef(got, z, 0.02f, 0.01f)) dbg_fail(ws, c < 1024 ? 18 : 19);
    }
    for (int s = gw; s < 512; s += NGW) {
        const int t = hsh(5 * s + 3) % T; float a = 0.f, q = 0.f;
        for (int k = l; k < 1024; k += 64) { const float v = bf2f(((const bf16*)(ws + WS_GV))[(size_t)t * 1024 + k]); a += v; q += v * v; }
        a = wave_sum(a); q = wave_sum(q);
        float pa = 0.f, pq = 0.f; if (l < 16) { const f32x2 p = ((const f32x2*)(ws + WS_VSTAT))[(size_t)t * 16 + l]; pa = p.x; pq = p.y; }
        pa = wave_sum(pa); pq = wave_sum(pq);
        if (!closef(pa, a, 0.01f, 0.5f) || !closef(pq, q, 0.01f, 0.5f)) dbg_fail(ws, 9);
    }
}

__device__ __forceinline__ void chk_C_pre(Ctx& X, const Args& A) {
    unsigned char* ws = X.ws; const int gw = X.bid * 8 + X.wave, NGW = X.G * 8, l = X.lane;
    float* EX = DBG_EXP(ws);
    for (int s = gw; s < 3 * 512; s += NGW) {
        const int kind = s / 512, si = s % 512;
        if (kind == 0) {
            const int t = hsh(7 * si + 1) % T, c = hsh(7 * si + 2) % 1024, g = c >> 7, t0 = t & ~127, tl = t - t0;
            float acc = 0.f;
            for (int sr = 0; sr <= tl; ++sr) {
                float a = 0.f, q = 0.f;
                for (int k = l; k < 1024; k += 64) { const float v = bf2f(((const bf16*)(ws + WS_GV))[(size_t)(t0 + sr) * 1024 + k]); a += v; q += v * v; }
                a = wave_sum(a); q = wave_sum(q);
                const float mean = a * (1.f / 1024.f), var = q * (1.f / 1024.f) - mean * mean, rstd = 1.f / sqrtf(var + LN_EPS);
                const float vn = (bf2f(((const bf16*)(ws + WS_GV))[(size_t)(t0 + sr) * 1024 + c]) - mean) * rstd * A.in[5][c] + A.in[6][c];
                acc += A.in[7][(g * 128 + tl) * 128 + sr] * vn;
            }
            EX[s] = bf2f(((const bf16*)(ws + WS_U))[(size_t)t * 1024 + c]) * (acc + A.in[8][g * 128 + tl]);
        } else if (kind == 1) {
            if (si >= 64) { EX[s] = 0.f; continue; }
            const int b = hsh(11 * si + 1) % NB, ch = hsh(11 * si + 2) % 1024, ts = hsh(11 * si + 3) % SEQ, g = ch >> 7, o = ch & 127;
            float xh[2][3] = {{0.f, 0.f, 0.f}, {0.f, 0.f, 0.f}}; float h = 0.f;
            const float lam = A.in[15][ch], sp = log1pf(__expf(-lam)), ba = A.in[12][ch], bi = A.in[14][ch];
            float cw[2][4], cb[2], wa[2], wi[2];
#pragma unroll
            for (int q = 0; q < 2; ++q) { const int i = g * 128 + l + 64 * q; cb[q] = A.in[10][i];
#pragma unroll
                for (int k = 0; k < 4; ++k) cw[q][k] = A.in[9][k * 1024 + i];
                wa[q] = rbf(A.in[11][(size_t)g * 16384 + (l + 64 * q) * 128 + o]); wi[q] = rbf(A.in[13][(size_t)g * 16384 + (l + 64 * q) * 128 + o]); }
            for (int t = 0; t <= ts; ++t) {
                float xc[2]; float pa = 0.f, pi = 0.f;
#pragma unroll
                for (int q = 0; q < 2; ++q) { const float x0 = bf2f(((const bf16*)(ws + WS_LX))[(size_t)(b * SEQ + t) * 1024 + g * 128 + l + 64 * q]);
                    xc[q] = rbf(cb[q] + cw[q][0] * x0 + cw[q][1] * xh[q][0] + cw[q][2] * xh[q][1] + cw[q][3] * xh[q][2]);
                    xh[q][2] = xh[q][1]; xh[q][1] = xh[q][0]; xh[q][0] = x0; pa += xc[q] * wa[q]; pi += xc[q] * wi[q]; }
                pa = wave_sum(pa); pi = wave_sum(pi);
                const float xo = __shfl(o < 64 ? xc[0] : xc[1], o & 63);
                const float r = 1.f / (1.f + __expf(-(pa + ba))), ii = 1.f / (1.f + __expf(-(pi + bi)));
                const float la = -8.f * r * sp, a = __expf(la), mult = sqrtf(-expm1f(2.f * la));
                h = a * h + mult * ii * xo;
            }
            EX[s] = h * bf2f(((const bf16*)(ws + WS_LG))[(size_t)(b * SEQ + ts) * 1024 + ch]);
        } else {
            const int t = hsh(13 * si + 1) % T, c = hsh(13 * si + 2) % 1024, hh = c >> 8, b = t / SEQ;
            float sc[4];
#pragma unroll
            for (int j = 0; j < 4; ++j) { const int m = l + 64 * j; float a = 0.f;
                for (int dd = 0; dd < 256; ++dd) a += bf2f(((const bf16*)(ws + WS_Q))[(size_t)t * 1024 + hh * 256 + dd]) * bf2f(((const bf16*)(ws + WS_KB))[(size_t)(b * 256 + m) * 1024 + hh * 256 + dd]);
                sc[j] = a; }
            const float mx = wave_max(fmaxf(fmaxf(sc[0], sc[1]), fmaxf(sc[2], sc[3])));
            float sum = 0.f, ov = 0.f;
#pragma unroll
            for (int j = 0; j < 4; ++j) { const float p = __expf(sc[j] - mx); sum += p; ov += p * bf2f(((const bf16*)(ws + WS_VT))[(size_t)c * 4096 + b * 256 + l + 64 * j]); }
            sum = wave_sum(sum); ov = wave_sum(ov);
            EX[s] = ov / sum;
        }
    }
}
__device__ __forceinline__ void chk_C_post(Ctx& X, const Args& A) {
    unsigned char* ws = X.ws; const float* EX = DBG_EXP(ws);
    for (int s = X.bid * 512 + X.tid; s < 3 * 512; s += X.G * 512) {
        const int kind = s / 512, si = s % 512; float got;
        if (kind == 0) { const int t = hsh(7 * si + 1) % T, c = hsh(7 * si + 2) % 1024; got = bf2f(((const bf16*)(ws + WS_U))[(size_t)t * 1024 + c]); }
        else if (kind == 1) { if (si >= 64) continue; const int b = hsh(11 * si + 1) % NB, ch = hsh(11 * si + 2) % 1024, ts = hsh(11 * si + 3) % SEQ; got = bf2f(((const bf16*)(ws + WS_LG))[(size_t)(b * SEQ + ts) * 1024 + ch]); }
        else { const int t = hsh(13 * si + 1) % T, c = hsh(13 * si + 2) % 1024; got = bf2f(((const bf16*)(ws + WS_Q))[(size_t)t * 1024 + c]); }
        if (!closef(got, EX[s], 0.04f, kind == 2 ? 0.004f : 0.02f)) dbg_fail(ws, 20 + kind);
    }
}
__device__ __forceinline__ void chk_D1(Ctx& X, const Args& A) {
    unsigned char* ws = X.ws; const int gw = X.bid * 8 + X.wave, NGW = X.G * 8, l = X.lane;
    for (int s = gw; s < 2048; s += NGW) {
        const int t = hsh(17 * s + 1) % T, c = hsh(17 * s + 2) % 1024; float ex = 0.f;
#pragma unroll
        for (int k = 0; k < 3; ++k) {
            const bf16* Y = (const bf16*)(ws + (k == 0 ? WS_U : k == 1 ? WS_LG : WS_Q)); const bf16* Gk = k == 0 ? (const bf16*)(ws + WS_G0) : k == 1 ? (const bf16*)X.out : (const bf16*)X.out + (size_t)T * 1024;
            float acc = 0.f;
            for (int j = l; j < 1024; j += 64) acc += bf2f(Y[(size_t)t * 1024 + j]) * rbf(A.in[17 + k][(size_t)j * 1024 + c]);
            ex += bf2f(Gk[(size_t)t * 1024 + c]) * wave_sum(acc);
        }
        const float got = bf2f(((const bf16*)(ws + WS_H0))[(size_t)t * 1024 + c]);
        if (!closef(got, ex, 0.02f, 0.01f)) dbg_fail(ws, 30);
    }
}
__device__ __forceinline__ void chk_D2(Ctx& X, const Args& A) {
    unsigned char* ws = X.ws; const int gw = X.bid * 8 + X.wave, NGW = X.G * 8, l = X.lane;
    for (int s = gw; s < 2048; s += NGW) {
        const int t = hsh(19 * s + 1) % T, c = hsh(19 * s + 2) % 1024;
        float a = 0.f, q = 0.f, acc = 0.f;
        for (int j = l; j < 1024; j += 64) { const float v = A.in[0][(size_t)t * 1024 + j]; a += v; q += v * v; acc += bf2f(((const bf16*)(ws + WS_H0))[(size_t)t * 1024 + j]) * rbf(A.in[20][(size_t)j * 1024 + c]); }
        a = wave_sum(a); q = wave_sum(q); acc = wave_sum(acc);
        const float mean = a * (1.f / 1024.f), var = q * (1.f / 1024.f) - mean * mean, rstd = 1.f / sqrtf(var + LN_EPS);
        const float ex = DN_ALPHA * ((A.in[0][(size_t)t * 1024 + c] - mean) * rstd * A.in[2][c] + A.in[3][c]) + acc;
        if (!closef(X.out[(size_t)t * 1024 + c], ex, 0.01f, 0.01f)) dbg_fail(ws, 31);
    }
}
__device__ __forceinline__ void chk_R1(Ctx& X, const Args& A) {
    unsigned char* ws = X.ws; const int gw = X.bid * 8 + X.wave, NGW = X.G * 8, l = X.lane;
    LAS float* hb = (LAS float*)(X.lds + X.wave * 8192); LAS float* cs = hb + 1024; LAS float* ss = cs + 64;
    int nmis = 0;
    for (int s = gw; s < 2048; s += NGW) {
        const int t = hsh(23 * s + 1) % T;
        float a = 0.f, q = 0.f;
        for (int j = l; j < 1024; j += 64) { const float v = X.out[(size_t)t * 1024 + j]; a += v; q += v * v; }
        a = wave_sum(a); q = wave_sum(q);
        const float mean = a * (1.f / 1024.f), var = q * (1.f / 1024.f) - mean * mean, rstd = 1.f / sqrtf(var + LN_EPS);
        bool badh = false;
        for (int j = l; j < 1024; j += 64) { const float h1 = (X.out[(size_t)t * 1024 + j] - mean) * rstd * A.in[21][j] + A.in[22][j]; hb[j] = h1;
            if (!closef(bf2f(((const bf16*)(ws + WS_H1))[(size_t)t * 1024 + j]), h1, 0.01f, 0.003f)) badh = true; }
        if (__any(badh)) dbg_fail(ws, 39);
        LDS_WAIT();
        float lg = 0.f;
        for (int k = 0; k < 1024; ++k) lg += hb[k] * A.in[23][k * 64 + l];
        const float sg = 1.f / (1.f + __expf(-lg)); ss[l] = sg; cs[l] = sg + A.in[24][l];
        LDS_WAIT();
        unsigned long long sel = 0ull, ksel = 0ull; float wsum = 0.f;
        {
            float gs[8]; unsigned gmask = 0u;
            for (int g = 0; g < 8; ++g) { float m1 = -3e38f, m2 = -3e38f; for (int j = 0; j < 8; ++j) { const float v = cs[g * 8 + j]; if (v > m1) { m2 = m1; m1 = v; } else if (v > m2) m2 = v; } gs[g] = m1 + m2; }
            for (int it = 0; it < 4; ++it) { float best = -3e38f; int bi = 0; for (int g = 0; g < 8; ++g) if (!((gmask >> g) & 1u) && gs[g] > best) { best = gs[g]; bi = g; } gmask |= 1u << bi; }
            for (int k = 0; k < 8; ++k) { float best = -3e38f; int be = 0; for (int e = 0; e < 64; ++e) { const float v = cs[e]; if (((gmask >> (e >> 3)) & 1u) && !((sel >> e) & 1ull) && v > best) { best = v; be = e; } } sel |= 1ull << be; wsum += ss[be]; }
        }
        const int* ip = (const int*)(ws + WS_IDX) + (size_t)t * 8; const float* wp = (const float*)(ws + WS_WTS) + (size_t)t * 8;
        bool wbad = false;
        for (int k = 0; k < 8; ++k) { const int e = ip[k]; if (e < 0 || e > 63) { dbg_fail(ws, 42); continue; } ksel |= 1ull << e; if (!closef(wp[k], ss[e] / wsum * ROUTED_SCALE, 0.01f, 1e-4f)) wbad = true; }
        if (ksel != sel) ++nmis; else if (wbad) dbg_fail(ws, 41);
        LDS_WAIT();
    }
    if (nmis > 0 && l == 0) atomicAdd((int*)ws + 4, nmis);
}
__device__ __forceinline__ void chk_R2(Ctx& X, const Args& A) {
    unsigned char* ws = X.ws;
    if (X.bid == 0 && X.tid == 0 && ((const int*)ws)[4] > 100) dbg_fail(ws, 40);
    for (int s = X.bid * 512 + X.tid; s < 16384; s += X.G * 512) {
        const int tok = hsh(29 * s + 1) % T, k = hsh(29 * s + 2) % 8, chn = tok / CT;
        const int dest = ((const int*)(ws + WS_POS))[tok * 8 + k], e = ((const int*)(ws + WS_IDX))[tok * 8 + k];
        const int nt = ((const int*)(ws + WS_NTILE))[chn];
        if (nt < CT / 32 || nt > RTMAX || dest < 0 || dest >= nt * 256) { dbg_fail(ws, 50); continue; }
        const unsigned ro = ((const unsigned*)(ws + WS_ROWOFF))[(size_t)chn * CROWS + ROWOFF_IDX(dest)];
        if (ro != (unsigned)tok * 2048u) dbg_fail(ws, 51);
        if (((const float*)(ws + WS_ROWW))[(size_t)chn * CROWS + dest] != ((const float*)(ws + WS_WTS))[tok * 8 + k]) dbg_fail(ws, 52);
        if (((const int*)(ws + WS_TILEE))[chn * (RTMAX + SHT) + (dest >> 8)] != e) dbg_fail(ws, 53);
    }
}
__device__ __forceinline__ void chk_E(Ctx& X, const Args& A, int chn, int which) {
    unsigned char* ws = X.ws; const int gw = X.bid * 8 + X.wave, NGW = X.G * 8, l = X.lane;
    const int nt = ((const int*)(ws + WS_NTILE))[chn];
    for (int s = gw; s < 2048; s += NGW) {
        const int ti = hsh(31 * s + 1 + chn) % (nt + SHT), tile = ti < nt ? ti : RTMAX + (ti - nt), row = tile * 256 + hsh(31 * s + 2) % 256;
        const int e = ((const int*)(ws + WS_TILEE))[chn * (RTMAX + SHT) + tile];
        if (e < 0 || e > 64) { dbg_fail(ws, 59); continue; }
        if (which == 0) {
            const int col = hsh(31 * s + 3) % 256;
            const unsigned tok = ((const unsigned*)(ws + WS_ROWOFF))[(size_t)chn * CROWS + ROWOFF_IDX(row)] / 2048u;
            const float* Wg = e < 64 ? A.in[25] + (size_t)e * 262144 : A.in[28]; const float* Wu = e < 64 ? A.in[26] + (size_t)e * 262144 : A.in[29];
            float ag = 0.f, au = 0.f;
            for (int k = l; k < 1024; k += 64) { const float hv = bf2f(((const bf16*)(ws + WS_H1))[(size_t)tok * 1024 + k]); ag += hv * rbf(Wg[(size_t)k * 256 + col]); au += hv * rbf(Wu[(size_t)k * 256 + col]); }
            ag = wave_sum(ag); au = wave_sum(au);
            const float ex = ag / (1.f + __expf(-ag)) * au;
            if (!closef(bf2f(((const bf16*)(ws + WS_HB))[((size_t)chn * CROWS + row) * 256 + col]), ex * ((const float*)(ws + WS_ROWW))[(size_t)chn * CROWS + row], 0.03f, 0.003f)) dbg_fail(ws, 60 + chn);
        } else {
            const int col = hsh(31 * s + 3) % 1024;
            const float* Wd = e < 64 ? A.in[27] + (size_t)e * 262144 : A.in[30];
            float acc = 0.f;
            for (int j = l; j < 256; j += 64) acc += bf2f(((const bf16*)(ws + WS_HB))[((size_t)chn * CROWS + row) * 256 + j]) * rbf(Wd[(size_t)j * 1024 + col]);
            acc = wave_sum(acc);
            { const int yw = ((const int*)(ws + WS_Y))[((size_t)row * 1024 + col) >> 2]; const int bs = col & 3; const float yv = (bs == 0 ? __builtin_amdgcn_cvt_f32_fp8(yw, 0) : bs == 1 ? __builtin_amdgcn_cvt_f32_fp8(yw, 1) : bs == 2 ? __builtin_amdgcn_cvt_f32_fp8(yw, 2) : __builtin_amdgcn_cvt_f32_fp8(yw, 3)) * (1.f / YSCALE);
              if (!closef(yv, acc, 0.08f, 0.004f)) dbg_fail(ws, 70 + chn); }
        }
    }
}
__device__ __forceinline__ void dbg_finish(Ctx& X) {
    const int* cw = (const int*)X.ws; const int code = cw[0];
    if (code != 0x7fffffff) { const float v = sqrtf((float)code); for (size_t i = (size_t)X.bid * 512 + X.tid; i < (size_t)T * D; i += (size_t)X.G * 512) X.out[i] = v; }
}
#endif
#define XB_TMO      128
#define XB_XCNT(j)  (256  + 64 * (j))
#define XB_XSUB(j)  (1280 + 64 * (j))
#define XB_XGEN(j)  (2304 + 64 * (j))
#define XB_TOP      3328
#define XB_TOPGEN   3392
#define XCD_BAR_WORDS 3456
#define XB_SPIN_CAP (1u << 18)

__device__ __forceinline__ unsigned xb_ld(unsigned* p)              { return __hip_atomic_load(p, __ATOMIC_RELAXED, __HIP_MEMORY_SCOPE_AGENT); }
__device__ __forceinline__ unsigned xb_add(unsigned* p, unsigned v) { return __hip_atomic_fetch_add(p, v, __ATOMIC_RELAXED, __HIP_MEMORY_SCOPE_AGENT); }
__device__ __forceinline__ unsigned xb_xcc_id() { return (unsigned)__builtin_amdgcn_s_getreg((3 << 11) | 20) & 0xFu; }
#define XB_SPIN(cond, bar) do { unsigned _sp = 0; while (cond) { __builtin_amdgcn_s_sleep(1); \
    if ((++_sp & 255u) == 0u) { if (xb_ld(&(bar)[XB_TMO])) break; if (_sp > XB_SPIN_CAP) { atomicAdd(&(bar)[XB_TMO], 1u); break; } } } } while (0)

struct XcdBarrier {
    unsigned* bar; unsigned x; int wv;
    volatile LAS unsigned* st;
};

__device__ __forceinline__ XcdBarrier xcd_barrier_post(unsigned* bar, volatile LAS unsigned* st, int wv) {
    XcdBarrier b; b.bar = bar; b.x = xb_xcc_id(); b.st = st; b.wv = wv;
    if (wv == 0 && lane_id() == 0) (void)xb_add(&bar[XB_XCNT(b.x)], 1u);
    return b;
}
__device__ __forceinline__ void xcd_barrier_complete(unsigned* bar, unsigned x, unsigned& nloc, unsigned& nx) {
    const unsigned G = gridDim.x * gridDim.y * gridDim.z;
    unsigned sum, cnt, mine, sp = 0u;
    for (;;) {
        sum = 0u; cnt = 0u; mine = 0u;
#pragma unroll
        for (unsigned j = 0; j < 16; ++j) { const unsigned c = xb_ld(&bar[XB_XCNT(j)]); sum += c; cnt += (c > 0u) ? 1u : 0u; mine = (j == x) ? c : mine; }
        if (sum == G) break;
        __builtin_amdgcn_s_sleep(1);
        if ((++sp & 255u) == 0u) { if (xb_ld(&bar[XB_TMO])) break; if (sp > XB_SPIN_CAP) { atomicAdd(&bar[XB_TMO], 1u); break; } }
    }
    nloc = mine > 0u ? mine : 1u; nx = cnt > 0u ? cnt : 1u;
}

__device__ __forceinline__ void xcd_barrier(const XcdBarrier& b) {
    asm volatile("s_waitcnt vmcnt(0)" ::: "memory");
    __syncthreads();
    if (b.wv == 0 && lane_id() == 0) {
        unsigned* bar = b.bar;
        __builtin_amdgcn_s_waitcnt(0);
        unsigned nloc = b.st[0], nx = b.st[1];
        if (nloc == 0u) { xcd_barrier_complete(bar, b.x, nloc, nx); b.st[0] = nloc; b.st[1] = nx; }
        const unsigned old = xb_add(&bar[XB_XSUB(b.x)], 1u);
        const unsigned gen = old / nloc;
        if (old + 1u == (gen + 1u) * nloc) {
            __builtin_amdgcn_fence(__ATOMIC_RELEASE, "agent");
            asm volatile("s_waitcnt vmcnt(0)" ::: "memory");
            const unsigned og = xb_add(&bar[XB_TOP], 1u);
            const unsigned tg = og / nx;
            if (og + 1u == (tg + 1u) * nx) xb_add(&bar[XB_TOPGEN], 1u);
            else XB_SPIN(xb_ld(&bar[XB_TOPGEN]) == tg, bar);
            __builtin_amdgcn_fence(__ATOMIC_ACQUIRE, "agent");
            xb_add(&bar[XB_XGEN(b.x)], 1u);
            asm volatile("s_waitcnt vmcnt(0)" ::: "memory");
        } else {
            XB_SPIN(xb_ld(&bar[XB_XGEN(b.x)]) == gen, bar);
            __builtin_amdgcn_fence(__ATOMIC_ACQUIRE, "agent");
            asm volatile("s_waitcnt vmcnt(0)" ::: "memory");
        }
    }
    __syncthreads();
}


#ifndef MK_USE_CG
#define MK_USE_CG 1
#endif
#ifndef MK_SPLIT
#define MK_SPLIT 0
#endif
#ifndef MK_TIME
#define MK_TIME -1
#endif
#ifndef MK_TOFF
#define MK_TOFF 0.f
#endif
#if MK_TIME >= 0
#define TSTAMP() do { if (X.bid == 0 && X.tid == 0) ((unsigned long long*)(X.ws + 4096))[ph] = __builtin_amdgcn_s_memrealtime(); } while (0)
#define TSTAMP2(k) do { if (X.bid == 0 && X.tid == 0) ((unsigned long long*)(X.ws + 4096))[k] = __builtin_amdgcn_s_memrealtime(); } while (0)
#else
#define TSTAMP() do {} while (0)
#define TSTAMP2(k) do {} while (0)
#endif
#if MK_DEBUG
#define DBG(x) x
#else
#define DBG(x)
#endif
#ifndef MK_GT
#define MK_GT 0
#endif
#ifndef MK_GBLK
#define MK_GBLK 0
#endif
#ifndef MK_GWAVE
#define MK_GWAVE 0
#endif
#ifndef MK_GSEL
#define MK_GSEL 0
#endif
#ifndef MK_GMUL
#define MK_GMUL 10.f
#endif
#ifndef MK_GGAIN
#define MK_GGAIN 4
#endif
#if MK_GT
#define GT_SPIN(id) do { if (MK_GT == (id)) { GRID_SYNC(); if (X.bid == MK_GBLK && X.wave == MK_GWAVE) { volatile LAS unsigned* g_ = (volatile LAS unsigned*)(X.lds + 141312 + MK_GWAVE * 32); \
        unsigned v_ = (MK_GSEL == 16) ? g_[0] + g_[1] + g_[2] + g_[3] + g_[4] + g_[6] : (MK_GSEL == 17) ? g_[2] + g_[4] : g_[MK_GSEL & 7]; v_ = (unsigned)__builtin_amdgcn_readfirstlane((int)v_) * MK_GGAIN; \
        const unsigned t0_ = (unsigned)__builtin_amdgcn_s_memrealtime(); while ((unsigned)__builtin_amdgcn_s_memrealtime() - t0_ < v_) __builtin_amdgcn_s_sleep(8); } __syncthreads(); } } while (0)
#define GT_CALL(id, PT, P) do { if (MK_GT == (id)) pg8::gemm_phase<PT, true>(X.lds, P, X.tid, nullptr); else pg8::gemm_phase(X.lds, P, X.tid); } while (0)
#else
#define GT_CALL(id, PT, P) pg8::gemm_phase(X.lds, P, X.tid)
#define GT_SPIN(id) do {} while (0)
#endif
#ifndef MK_TA
#define MK_TA MK_TIME
#define MK_TB (MK_TIME + 1)
#endif
#ifdef DRY_F
constexpr int N_PHASES = 8 + 3 * NCH;
#else
constexpr int N_PHASES = 8 + 2 * NCH;
#endif

__global__ void __launch_bounds__(512, 2) mk_fwd(Args a) {
    extern __shared__ __attribute__((aligned(16))) unsigned char lds_raw[];
#if MK_USE_CG || MK_DEBUG || MK_TIME >= 0
    cg::grid_group grid = cg::this_grid();
#endif
    Ctx X;
    X.out = a.out; X.ws = a.ws; X.lds = (LAS unsigned char*)lds_raw;
#define SET_TID() do { int t_ = wave0 * 64 + lane_id(); asm volatile("" : "+v"(t_)); X.tid = t_; X.lane = t_ & 63; X.wave = __builtin_amdgcn_readfirstlane(t_ >> 6); } while (0)
    const int wave0 = __builtin_amdgcn_readfirstlane((int)threadIdx.x >> 6);
    SET_TID();
    X.G = gridDim.x; X.bid = blockIdx.x; X.vcu = (X.G % 8 == 0) ? (X.bid % 8) * (X.G / 8) + X.bid / 8 : X.bid;
    if (X.tid < 16) ((volatile LAS unsigned*)(X.lds + LDS_BYTES - 64))[X.tid] = 0u;
#if MK_USE_CG
    if (blockIdx.x == 0) for (int i = X.tid; i < XCD_BAR_WORDS; i += 512) ((unsigned*)(X.ws + WS_BAR))[i] = 0u;
    XcdBarrier xbar; xbar.bar = nullptr; xbar.x = 0; xbar.st = nullptr; xbar.wv = 0;
#else
    __syncthreads();
    XcdBarrier xbar = xcd_barrier_post((unsigned*)(X.ws + WS_BAR), (volatile LAS unsigned*)(X.lds + LDS_BYTES - 64), wave0);
#endif
    const int lo = a.ph_lo, hi = a.ph_hi;
    int ph = 0;
    constexpr int TE_LDS = pg8::STAGE_BYTES + 4096;
#define LOAD_TILE_TABLE() do { for (int i_ = X.tid; i_ < NCH * (RTMAX + SHT); i_ += 512) ((LAS int*)(X.lds + TE_LDS))[i_] = ((const int*)(X.ws + WS_TILEE))[i_]; __syncthreads(); } while (0)
#define PHASE_BEGIN() if (lo <= ph && ph < hi) { SET_TID(); TSTAMP();
#if MK_USE_CG
#define GRID_SYNC_FIRST() do { asm volatile("s_waitcnt vmcnt(0) lgkmcnt(0)" ::: "memory"); __syncthreads(); grid.sync(); xbar = xcd_barrier_post((unsigned*)(X.ws + WS_BAR), (volatile LAS unsigned*)(X.lds + LDS_BYTES - 64), wave0); } while (0)
#define GRID_SYNC() xcd_barrier(xbar)
#else
#define GRID_SYNC() xcd_barrier(xbar)
#endif
#define PHASE_END() if (ph + 1 < hi) GRID_SYNC(); } ++ph;

    PHASE_BEGIN() DBG(if (X.bid == 0 && X.tid < 64) ((int*)X.ws)[X.tid] = (X.tid == 0) ? 0x7fffffff : 0;) phase_p0(X, a); if (ph + 1 < hi) GRID_SYNC_FIRST(); } ++ph;
    PHASE_BEGIN() { ProbB P{1024, X.G, X.bid, X.ws, (bf16*)X.out}; GT_CALL(1, ProbB, P); } GT_SPIN(1); DBG(if (X.tid == 0) atomicAdd((int*)X.ws + 40, 1);) PHASE_END()
    PHASE_BEGIN()
        DBG(if (X.tid == 0 && __hip_atomic_load((int*)X.ws + 40, __ATOMIC_RELAXED, __HIP_MEMORY_SCOPE_AGENT) != X.G) dbg_fail(X.ws, 2); chk_B(X, a); chk_C_pre(X, a); GRID_SYNC();)
        conv_wbr(X, a);
        __syncthreads();
#ifdef DRY_LRU
        for (int u = X.bid; u < 256; u += X.G) lru_unit<true>(X, a, u);
#endif
#ifdef DRY_GMLP
        gmlp_units<true>(X, a);
#endif
        const bool lru_last = (X.bid >> 3) & 1;
        SET_TID(); TSTAMP2(32);
        if (!lru_last) { for (int u = X.bid; u < 256; u += X.G) lru_unit(X, a, u); }
        SET_TID(); TSTAMP2(33);
        for (int u = X.bid; u < 512; u += X.G) attn_unit(X, a, u);
        SET_TID(); TSTAMP2(34);
        gmlp_units(X, a);
        SET_TID();
        if (lru_last) { for (int u = X.bid; u < 256; u += X.G) lru_unit(X, a, u); }
        TSTAMP2(35);
    PHASE_END()
    PHASE_BEGIN() DBG(chk_C_post(X, a);) { ProbD1 P{3072, X.G, X.bid, X.ws, (bf16*)X.out}; pg8::gemm_phase(X.lds, P, X.tid); } PHASE_END()
    PHASE_BEGIN() DBG(chk_D1(X, a); GRID_SYNC();) { const bool conv_first = (X.bid >> 3) & 1;
        if (conv_first) { conv_experts(X, a); __syncthreads(); SET_TID(); }
        { ProbD2 P{1024, X.G, X.bid, X.ws}; GT_CALL(4, ProbD2, P); } GT_SPIN(4);
        if (!conv_first) conv_experts(X, a); } PHASE_END()
    PHASE_BEGIN() DBG(chk_D2(X, a); GRID_SYNC();) for (int b = X.bid; b < T / 128; b += X.G) route_block(X, a, b); PHASE_END()
    PHASE_BEGIN() DBG(chk_R1(X, a); __syncthreads();) for (int b = X.bid; b < T / 128; b += X.G) place_block(X, a, b); PHASE_END()
    PHASE_BEGIN() DBG(chk_R2(X, a);) { LOAD_TILE_TABLE(); const int* np = (const int*)(X.ws + WS_NTILE); ProbE1 P{1024, X.G, X.vcu, X.ws, __builtin_amdgcn_readfirstlane(np[0]), __builtin_amdgcn_readfirstlane(np[1]), (LAS const int*)(X.lds + TE_LDS), X.out};     GT_CALL(3, ProbE1, P); } GT_SPIN(3); PHASE_END()
    for (int chn = 0; chn < NCH; ++chn) {
        PHASE_BEGIN() DBG(if (chn == 0) { for (int c2 = 0; c2 < NCH; ++c2) chk_E(X, a, c2, 0); GRID_SYNC(); }) { LOAD_TILE_TABLE(); const int nt = __builtin_amdgcn_readfirstlane(((const int*)(X.ws + WS_NTILE))[chn]); ProbE2 P{256, X.G, X.vcu, X.ws, chn, nt, (LAS const int*)(X.lds + TE_LDS)}; GT_CALL(2, ProbE2, P); } GT_SPIN(2); PHASE_END()
#ifdef DRY_F
        PHASE_BEGIN() combine_rows<true>(X, a, chn); PHASE_END()
#endif
        PHASE_BEGIN() DBG(chk_E(X, a, chn, 1);) combine_rows(X, a, chn); PHASE_END()
    }
    DBG(grid.sync(); dbg_finish(X);)
#if MK_TIME >= 0 && defined(MK_PG)
    GRID_SYNC(); TSTAMP();
    if (X.bid == 0 && X.tid == 0) { const unsigned long long* ts = (const unsigned long long*)(X.ws + 4096); const unsigned long long d_ = (ts[MK_TB] - ts[MK_TA]) * MK_PG;
        const unsigned long long t0_ = __builtin_amdgcn_s_memrealtime(); while (__builtin_amdgcn_s_memrealtime() - t0_ < d_) __builtin_amdgcn_s_sleep(8); }
#elif MK_TIME >= 0
    GRID_SYNC(); TSTAMP(); GRID_SYNC();
    { const unsigned long long* ts = (const unsigned long long*)(X.ws + 4096); const float us = (float)(ts[MK_TIME + 1] - ts[MK_TIME]) * 0.01f;
      const float v = sqrtf(1.f + floorf((us + MK_TOFF) * (1.f / 16.f))); for (size_t i = (size_t)X.bid * 512 + X.tid; i < (size_t)T * D; i += (size_t)X.G * 512) X.out[i] = v; }
#endif
}

extern "C" void kernel_launch(void* const* d_in, const int* in_sizes, int n_in, void* d_out, int out_size, void* d_ws, size_t ws_size, hipStream_t stream) {
    static int grid = 0;
    if (grid == 0) {
        if (n_in != 33 || out_size != T * D || ws_size < WS_END) { fprintf(stderr, "kernel_launch: unexpected shapes: n_in %d out %d ws %zu\n", n_in, out_size, ws_size); grid = -1; return; }
        int dev = 0, cus = 0, per_cu = 0;
        if (hipGetDevice(&dev) != hipSuccess || hipDeviceGetAttribute(&cus, hipDeviceAttributeMultiprocessorCount, dev) != hipSuccess) { grid = -1; return; }
        if (hipFuncSetAttribute((const void*)mk_fwd, hipFuncAttributeMaxDynamicSharedMemorySize, LDS_BYTES) != hipSuccess) { fprintf(stderr, "kernel_launch: hipFuncSetAttribute failed\n"); grid = -1; return; }
        if (hipOccupancyMaxActiveBlocksPerMultiprocessor(&per_cu, (const void*)mk_fwd, 512, LDS_BYTES) != hipSuccess || per_cu < 1) { fprintf(stderr, "kernel_launch: occupancy query says %d\n", per_cu); per_cu = 1; }
        (void)hipGetLastError();
        grid = cus;
        fprintf(stderr, "kernel_launch: cus %d per_cu %d grid %d ws %zu\n", cus, per_cu, grid, ws_size);
    }
    if (grid < 0) return;
#if !MK_USE_CG
    if (hipMemsetAsync((char*)d_ws + WS_BAR, 0, XCD_BAR_WORDS * 4, stream) != hipSuccess) { fprintf(stderr, "kernel_launch: hipMemsetAsync of the barrier words failed\n"); return; }
#endif
    Args a{};
    for (int i = 0; i < 33; ++i) a.in[i] = (const float*)d_in[i];
    a.out = (float*)d_out; a.ws = (unsigned char*)d_ws;
#if MK_SPLIT
    for (int p = 0; p < N_PHASES; ++p) { a.ph_lo = p; a.ph_hi = p + 1;
#else
    { a.ph_lo = 0; a.ph_hi = N_PHASES;
#endif
        void* args[] = {&a};
        const hipError_t e = hipLaunchCooperativeKernel((const void*)mk_fwd, dim3(grid), dim3(512), args, LDS_BYTES, stream);
        if (e != hipSuccess) fprintf(stderr, "kernel_launch: cooperative launch failed: %s (grid %d)\n", hipGetErrorString(e), grid);
    }
}
```
